# Optimizing an MI355X kernel written in HIP

```python
import math
import jax, jax.numpy as jnp
from jax import lax
import numpy as np

D_MODEL = 2048
BATCH = 4
SEQ = 4096
DEPTH = 2

CHUNK = 64
QB = 128
HEAD_DIM = 64
A_HEADS = 16
A_KV_HEADS = 4
WINDOW = 128
WINDOW_CHUNKS = WINDOW // CHUNK
B_HEADS = 16
KV_RANK = 256
IDX_HEADS = 8
IDX_DIM = 64
TOPK_MAX = 256
C_HEADS = 16
C_HEAD_DIM = 128
NUM_BUCKETS = 32
MAX_DISTANCE = 128
D_FF = 5632
CONV_W = 3
EPS = 1e-6

N_EVEN = (DEPTH + 1) // 2
N_ODD = DEPTH // 2
EVEN_SPLITS = (A_HEADS * HEAD_DIM, A_KV_HEADS * HEAD_DIM, A_KV_HEADS * HEAD_DIM,
               B_HEADS * HEAD_DIM, KV_RANK, IDX_HEADS * IDX_DIM, IDX_DIM, IDX_HEADS)
EVEN_IN = sum(EVEN_SPLITS)
MIX_WIDTH_EVEN = (A_HEADS + B_HEADS) * HEAD_DIM
MIX_WIDTH_ODD = C_HEADS * C_HEAD_DIM

kernel_name = 'hybrid_chunk_causal_swa_dsa_stickbreak_convffn'


def rms_norm(x, g):
    xf = x.astype(jnp.float32)
    y = xf * lax.rsqrt(jnp.mean(xf * xf, axis=-1, keepdims=True) + EPS)
    return (y * g.astype(jnp.float32)).astype(x.dtype)


def split_cols(a, sizes):
    offs = np.cumsum(sizes)[:-1].tolist()
    return jnp.split(a, offs, axis=-1)


def t5_bucket(rel):
    half = NUM_BUCKETS // 2
    max_exact = half // 2
    n = jnp.abs(rel)
    nf = jnp.maximum(n, 1).astype(jnp.float32)
    large = max_exact + (jnp.log(nf / max_exact) / math.log(MAX_DISTANCE / max_exact)
                         * (half - max_exact)).astype(jnp.int32)
    large = jnp.minimum(large, half - 1)
    return jnp.where(rel > 0, half, 0) + jnp.where(n < max_exact, n, large)


def to_blocks(a):
    return a.reshape(a.shape[0], a.shape[1] // QB, QB, *a.shape[2:]).swapaxes(0, 1)


def from_blocks(o):
    return o.swapaxes(0, 1).reshape(o.shape[1], o.shape[0] * QB, -1)


def swa_sink_attention(q, k, v, sinks, bias_table):
    Bn, S, H, Dh = q.shape
    KV = k.shape[2]
    G = H // KV
    nblk = S // QB

    def band(a):
        ap = jnp.pad(a, ((0, 0), (QB, 0), (0, 0), (0, 0))).reshape(Bn, nblk + 1, QB, KV, Dh)
        return jnp.concatenate([ap[:, :-1], ap[:, 1:]], axis=2)

    kb, vb = band(k), band(v)
    qg = q.reshape(Bn, nblk, QB, KV, G, Dh)
    s = jnp.einsum('bnqkgd,bnskd->bnkgqs', qg, kb).astype(jnp.float32) * Dh ** -0.5
    q_off = jnp.arange(QB)
    k_off = jnp.arange(2 * QB) - QB
    rel = k_off[None, :] - q_off[:, None]
    bias = bias_table.astype(jnp.float32)[t5_bucket(rel)]
    bias = jnp.transpose(bias, (2, 0, 1)).reshape(KV, G, QB, 2 * QB)
    start = jnp.arange(nblk)[:, None] * QB
    qpos = start + q_off
    kpos = start + k_off
    qc = qpos // CHUNK
    kc = jnp.floor_divide(kpos, CHUNK)
    allowed = ((kpos >= 0)[:, None, :]
               & (kc[:, None, :] <= qc[:, :, None])
               & (kc[:, None, :] >= qc[:, :, None] - WINDOW_CHUNKS))
    s = jnp.where(allowed[None, :, None, None], s + bias, -jnp.inf)
    sink = sinks.astype(jnp.float32).reshape(KV, G)[:, :, None, None]
    m = jnp.maximum(jnp.max(s, axis=-1, keepdims=True), sink)
    p = jnp.exp(s - m)
    p = p / (jnp.sum(p, axis=-1, keepdims=True) + jnp.exp(sink - m))
    o = jnp.einsum('bnkgqs,bnskd->bnqkgd', p.astype(v.dtype), vb)
    return o.reshape(Bn, S, H * Dh)


def dsa_attention(q, c_kv, q_idx, k_idx, w_idx, w_uk, w_uv, bias_table):
    Bn, S, H, Dh = q.shape
    topk = min(TOPK_MAX, S // 4)
    kchunk = jnp.arange(S) // CHUNK
    bias_table = bias_table.astype(jnp.float32)

    def block(args):
        qb, qib, wb, n = args
        qpos = n * QB + jnp.arange(QB)
        qchunk = qpos // CHUNK
        r = jax.nn.relu(jnp.einsum('bqhd,bsd->bqhs', qib, k_idx).astype(jnp.float32) * IDX_DIM ** -0.5)
        score = jnp.einsum('bqhs,bqh->bqs', r, wb.astype(jnp.float32) * IDX_HEADS ** -0.5)
        score = jnp.where((kchunk[None, :] <= qchunk[:, None])[None], score, -jnp.inf)
        _, idx = lax.top_k(score, topk)
        valid = (idx // CHUNK) <= qchunk[None, :, None]
        c_sel = jax.vmap(lambda cb, ib: cb[ib])(c_kv, idx)
        q_lat = jnp.einsum('bqhd,hdr->bqhr', qb, w_uk)
        s = jnp.einsum('bqhr,bqkr->bqhk', q_lat, c_sel).astype(jnp.float32) * Dh ** -0.5
        bias = bias_table[t5_bucket(idx - qpos[None, :, None])]
        s = jnp.where(valid[:, :, None, :], s + jnp.swapaxes(bias, 2, 3), -jnp.inf)
        p = jax.nn.softmax(s, axis=-1).astype(c_sel.dtype)
        o_lat = jnp.einsum('bqhk,bqkr->bqhr', p, c_sel)
        return jnp.einsum('bqhr,hrd->bqhd', o_lat, w_uv)

    out = lax.map(block, (to_blocks(q), to_blocks(q_idx), to_blocks(w_idx), jnp.arange(S // QB)))
    return from_blocks(out)


def stick_breaking_attention(q, k, v):
    Bn, S, H, Dh = q.shape
    kpos = jnp.arange(S)

    def block(args):
        qb, n = args
        qpos = n * QB + jnp.arange(QB)
        z = jnp.einsum('bqhd,bshd->bhqs', qb, k).astype(jnp.float32) * Dh ** -0.5
        earlier = kpos[None, :] < qpos[:, None]
        log_keep = jnp.where(earlier, jax.nn.log_sigmoid(-z), 0.0)
        between = lax.cumsum(log_keep, axis=3, reverse=True) - log_keep
        a = jnp.where(earlier, jnp.exp(jax.nn.log_sigmoid(z) + between), 0.0)
        return jnp.einsum('bhqs,bshd->bqhd', a.astype(v.dtype), v)

    return from_blocks(lax.map(block, (to_blocks(q), jnp.arange(S // QB))))


def even_mixer(h, w_in, kv_norm_g, w_uk, w_uv, sinks, w_out, rel_bias):
    Bn, S, _ = h.shape
    qa, ka, va, qb, c_lat, qi, ki, wi = split_cols(h @ w_in, EVEN_SPLITS)
    o_a = swa_sink_attention(qa.reshape(Bn, S, A_HEADS, HEAD_DIM),
                             ka.reshape(Bn, S, A_KV_HEADS, HEAD_DIM),
                             va.reshape(Bn, S, A_KV_HEADS, HEAD_DIM),
                             sinks, rel_bias[:, :A_HEADS])
    o_b = dsa_attention(qb.reshape(Bn, S, B_HEADS, HEAD_DIM), rms_norm(c_lat, kv_norm_g),
                        qi.reshape(Bn, S, IDX_HEADS, IDX_DIM), ki, wi, w_uk, w_uv,
                        rel_bias[:, A_HEADS:])
    return jnp.concatenate([o_a, o_b], axis=-1) @ w_out


def odd_mixer(h, w_in, w_out):
    Bn, S, _ = h.shape
    q, k, v = jnp.split(h @ w_in, 3, axis=-1)
    shp = (Bn, S, C_HEADS, C_HEAD_DIM)
    return stick_breaking_attention(q.reshape(shp), k.reshape(shp), v.reshape(shp)) @ w_out


def conv_ffn(h, w_up, conv_w, conv_b, w_down):
    S = h.shape[1]
    u = h @ w_up
    up = jnp.pad(u, ((0, 0), (CONV_W - 1, 0), (0, 0)))
    u = sum(conv_w[j] * up[:, j:j + S] for j in range(CONV_W)) + conv_b
    gate, val = jnp.split(u, 2, axis=-1)
    return (jax.nn.silu(gate) * val) @ w_down


def setup_inputs(seed: int = 0) -> dict:
    key = jax.random.key(seed)
    ks = jax.random.split(key, 21)
    D = D_MODEL

    def nrm(k, shape, scale):
        return jax.random.normal(k, shape, jnp.float32) * scale

    return {
        'x': nrm(ks[0], (BATCH, SEQ, D), 1.0),
        'c': nrm(ks[1], (BATCH, D), 1.0),
        'rel_bias': nrm(ks[2], (NUM_BUCKETS, A_HEADS + B_HEADS), 0.5),
        'ada_w': nrm(ks[3], (DEPTH, D, 6 * D), D ** -0.5),
        'ada_b': nrm(ks[4], (DEPTH, 6 * D), 0.02),
        'norm_mix_g': 1.0 + nrm(ks[5], (DEPTH, D), 0.02),
        'norm_ffn_g': 1.0 + nrm(ks[6], (DEPTH, D), 0.02),
        'ev_w_in': nrm(ks[7], (N_EVEN, D, EVEN_IN), D ** -0.5),
        'ev_kv_norm_g': 1.0 + nrm(ks[8], (N_EVEN, KV_RANK), 0.02),
        'ev_w_uk': nrm(ks[9], (N_EVEN, B_HEADS, HEAD_DIM, KV_RANK), KV_RANK ** -0.5),
        'ev_w_uv': nrm(ks[10], (N_EVEN, B_HEADS, KV_RANK, HEAD_DIM), KV_RANK ** -0.5),
        'ev_sinks': nrm(ks[11], (N_EVEN, A_HEADS), 0.5),
        'ev_w_out': nrm(ks[12], (N_EVEN, MIX_WIDTH_EVEN, D), MIX_WIDTH_EVEN ** -0.5),
        'od_w_in': nrm(ks[13], (N_ODD, D, 3 * MIX_WIDTH_ODD), D ** -0.5),
        'od_w_out': nrm(ks[14], (N_ODD, MIX_WIDTH_ODD, D), MIX_WIDTH_ODD ** -0.5),
        'ffn_w_up': nrm(ks[15], (DEPTH, D, 2 * D_FF), D ** -0.5),
        'ffn_conv_w': nrm(ks[16], (DEPTH, CONV_W, 2 * D_FF), CONV_W ** -0.5),
        'ffn_conv_b': nrm(ks[17], (DEPTH, 2 * D_FF), 0.02),
        'ffn_w_down': nrm(ks[18], (DEPTH, D_FF, D), D_FF ** -0.5),
        'final_g': 1.0 + nrm(ks[19], (D,), 0.02),
    }


def reference(x, c, rel_bias, ada_w, ada_b, norm_mix_g, norm_ffn_g, ev_w_in, ev_kv_norm_g,
              ev_w_uk, ev_w_uv, ev_sinks, ev_w_out, od_w_in, od_w_out, ffn_w_up, ffn_conv_w,
              ffn_conv_b, ffn_w_down, final_g):
    c_act = jax.nn.silu(c)
    for i in range(DEPTH):
        mod = c_act @ ada_w[i] + ada_b[i]
        sh1, sc1, g1, sh2, sc2, g2 = [m[:, None, :] for m in jnp.split(mod, 6, axis=-1)]
        h = rms_norm(x, norm_mix_g[i]) * (1.0 + sc1) + sh1
        if i % 2 == 0:
            j = i // 2
            y = even_mixer(h, ev_w_in[j], ev_kv_norm_g[j], ev_w_uk[j], ev_w_uv[j],
                           ev_sinks[j], ev_w_out[j], rel_bias)
        else:
            j = i // 2
            y = odd_mixer(h, od_w_in[j], od_w_out[j])
        x = x + g1 * y
        h = rms_norm(x, norm_ffn_g[i]) * (1.0 + sc2) + sh2
        x = x + g2 * conv_ffn(h, ffn_w_up[i], ffn_conv_w[i], ffn_conv_b[i], ffn_w_down[i])
    return rms_norm(x, final_g)
```

```cpp
#include <hip/hip_runtime.h>
#include <hip/hip_cooperative_groups.h>
#include <cstdio>
#include <cstdint>
namespace cg = cooperative_groups;

namespace pg8 {
#define PG8_LAS __attribute__((address_space(3)))
typedef unsigned short bf16_t;
typedef short bf16x8 __attribute__((ext_vector_type(8)));
typedef float f32x4 __attribute__((ext_vector_type(4)));
typedef unsigned u32x4 __attribute__((ext_vector_type(4)));
constexpr int BM = 256, BK = 64, HALF = 128, HTB = HALF * BK * 2  , STAGE_BYTES = 8 * HTB, NXCD = 8, WGM = 8;

__host__ __device__ __forceinline__ int lds_byte(int r, int c) { const int st = (r >> 4) * 2 + (c >> 5), rr = r & 15, cc = c & 31, ob = rr * 64 + cc * 2; return st * 1024 + (ob ^ (((ob >> 9) & 1) << 5)); }
__host__ __device__ __forceinline__ void stage_rc(int b, int& R, int& C) { const int st = b / 1024, sb = b % 1024, swz = sb ^ (((sb >> 9) & 1) << 5); R = (st >> 1) * 16 + swz / 64; C = (st & 1) * 32 + (swz % 64) / 2; }
__host__ __device__ __forceinline__ int perm32(int rho) { const int n = rho >> 4, i = rho & 15; return 8 * (i >> 2) + 4 * n + (i & 3); }

struct Unit { int pm, pn; };
struct Gemm { const bf16_t* A; const bf16_t* Bt; int M, N, K; };

struct StaticOrder {
    int nM, nN, nwg, G, c;
    __host__ __device__ void init(int M, int N, int G_, int c_) { nM = M / BM; nN = N / BM; nwg = nM * nN; G = G_; c = c_; }
    __host__ __device__ bool next(int i, Unit& u) const {
        const long L = (long)i * G + c; if (L >= nwg) return false;
        int wgid = (int)L; { const int q = nwg / NXCD, r = nwg % NXCD, xcd = wgid % NXCD, off = wgid / NXCD; wgid = (xcd < r ? xcd * (q + 1) : r * (q + 1) + (xcd - r) * q) + off; }
        const int nig = WGM * nN, gid = wgid / nig, fm = gid * WGM, gsz = (nM - fm) < WGM ? (nM - fm) : WGM;
        u.pm = fm + ((wgid % nig) % gsz); u.pn = (wgid % nig) / gsz; return true;
    }
    __device__ __forceinline__ void a_ready(const Unit&) const {}
    __device__ __forceinline__ void done(const Unit&) const {}
};

__device__ __forceinline__ unsigned cvt_pk_bf16(float lo, float hi) { unsigned r; asm volatile("v_cvt_pk_bf16_f32 %0, %1, %2" : "=v"(r) : "v"(lo), "v"(hi)); return r; }
typedef float f32x2 __attribute__((ext_vector_type(2)));
typedef unsigned u32x2v __attribute__((ext_vector_type(2)));
typedef float f32x2c __attribute__((ext_vector_type(2))); typedef __bf16 bf16x2c __attribute__((ext_vector_type(2)));
__device__ __forceinline__ unsigned pkb(float lo, float hi) { f32x2c v = {lo, hi}; bf16x2c b = __builtin_convertvector(v, bf16x2c); return __builtin_bit_cast(unsigned, b); }
struct EpiBf16 {
    static constexpr bool PERM = true, AFTER_DRAIN = false;
    bf16_t* O; int ldc;
    __device__ __forceinline__ void operator()(const f32x4 (&acc)[2][2][4][2], const Unit& u, int wr, int wc, int fr, int fq) const {
        const int row0 = u.pm * BM + wr * 64 + fr; const int col0 = u.pn * BM + wc * 32 + 8 * fq;
#pragma unroll
        for (int ai = 0; ai < 2; ++ai)
#pragma unroll
            for (int m = 0; m < 4; ++m) { bf16_t* rowp = O + (size_t)(row0 + ai * HALF + m * 16) * ldc + col0;
#pragma unroll
                for (int bj = 0; bj < 2; ++bj) { const f32x4 v0 = acc[ai][bj][m][0], v1 = acc[ai][bj][m][1];
                    u32x4 w; w.x = pkb(v0[0], v0[1]); w.y = pkb(v0[2], v0[3]); w.z = pkb(v1[0], v1[1]); w.w = pkb(v1[2], v1[3]);
                    *(u32x4*)(rowp + bj * HALF) = w; } }
    }
};
struct EpiResid {
    static constexpr bool PERM = false, AFTER_DRAIN = false;
    const float* base; float* out; const float* gate;
    __device__ __forceinline__ void operator()(const f32x4 (&acc)[2][2][4][2], const Unit& u, int wr, int wc, int fr, int fq) const {
        const int b = (u.pm * BM) >> 12; const int col0 = u.pn * BM + wc * 32 + 4 * fq; const float* gp = gate + (size_t)b * 12288 + col0;
#pragma unroll
        for (int bj = 0; bj < 2; ++bj)
#pragma unroll
            for (int n = 0; n < 2; ++n) { const f32x4 gv = *(const f32x4*)(gp + bj * HALF + n * 16);
#pragma unroll
                for (int ai = 0; ai < 2; ++ai)
#pragma unroll
                    for (int m = 0; m < 4; ++m) { const size_t off = (size_t)(u.pm * BM + ai * HALF + wr * 64 + m * 16 + fr) * 2048 + col0 + bj * HALF + n * 16;
                        const f32x4 bs = *(const f32x4*)(base + off); *(f32x4*)(out + off) = bs + gv * acc[ai][bj][m][n]; } }
    }
};
template <class Epi, class Sched, bool ALIGN_EPI = false, bool SP2 = false>
__device__ __forceinline__ void gemm_phase(PG8_LAS unsigned char* lds, const Gemm g, const Sched& S, const Epi& E) {
    int tid_o = threadIdx.x; asm volatile("" : "+v"(tid_o)); const int tid = tid_o, wid = __builtin_amdgcn_readfirstlane(tid >> 6), lane = tid & 63, wr = wid >> 2, wc = wid & 3, fr = lane & 15, fq = lane >> 4;
    const int K = g.K, nt = K / BK;
    unsigned voffA[2], voffB[2];
#pragma unroll
    for (int i = 0; i < 2; ++i) { int R, C; stage_rc(tid * 16 + i * 8192, R, C); const int Rb = Epi::PERM ? ((R & ~31) + perm32(R & 31)) : R;
        voffA[i] = (unsigned)(R * K + C) * 2u; voffB[i] = (unsigned)(Rb * K + C) * 2u; }
    const size_t kstep = (size_t)(BK * 2);
    const size_t hstep = (size_t)HALF * K * 2;
    const size_t tstep = 2 * hstep;
    const unsigned ldsw = (unsigned)wid * 1024u;
    const int aoff = lds_byte(wr * 64 + fr, fq * 8), boff = lds_byte(wc * 32 + fr, fq * 8);
#define PG8_SA(b, h) (((b) * 2 + (h)) * HTB)
#define PG8_SB(b, h) ((4 + (b) * 2 + (h)) * HTB)
#define PG8_STAGE(bufoff, gbase, voff) do { _Pragma("unroll") for (int _i = 0; _i < 2; ++_i) \
        __builtin_amdgcn_global_load_lds((const unsigned*)((const char*)(gbase) + (voff)[_i]), (PG8_LAS unsigned*)(lds + (bufoff) + ldsw + _i * 8192), 16, 0, 0); } while (0)
#define PG8_LDA(dst, b, h) do { _Pragma("unroll") for (int m = 0; m < 4; ++m) _Pragma("unroll") for (int k = 0; k < 2; ++k) dst[m][k] = *(const PG8_LAS bf16x8*)(lds + PG8_SA(b, h) + aoff + m * 2048 + k * 1024); } while (0)
#define PG8_LDB(dst, b, h) do { _Pragma("unroll") for (int n = 0; n < 2; ++n) _Pragma("unroll") for (int k = 0; k < 2; ++k) dst[n][k] = *(const PG8_LAS bf16x8*)(lds + PG8_SB(b, h) + boff + n * 2048 + k * 1024); } while (0)
#define PG8_MMA(ai, bj, At, Bt) do { __builtin_amdgcn_s_setprio(1); _Pragma("unroll") for (int m = 0; m < 4; ++m) _Pragma("unroll") for (int n = 0; n < 2; ++n) _Pragma("unroll") for (int k = 0; k < 2; ++k) \
        acc[ai][bj][m][n] = __builtin_amdgcn_mfma_f32_16x16x32_bf16(Bt[n][k], At[m][k], acc[ai][bj][m][n], 0, 0, 0); __builtin_amdgcn_s_setprio(0); } while (0)
#define PG8_WAIT_V(n) asm volatile("s_waitcnt vmcnt(" #n ")" ::: "memory")
#define PG8_WAIT_L(n) asm volatile("s_waitcnt lgkmcnt(" #n ")" ::: "memory")
#define PG8_BAR __builtin_amdgcn_s_barrier()
#define PG8_SCHED __builtin_amdgcn_sched_barrier(0)
    Unit cur, nxt; int ui = 0;
    if (!S.next(0, cur)) return;
    f32x4 acc[2][2][4][2];
#pragma unroll
    for (int a = 0; a < 2; ++a)
#pragma unroll
        for (int b = 0; b < 2; ++b)
#pragma unroll
            for (int m = 0; m < 4; ++m)
#pragma unroll
                for (int n = 0; n < 2; ++n) acc[a][b][m][n] = (f32x4){0.f, 0.f, 0.f, 0.f};
    bf16x8 At[4][2], B0[2][2], B1[2][2];
    const char* cA = (const char*)g.A + (size_t)cur.pm * tstep; const char* cB = (const char*)g.Bt + (size_t)cur.pn * tstep;
    S.a_ready(cur);
    if constexpr (SP2) {
        PG8_STAGE(PG8_SB(0, 0), cB, voffB); PG8_STAGE(PG8_SB(0, 1), cB + hstep, voffB); PG8_STAGE(PG8_SA(0, 0), cA, voffA); PG8_STAGE(PG8_SA(0, 1), cA + hstep, voffA);
        if (wr == 1) PG8_BAR;
        PG8_WAIT_V(2); PG8_BAR;
        PG8_STAGE(PG8_SB(1, 0), cB + kstep, voffB); PG8_STAGE(PG8_SA(1, 0), cA + kstep, voffA); PG8_STAGE(PG8_SB(1, 1), cB + hstep + kstep, voffB);
        PG8_WAIT_V(6); PG8_BAR;
    } else {
        PG8_STAGE(PG8_SB(0, 0), cB, voffB); PG8_STAGE(PG8_SA(0, 0), cA, voffA); PG8_STAGE(PG8_SB(0, 1), cB + hstep, voffB); PG8_STAGE(PG8_SA(0, 1), cA + hstep, voffA);
        if (wr == 1) PG8_BAR;
        PG8_WAIT_V(4); PG8_BAR;
        PG8_STAGE(PG8_SB(1, 0), cB + kstep, voffB); PG8_STAGE(PG8_SA(1, 0), cA + kstep, voffA); PG8_STAGE(PG8_SB(1, 1), cB + hstep + kstep, voffB);
        PG8_WAIT_V(6); PG8_BAR;
    }
    for (;;) {
        const bool has_next = S.next(ui + 1, nxt);
        const char* nA = has_next ? (const char*)g.A + (size_t)nxt.pm * tstep : cA; const char* nB = has_next ? (const char*)g.Bt + (size_t)nxt.pn * tstep : cB;
        for (int t = 0; t < nt; t += 2) {
            const bool last = (t == nt - 2);
            const char* a1 = cA + (size_t)(t + 1) * kstep;
            const char* a2 = last ? nA : cA + (size_t)(t + 2) * kstep; const char* b2 = last ? nB : cB + (size_t)(t + 2) * kstep;
            const char* a3 = a2 + kstep; const char* b3 = b2 + kstep;
            if (last && has_next) S.a_ready(nxt);
            if constexpr (SP2) {
            PG8_LDB(B0, 0, 0); PG8_LDB(B1, 0, 1); PG8_SCHED; PG8_LDA(At, 0, 0); PG8_STAGE(PG8_SA(1, 1), a1 + hstep, voffA);
            PG8_WAIT_V(8); PG8_WAIT_L(0); PG8_BAR; PG8_MMA(0, 0, At, B0); PG8_MMA(0, 1, At, B1); PG8_BAR; PG8_SCHED;
            PG8_LDA(At, 0, 1); PG8_STAGE(PG8_SB(0, 0), b2, voffB); PG8_STAGE(PG8_SB(0, 1), b2 + hstep, voffB); PG8_STAGE(PG8_SA(0, 0), a2, voffA);
            PG8_WAIT_V(8); PG8_WAIT_L(0); PG8_BAR; PG8_MMA(1, 0, At, B0); PG8_MMA(1, 1, At, B1); PG8_BAR; PG8_SCHED;
            PG8_LDB(B0, 1, 0); PG8_LDB(B1, 1, 1); PG8_SCHED; PG8_LDA(At, 1, 0); PG8_STAGE(PG8_SA(0, 1), a2 + hstep, voffA);
            PG8_WAIT_V(8); PG8_WAIT_L(0); PG8_BAR; PG8_MMA(0, 0, At, B0); PG8_MMA(0, 1, At, B1); PG8_BAR; PG8_SCHED;
            PG8_LDA(At, 1, 1); PG8_STAGE(PG8_SB(1, 0), b3, voffB); PG8_STAGE(PG8_SB(1, 1), b3 + hstep, voffB); PG8_STAGE(PG8_SA(1, 0), a3, voffA);
            PG8_WAIT_V(8); PG8_WAIT_L(0); PG8_BAR; PG8_MMA(1, 0, At, B0); PG8_MMA(1, 1, At, B1); PG8_BAR; PG8_SCHED;
            } else {
            PG8_LDB(B0, 0, 0); PG8_SCHED; PG8_LDA(At, 0, 0); PG8_STAGE(PG8_SA(1, 1), a1 + hstep, voffA);
            PG8_WAIT_L(8); PG8_BAR; PG8_WAIT_L(0); PG8_MMA(0, 0, At, B0); PG8_BAR; PG8_SCHED;
            PG8_LDB(B1, 0, 1); PG8_STAGE(PG8_SB(0, 0), b2, voffB);
            PG8_BAR; PG8_WAIT_L(0); PG8_MMA(0, 1, At, B1); PG8_BAR;
            PG8_LDA(At, 0, 1); PG8_STAGE(PG8_SA(0, 0), a2, voffA);
            PG8_BAR; PG8_WAIT_L(0); PG8_MMA(1, 0, At, B0); PG8_BAR; PG8_SCHED;
            PG8_STAGE(PG8_SB(0, 1), b2 + hstep, voffB);
            PG8_WAIT_V(6); PG8_BAR; PG8_MMA(1, 1, At, B1); PG8_BAR;
            PG8_LDB(B0, 1, 0); PG8_SCHED; PG8_LDA(At, 1, 0); PG8_STAGE(PG8_SA(0, 1), a2 + hstep, voffA);
            PG8_WAIT_L(8); PG8_BAR; PG8_WAIT_L(0); PG8_MMA(0, 0, At, B0); PG8_BAR; PG8_SCHED;
            PG8_LDB(B1, 1, 1); PG8_STAGE(PG8_SB(1, 0), b3, voffB);
            PG8_BAR; PG8_WAIT_L(0); PG8_MMA(0, 1, At, B1); PG8_BAR;
            PG8_LDA(At, 1, 1); PG8_STAGE(PG8_SA(1, 0), a3, voffA);
            PG8_BAR; PG8_WAIT_L(0); PG8_MMA(1, 0, At, B0); PG8_BAR; PG8_SCHED;
            PG8_STAGE(PG8_SB(1, 1), b3 + hstep, voffB);
            PG8_WAIT_V(6); PG8_BAR; PG8_MMA(1, 1, At, B1); PG8_BAR;
            }
        }
        if constexpr (ALIGN_EPI) { if (wr == 0) PG8_BAR; }
        if constexpr (!Epi::AFTER_DRAIN) { E(acc, cur, wr, wc, fr, fq); S.done(cur); }
        if (!has_next) break;
#pragma unroll
        for (int a = 0; a < 2; ++a)
#pragma unroll
            for (int b = 0; b < 2; ++b)
#pragma unroll
                for (int m = 0; m < 4; ++m)
#pragma unroll
                    for (int n = 0; n < 2; ++n) acc[a][b][m][n] = (f32x4){0.f, 0.f, 0.f, 0.f};
        cur = nxt; cA = nA; cB = nB; ++ui;
        if constexpr (ALIGN_EPI) { if (wr == 1) PG8_BAR; }
    }
    PG8_WAIT_V(0);
    if constexpr (!ALIGN_EPI) { if (wr == 0) PG8_BAR; }
    PG8_BAR;
    if constexpr (Epi::AFTER_DRAIN) { E.fused(acc, cur, wr, wc, fr, fq, lds, wid, lane); S.done(cur); }
#undef PG8_SA
#undef PG8_SB
#undef PG8_STAGE
#undef PG8_LDA
#undef PG8_LDB
#undef PG8_MMA
#undef PG8_WAIT_V
#undef PG8_WAIT_L
#undef PG8_BAR
#undef PG8_SCHED
}
}

constexpr int NB = 4, SEQ = 4096, DM = 2048, MTOK = NB * SEQ;
constexpr int EV_PITCH = 3584, EV_IN = 3400, OD_PITCH = 6144, DFF = 5632, DFF2 = 11264;
constexpr int C_QA = 0, C_KA = 1024, C_VA = 1280, C_QB = 1536, C_CLAT = 2560, C_QI = 2816, C_KI = 3328, C_WI = 3392;
constexpr float EPS = 1e-6f;
constexpr size_t MiB = 1u << 20;
constexpr size_t WS_MOD = 0, WS_WUKT = 512 * 1024, WS_WUVT = 1 * MiB, WS_WIN = 2 * MiB, WS_WOUT = 26 * MiB, WS_WUP = 34 * MiB, WS_WDN = 78 * MiB,
                 WS_XN = 100 * MiB, WS_BIG = 164 * MiB, WS_QLAT = 276 * MiB, WS_G = 516 * MiB, WS_ATT = 516 * MiB, WS_CKV = 580 * MiB,
                 WS_IDX = 588 * MiB, WS_CNT = 604 * MiB, WS_END = 692 * MiB;
constexpr int LDS_BYTES = 147456;
#ifndef SKIP_SWA
#define SKIP_SWA 0
#endif
#ifndef SKIP_DSA
#define SKIP_DSA 0
#endif
#ifndef SKIP_SB
#define SKIP_SB 0
#endif

typedef unsigned short bf16_t;
typedef short bf16x8 __attribute__((ext_vector_type(8)));
typedef float f32x4 __attribute__((ext_vector_type(4)));
typedef unsigned u32x4 __attribute__((ext_vector_type(4)));
typedef unsigned u32x2 __attribute__((ext_vector_type(2)));
#define LAS __attribute__((address_space(3)))
#define MFMA16(a, b, c) __builtin_amdgcn_mfma_f32_16x16x32_bf16((a), (b), (c), 0, 0, 0)

typedef float f32x2_t __attribute__((ext_vector_type(2))); typedef __bf16 bf16x2_t __attribute__((ext_vector_type(2)));
__device__ __forceinline__ unsigned pk2(float lo, float hi) { f32x2_t v = {lo, hi}; bf16x2_t b = __builtin_convertvector(v, bf16x2_t); return __builtin_bit_cast(unsigned, b); }
__device__ __forceinline__ float bflo(unsigned w) { return __uint_as_float(w << 16); }
__device__ __forceinline__ float bfhi(unsigned w) { return __uint_as_float(w & 0xffff0000u); }
__device__ __forceinline__ float wave_sum(float v) {
#pragma unroll
    for (int o = 1; o < 64; o <<= 1) v += __shfl_xor(v, o);
    return v;
}
__device__ __forceinline__ int wave_sum_i(int v) {
#pragma unroll
    for (int o = 1; o < 64; o <<= 1) v += __shfl_xor(v, o);
    return v;
}
__device__ __forceinline__ int t5_bucket(int rel) {
    const int n = rel < 0 ? -rel : rel; int v = n;
    if (n >= 8) v = 8 + (n >= 12) + (n >= 16) + (n >= 23) + (n >= 32) + (n >= 46) + (n >= 64) + (n >= 91);
    return (rel > 0 ? 16 : 0) + v;
}
__device__ __forceinline__ bf16x8 mk8(unsigned a, unsigned b, unsigned c, unsigned d) { u32x4 w; w.x = a; w.y = b; w.z = c; w.w = d; return __builtin_bit_cast(bf16x8, w); }

struct Args { const float* in[20]; float* out; unsigned char* ws; };

__device__ __forceinline__ void transpose_item(const float* W, int K, int N, bf16_t* WT, LAS float* scr, int item, int nblk, int lane) {
    const int kb = item / nblk, nb = item % nblk, k0 = 64 * kb, n0 = 32 * nb; const int nc = n0 + (lane & 31);
#pragma unroll 8
    for (int i = 0; i < 32; ++i) { const int kk = 2 * i + (lane >> 5); scr[kk * 33 + (lane & 31)] = (nc < N) ? W[(size_t)(k0 + kk) * N + nc] : 0.f; }
    asm volatile("s_waitcnt lgkmcnt(0)" ::: "memory");
    const int c = lane & 7;
#pragma unroll
    for (int j = 0; j < 4; ++j) { const int n = (lane >> 3) + 8 * j; const LAS float* s = scr + (8 * c) * 33 + n;
        u32x4 o; o.x = pk2(s[0 * 33], s[1 * 33]); o.y = pk2(s[2 * 33], s[3 * 33]); o.z = pk2(s[4 * 33], s[5 * 33]); o.w = pk2(s[6 * 33], s[7 * 33]);
        *(u32x4*)(WT + (size_t)(n0 + n) * K + k0 + 8 * c) = o; }
    asm volatile("s_waitcnt lgkmcnt(0)" ::: "memory");
}
__device__ __forceinline__ void convert_matrix(const float* W, int K, int N, int Npad, bf16_t* WT, LAS float* scr, int gw, int NGW, int lane) {
    const int nblk = Npad / 32, nitems = (K / 64) * nblk;
    for (int it = gw; it < nitems; it += NGW) transpose_item(W, K, N, WT, scr, it, nblk, lane);
}

__device__ __forceinline__ void norm_mod_phase(const float* xin, const float* g, const float* modl, int sh_off, int sc_off, bf16_t* XN, int gw, int NGW, int lane) {
    for (int row = gw; row < MTOK; row += NGW) {
        const int b = row >> 12;
        const f32x4* xr = (const f32x4*)(xin + (size_t)row * DM) + lane;
        f32x4 v[8]; float ss = 0.f;
#pragma unroll
        for (int j = 0; j < 8; ++j) { v[j] = xr[64 * j]; ss += (v[j].x * v[j].x + v[j].y * v[j].y) + (v[j].z * v[j].z + v[j].w * v[j].w); }
        ss = wave_sum(ss);
        const float r = rsqrtf(ss * (1.f / DM) + EPS);
        const float* mb = modl + (size_t)b * 12288;
#pragma unroll
        for (int j = 0; j < 8; ++j) { const int col = 4 * (64 * j + lane);
            const f32x4 g4 = *(const f32x4*)(g + col), sc = *(const f32x4*)(mb + sc_off + col), sh = *(const f32x4*)(mb + sh_off + col);
            const f32x4 y = v[j] * r * g4; const f32x4 h = y * (sc + 1.f) + sh;
            u32x2 w; w.x = pk2(h.x, h.y); w.y = pk2(h.z, h.w);
            *(u32x2*)(XN + (size_t)row * DM + col) = w; }
    }
}

__device__ __forceinline__ void conv_gate_phase(const bf16_t* U, const float* cw, const float* cb, bf16_t* Gout, int G, int tid) {
    for (int item = blockIdx.x * 512 + tid; item < 1024 * 704; item += G * 512) {
        const int cg8 = item % 704, run = item / 704; const int row0 = run * 16, c0 = cg8 * 8; const bool first = (row0 & 4095) == 0;
        float wg[3][8], wv[3][8], bg[8], bv[8];
#pragma unroll
        for (int j = 0; j < 3; ++j) {
            const f32x4 a0 = *(const f32x4*)(cw + j * DFF2 + c0), a1 = *(const f32x4*)(cw + j * DFF2 + c0 + 4);
            const f32x4 b0 = *(const f32x4*)(cw + j * DFF2 + DFF + c0), b1 = *(const f32x4*)(cw + j * DFF2 + DFF + c0 + 4);
#pragma unroll
            for (int e = 0; e < 4; ++e) { wg[j][e] = a0[e]; wg[j][4 + e] = a1[e]; wv[j][e] = b0[e]; wv[j][4 + e] = b1[e]; }
        }
        { const f32x4 a0 = *(const f32x4*)(cb + c0), a1 = *(const f32x4*)(cb + c0 + 4), b0 = *(const f32x4*)(cb + DFF + c0), b1 = *(const f32x4*)(cb + DFF + c0 + 4);
#pragma unroll
          for (int e = 0; e < 4; ++e) { bg[e] = a0[e]; bg[4 + e] = a1[e]; bv[e] = b0[e]; bv[4 + e] = b1[e]; } }
        float g2[8], g1[8], v2[8], v1[8];
#pragma unroll
        for (int e = 0; e < 8; ++e) { g2[e] = 0.f; g1[e] = 0.f; v2[e] = 0.f; v1[e] = 0.f; }
        if (!first) {
            const u32x4 a = *(const u32x4*)(U + (size_t)(row0 - 2) * DFF2 + c0), b = *(const u32x4*)(U + (size_t)(row0 - 2) * DFF2 + DFF + c0);
            const u32x4 c = *(const u32x4*)(U + (size_t)(row0 - 1) * DFF2 + c0), d = *(const u32x4*)(U + (size_t)(row0 - 1) * DFF2 + DFF + c0);
#pragma unroll
            for (int e = 0; e < 4; ++e) { g2[2 * e] = bflo(a[e]); g2[2 * e + 1] = bfhi(a[e]); v2[2 * e] = bflo(b[e]); v2[2 * e + 1] = bfhi(b[e]);
                                          g1[2 * e] = bflo(c[e]); g1[2 * e + 1] = bfhi(c[e]); v1[2 * e] = bflo(d[e]); v1[2 * e + 1] = bfhi(d[e]); }
        }
#pragma unroll 4
        for (int t = 0; t < 16; ++t) {
            const u32x4 a = *(const u32x4*)(U + (size_t)(row0 + t) * DFF2 + c0), b = *(const u32x4*)(U + (size_t)(row0 + t) * DFF2 + DFF + c0);
            float gc[8], vc[8], r[8];
#pragma unroll
            for (int e = 0; e < 4; ++e) { gc[2 * e] = bflo(a[e]); gc[2 * e + 1] = bfhi(a[e]); vc[2 * e] = bflo(b[e]); vc[2 * e + 1] = bfhi(b[e]); }
#pragma unroll
            for (int e = 0; e < 8; ++e) {
                const float gg = wg[0][e] * g2[e] + wg[1][e] * g1[e] + wg[2][e] * gc[e] + bg[e];
                const float vv = wv[0][e] * v2[e] + wv[1][e] * v1[e] + wv[2][e] * vc[e] + bv[e];
                r[e] = gg / (1.f + __expf(-gg)) * vv;
                g2[e] = g1[e]; g1[e] = gc[e]; v2[e] = v1[e]; v1[e] = vc[e];
            }
            u32x4 o; o.x = pk2(r[0], r[1]); o.y = pk2(r[2], r[3]); o.z = pk2(r[4], r[5]); o.w = pk2(r[6], r[7]);
            *(u32x4*)(Gout + (size_t)(row0 + t) * DFF + c0) = o;
        }
    }
}

__global__ void __launch_bounds__(512, 2) mega_fwd(Args a) {
    extern __shared__ __attribute__((aligned(16))) unsigned char lds[];
    cg::grid_group grid = cg::this_grid();
    LAS unsigned char* L = (LAS unsigned char*)lds;
    const int G = gridDim.x, NGW = G * 8;
    unsigned* bar_ctr = (unsigned*)(a.ws + 458752); unsigned bar_target = 0u;
#define GSYNC() do { __builtin_amdgcn_fence(__ATOMIC_RELEASE, "agent"); asm volatile("s_waitcnt vmcnt(0) lgkmcnt(0)" ::: "memory"); __syncthreads(); bar_target += (unsigned)G; \
        if (threadIdx.x == 0) { __hip_atomic_fetch_add(bar_ctr, 1u, __ATOMIC_RELEASE, __HIP_MEMORY_SCOPE_AGENT); \
            while (__hip_atomic_load(bar_ctr, __ATOMIC_ACQUIRE, __HIP_MEMORY_SCOPE_AGENT) < bar_target) __builtin_amdgcn_s_sleep(2); } \
        __syncthreads(); __builtin_amdgcn_fence(__ATOMIC_ACQUIRE, "agent"); asm volatile("s_waitcnt vmcnt(0)" ::: "memory"); } while (0)
#define IDS int tid = threadIdx.x; asm volatile("" : "+v"(tid)); const int lane = tid & 63, wave = __builtin_amdgcn_readfirstlane(tid >> 6), fr = lane & 15, fq = lane >> 4; const int gw = blockIdx.x * 8 + wave; (void)fr; (void)fq; (void)gw; (void)lane; \
            LAS float* scr = (LAS float*)(L + 65536 + wave * 8448); (void)scr;
    unsigned char* ws = a.ws;
    float* MOD = (float*)(ws + WS_MOD);
    bf16_t* WUKT = (bf16_t*)(ws + WS_WUKT); bf16_t* WUVT = (bf16_t*)(ws + WS_WUVT);
    bf16_t* WIN = (bf16_t*)(ws + WS_WIN); bf16_t* WOUT = (bf16_t*)(ws + WS_WOUT); bf16_t* WUP = (bf16_t*)(ws + WS_WUP); bf16_t* WDN = (bf16_t*)(ws + WS_WDN);
    bf16_t* XN = (bf16_t*)(ws + WS_XN); bf16_t* PROJ = (bf16_t*)(ws + WS_BIG); bf16_t* UB = (bf16_t*)(ws + WS_BIG); bf16_t* QLAT = (bf16_t*)(ws + WS_QLAT);
    bf16_t* GB = (bf16_t*)(ws + WS_G); bf16_t* ATT = (bf16_t*)(ws + WS_ATT); bf16_t* CKV = (bf16_t*)(ws + WS_CKV);
    int* IDX = (int*)(ws + WS_IDX); int* CNT = (int*)(ws + WS_CNT);
    const float* x_in = a.in[0]; const float* rel_bias = a.in[2];
    float* xres = a.out;

    grid.sync();
    {
        IDS
        LAS float* cs = (LAS float*)L; LAS float* red = cs + 8192;
        for (int it = blockIdx.x; it < 192; it += G) {
            const int i = it / 96, jc = it % 96;
            for (int idx = tid; idx < 8192; idx += 512) { const float v = a.in[1][idx]; cs[idx] = v / (1.f + expf(-v)); }
            __syncthreads();
            const int cq = tid & 31, kg = tid >> 5;
            const float* w = a.in[3] + (size_t)i * 2048 * 12288 + jc * 128 + cq * 4;
            f32x4 ac[4];
#pragma unroll
            for (int b = 0; b < 4; ++b) ac[b] = (f32x4){0.f, 0.f, 0.f, 0.f};
#pragma unroll 4
            for (int kk = 0; kk < 128; ++kk) { const int k = kg * 128 + kk; const f32x4 wv = *(const f32x4*)(w + (size_t)k * 12288);
#pragma unroll
                for (int b = 0; b < 4; ++b) ac[b] += wv * cs[b * 2048 + k]; }
#pragma unroll
            for (int b = 0; b < 4; ++b) *(LAS f32x4*)(red + (kg * 4 + b) * 128 + cq * 4) = ac[b];
            __syncthreads();
            { const int b = tid >> 7, col = tid & 127; float s = a.in[4][i * 12288 + jc * 128 + col];
#pragma unroll
              for (int k2 = 0; k2 < 16; ++k2) s += red[(k2 * 4 + b) * 128 + col];
              MOD[(size_t)(i * 4 + b) * 12288 + jc * 128 + col] = s; }
            __syncthreads();
        }
        convert_matrix(a.in[7], 2048, EV_IN, EV_PITCH, WIN, scr, gw, NGW, lane);
        convert_matrix(a.in[12], 2048, 2048, 2048, WOUT, scr, gw, NGW, lane);
        convert_matrix(a.in[15], 2048, DFF2, DFF2, WUP, scr, gw, NGW, lane);
        convert_matrix(a.in[18], DFF, 2048, 2048, WDN, scr, gw, NGW, lane);
        for (int h = 0; h < 16; ++h) {
            convert_matrix(a.in[9] + (size_t)h * 64 * 256, 64, 256, 256, WUKT + (size_t)h * 256 * 64, scr, gw, NGW, lane);
            convert_matrix(a.in[10] + (size_t)h * 256 * 64, 256, 64, 64, WUVT + (size_t)h * 64 * 256, scr, gw, NGW, lane);
        }
    }
    GSYNC();

#pragma unroll
    for (int layer = 0; layer < 2; ++layer) {
        const float* modl = MOD + (size_t)layer * 4 * 12288;
        const float* xcur = (layer == 0) ? x_in : (const float*)xres;
        { IDS
        norm_mod_phase(xcur, a.in[5] + layer * DM, modl, 0, 2048, XN, gw, NGW, lane);
        if (layer == 1) {
            convert_matrix(a.in[13], 2048, OD_PITCH, OD_PITCH, WIN, scr, gw, NGW, lane);
            convert_matrix(a.in[14], 2048, 2048, 2048, WOUT, scr, gw, NGW, lane);
            convert_matrix(a.in[15] + (size_t)2048 * DFF2, 2048, DFF2, DFF2, WUP, scr, gw, NGW, lane);
            convert_matrix(a.in[18] + (size_t)DFF * 2048, DFF, 2048, 2048, WDN, scr, gw, NGW, lane);
        } }
        GSYNC();
#if SKIP_SWA || SKIP_DSA || SKIP_SB
        { IDS for (size_t i = (size_t)blockIdx.x * 512 + tid; i < (size_t)MTOK * DM / 8; i += (size_t)G * 512) ((u32x4*)ATT)[i] = (u32x4){0u, 0u, 0u, 0u}; }
#endif
        if (layer == 0) {
            { pg8::Gemm g{XN, WIN, MTOK, EV_PITCH, 2048}; pg8::StaticOrder S; S.init(MTOK, EV_PITCH, G, (int)blockIdx.x);
              pg8::EpiBf16 E{PROJ, EV_PITCH};
              pg8::gemm_phase<pg8::EpiBf16, pg8::StaticOrder, true, true>(L, g, S, E); }
            GSYNC();
            { IDS
            for (int row = gw; row < MTOK; row += NGW) {
                const u32x2 w = *(const u32x2*)(PROJ + (size_t)row * EV_PITCH + C_CLAT + 4 * lane);
                const float x0 = bflo(w.x), x1 = bfhi(w.x), x2 = bflo(w.y), x3 = bfhi(w.y);
                const float ss = wave_sum((x0 * x0 + x1 * x1) + (x2 * x2 + x3 * x3));
                const float r = rsqrtf(ss * (1.f / 256.f) + EPS);
                const f32x4 g4 = *(const f32x4*)(a.in[8] + 4 * lane);
                u32x2 o; o.x = pk2(x0 * r * g4.x, x1 * r * g4.y); o.y = pk2(x2 * r * g4.z, x3 * r * g4.w);
                *(u32x2*)(CKV + (size_t)row * 256 + 4 * lane) = o;
            } }
            { IDS
            for (int unit = gw; unit < 16384; unit += NGW) {
                const int h = unit & 15, t0 = (unit >> 4) * 16;
                bf16x8 bq[2];
#pragma unroll
                for (int ks = 0; ks < 2; ++ks) bq[ks] = *(const bf16x8*)(PROJ + (size_t)(t0 + fr) * EV_PITCH + C_QB + h * 64 + 32 * ks + 8 * fq);
#pragma unroll 4
                for (int rt = 0; rt < 16; ++rt) {
                    f32x4 acc = (f32x4){0.f, 0.f, 0.f, 0.f};
#pragma unroll
                    for (int ks = 0; ks < 2; ++ks) { const bf16x8 aw = *(const bf16x8*)(WUKT + (size_t)(h * 256 + 16 * rt + fr) * 64 + 32 * ks + 8 * fq); acc = MFMA16(aw, bq[ks], acc); }
                    u32x2 o; o.x = pk2(acc[0] * 0.125f, acc[1] * 0.125f); o.y = pk2(acc[2] * 0.125f, acc[3] * 0.125f);
                    *(u32x2*)(QLAT + ((size_t)(t0 + fr) * 16 + h) * 256 + 16 * rt + 4 * fq) = o;
                }
            } }
#if !SKIP_DSA
            { IDS
            for (int row = gw; row < MTOK; row += NGW) {
                const int b = row >> 12, tpos = row & 4095, c = tpos >> 6, nall = (c + 1) * 64;
                int* idxp = IDX + (size_t)row * 256;
                if (nall <= 256) { for (int i = lane; i < nall; i += 64) idxp[i] = i; if (lane == 0) CNT[row] = nall; continue; }
                const int nquads = c + 1;
                bf16x8 qa[2];
#pragma unroll
                for (int ks = 0; ks < 2; ++ks) qa[ks] = *(const bf16x8*)(PROJ + (size_t)row * EV_PITCH + C_QI + (fr & 7) * 64 + 32 * ks + 8 * fq);
                float wgt[4];
                { const u32x2 ww = *(const u32x2*)(PROJ + (size_t)row * EV_PITCH + C_WI + 4 * (fq & 1)); wgt[0] = bflo(ww.x); wgt[1] = bfhi(ww.x); wgt[2] = bflo(ww.y); wgt[3] = bfhi(ww.y); }
                const bf16_t* kbase = PROJ + ((size_t)b * SEQ + fr) * EV_PITCH + C_KI + 8 * fq;
                unsigned v[64];
#pragma unroll
                for (int q = 0; q < 64; ++q) {
                    unsigned val = 0u;
                    if (q < nquads) {
                        float keep = 0.f;
#pragma unroll
                        for (int tt = 0; tt < 4; ++tt) {
                            const bf16_t* kp = kbase + (size_t)(q * 64 + tt * 16) * EV_PITCH;
                            const bf16x8 b0 = *(const bf16x8*)kp, b1 = *(const bf16x8*)(kp + 32);
                            f32x4 acc = (f32x4){0.f, 0.f, 0.f, 0.f};
                            acc = MFMA16(qa[0], b0, acc); acc = MFMA16(qa[1], b1, acc);
                            float part = (wgt[0] * fmaxf(acc[0], 0.f) + wgt[1] * fmaxf(acc[1], 0.f)) + (wgt[2] * fmaxf(acc[2], 0.f) + wgt[3] * fmaxf(acc[3], 0.f));
                            part += __shfl_xor(part, 16);
                            keep = (fq == tt) ? part : keep;
                        }
                        unsigned u = __float_as_uint(keep); if (u == 0x80000000u) u = 0u;
                        val = (u & 0x80000000u) ? ~u : (u | 0x80000000u);
                    }
                    v[q] = val;
                }
                unsigned T = 0u;
                for (int bit = 31; bit >= 0; --bit) {
                    const unsigned cand = T | (1u << bit); int cnt = 0;
#pragma unroll
                    for (int q = 0; q < 64; ++q) cnt += (v[q] >= cand) ? 1 : 0;
                    cnt = wave_sum_i(cnt);
                    if (cnt >= 256) T = cand;
                }
                int cgt = 0;
#pragma unroll
                for (int q = 0; q < 64; ++q) cgt += (v[q] > T) ? 1 : 0;
                cgt = wave_sum_i(cgt);
                int need = 256 - cgt, pos = 0;
                const unsigned long long ltmask = (1ull << lane) - 1ull;
#pragma unroll
                for (int q = 0; q < 64; ++q) {
                    if (q < nquads) {
                        const bool gt = v[q] > T, eq = v[q] == T;
                        const unsigned long long meq = __ballot(eq);
                        const int eqrank = __popcll(meq & ltmask);
                        const bool sel = gt || (eq && eqrank < need);
                        const unsigned long long msel = __ballot(sel);
                        if (sel) idxp[pos + __popcll(msel & ltmask)] = q * 64 + lane;
                        pos += __popcll(msel);
                        const int neq = __popcll(meq); need -= (neq < need ? neq : need);
                    }
                }
                if (lane == 0) CNT[row] = 256;
            } }
#endif
#if !SKIP_SWA
            {
                IDS
                LAS bf16_t* Vt = (LAS bf16_t*)L;
                LAS float* bT = (LAS float*)(L + 64 * 200 * 2);
                __syncthreads();
                for (int unit = blockIdx.x; unit < 1024; unit += G) {
                    const int b = unit >> 8, c = (unit >> 2) & 63, kvh = unit & 3;
                    const int kstart = (c >= 2 ? c - 2 : 0) * 64, nk = (c + 1) * 64 - kstart;
                    const size_t rowbase = (size_t)b * SEQ;
                    for (int idx = tid; idx < 1024; idx += 512) { const int g = idx >> 8, ri = idx & 255; bT[idx] = rel_bias[t5_bucket(ri - 191) * 32 + kvh * 4 + g]; }
                    for (int i = tid; i < nk * 8; i += 512) { const int key = i >> 3, ch = i & 7;
                        const u32x4 w = *(const u32x4*)(PROJ + (rowbase + kstart + key) * EV_PITCH + C_VA + kvh * 64 + ch * 8);
                        LAS bf16_t* vp = Vt + (ch * 8) * 200 + key;
                        vp[0 * 200] = (bf16_t)(w.x & 0xffffu); vp[1 * 200] = (bf16_t)(w.x >> 16); vp[2 * 200] = (bf16_t)(w.y & 0xffffu); vp[3 * 200] = (bf16_t)(w.y >> 16);
                        vp[4 * 200] = (bf16_t)(w.z & 0xffffu); vp[5 * 200] = (bf16_t)(w.z >> 16); vp[6 * 200] = (bf16_t)(w.w & 0xffffu); vp[7 * 200] = (bf16_t)(w.w >> 16); }
                    __syncthreads();
                    const int g = wave >> 1, qh = wave & 1, head = kvh * 4 + g, q0 = c * 64 + qh * 32;
                    const int ntile = nk >> 4;
                    bf16x8 bq[2][2];
#pragma unroll
                    for (int m = 0; m < 2; ++m)
#pragma unroll
                        for (int ks = 0; ks < 2; ++ks) bq[m][ks] = *(const bf16x8*)(PROJ + (rowbase + q0 + 16 * m + fr) * EV_PITCH + C_QA + head * 64 + 32 * ks + 8 * fq);
                    f32x4 s[12][2];
#pragma unroll
                    for (int t = 0; t < 12; ++t) {
                        if (t < ntile) {
                            const bf16_t* kp = PROJ + (rowbase + kstart + 16 * t + fr) * EV_PITCH + C_KA + kvh * 64 + 8 * fq;
                            const bf16x8 k0 = *(const bf16x8*)kp, k1 = *(const bf16x8*)(kp + 32);
#pragma unroll
                            for (int m = 0; m < 2; ++m) { f32x4 acc = (f32x4){0.f, 0.f, 0.f, 0.f}; acc = MFMA16(k0, bq[m][0], acc); acc = MFMA16(k1, bq[m][1], acc); s[t][m] = acc; }
                        } else { s[t][0] = (f32x4){0.f, 0.f, 0.f, 0.f}; s[t][1] = (f32x4){0.f, 0.f, 0.f, 0.f}; }
                    }
                    const float sink = a.in[11][head];
                    float inv[2];
#pragma unroll
                    for (int m = 0; m < 2; ++m) {
                        const int qpos = q0 + 16 * m + fr;
                        float mx = -1e30f;
#pragma unroll
                        for (int t = 0; t < 12; ++t)
                            if (t < ntile) {
#pragma unroll
                                for (int j = 0; j < 4; ++j) { const int ri = (kstart + 16 * t + 4 * fq + j) - qpos + 191; const float vv = s[t][m][j] * 0.125f + bT[g * 256 + ri]; s[t][m][j] = vv; mx = fmaxf(mx, vv); }
                            }
                        mx = fmaxf(mx, __shfl_xor(mx, 16)); mx = fmaxf(mx, __shfl_xor(mx, 32)); mx = fmaxf(mx, sink);
                        float sum = 0.f;
#pragma unroll
                        for (int t = 0; t < 12; ++t)
                            if (t < ntile) {
#pragma unroll
                                for (int j = 0; j < 4; ++j) { const float p = __expf(s[t][m][j] - mx); s[t][m][j] = p; sum += p; }
                            }
                        sum += __shfl_xor(sum, 16); sum += __shfl_xor(sum, 32);
                        inv[m] = 1.f / (sum + __expf(sink - mx));
                    }
                    f32x4 o[4][2];
#pragma unroll
                    for (int dt = 0; dt < 4; ++dt) { o[dt][0] = (f32x4){0.f, 0.f, 0.f, 0.f}; o[dt][1] = (f32x4){0.f, 0.f, 0.f, 0.f}; }
#pragma unroll
                    for (int st = 0; st < 6; ++st) {
                        if (2 * st < ntile) {
                            bf16x8 pb[2];
#pragma unroll
                            for (int m = 0; m < 2; ++m) pb[m] = mk8(pk2(s[2 * st][m][0], s[2 * st][m][1]), pk2(s[2 * st][m][2], s[2 * st][m][3]), pk2(s[2 * st + 1][m][0], s[2 * st + 1][m][1]), pk2(s[2 * st + 1][m][2], s[2 * st + 1][m][3]));
#pragma unroll
                            for (int dt = 0; dt < 4; ++dt) {
                                const LAS bf16_t* vp = Vt + (16 * dt + fr) * 200 + 32 * st + 4 * fq;
                                const u32x2 lo = *(const LAS u32x2*)vp, hi = *(const LAS u32x2*)(vp + 16);
                                const bf16x8 av = mk8(lo.x, lo.y, hi.x, hi.y);
                                o[dt][0] = MFMA16(av, pb[0], o[dt][0]); o[dt][1] = MFMA16(av, pb[1], o[dt][1]);
                            }
                        }
                    }
#pragma unroll
                    for (int m = 0; m < 2; ++m)
#pragma unroll
                        for (int dt = 0; dt < 4; ++dt) { u32x2 w; w.x = pk2(o[dt][m][0] * inv[m], o[dt][m][1] * inv[m]); w.y = pk2(o[dt][m][2] * inv[m], o[dt][m][3] * inv[m]);
                            *(u32x2*)(ATT + (rowbase + q0 + 16 * m + fr) * DM + head * 64 + 16 * dt + 4 * fq) = w; }
                    __syncthreads();
                }
            }
#endif
            GSYNC();
#if !SKIP_DSA
            {
                IDS
                LAS float* bB = (LAS float*)(L + 8 * 16896);
                if (tid < 512) bB[tid] = rel_bias[(tid >> 4) * 32 + 16 + (tid & 15)];
                __syncthreads();
                LAS bf16_t* cb = (LAS bf16_t*)(L + wave * 16896);
                for (int row = gw; row < MTOK; row += NGW) {
                    const int b = row >> 12, tpos = row & 4095; const size_t rowbase = (size_t)b * SEQ;
                    const int cnt = __builtin_amdgcn_readfirstlane(CNT[row]); const int nch = cnt >> 5;
                    bf16x8 ql[8];
#pragma unroll
                    for (int ks = 0; ks < 8; ++ks) ql[ks] = *(const bf16x8*)(QLAT + ((size_t)row * 16 + fr) * 256 + 32 * ks + 8 * fq);
                    f32x4 o[16];
#pragma unroll
                    for (int rt = 0; rt < 16; ++rt) o[rt] = (f32x4){0.f, 0.f, 0.f, 0.f};
                    float mrun = -1e30f, lpart = 0.f;
                    for (int ch = 0; ch < nch; ++ch) {
                        const int myidx = IDX[(size_t)row * 256 + 32 * ch + (lane & 31)];
#pragma unroll
                        for (int it = 0; it < 16; ++it) { const int key = 2 * it + (lane >> 5), seg = lane & 31; const int kidx = __shfl(myidx, key);
                            const u32x4 w = *(const u32x4*)(CKV + (rowbase + kidx) * 256 + seg * 8); *(LAS u32x4*)(cb + key * 264 + seg * 8) = w; }
                        asm volatile("s_waitcnt lgkmcnt(0)" ::: "memory");
                        f32x4 sa[2];
#pragma unroll
                        for (int kt = 0; kt < 2; ++kt) { f32x4 acc = (f32x4){0.f, 0.f, 0.f, 0.f};
#pragma unroll
                            for (int ks = 0; ks < 8; ++ks) { const bf16x8 ac = *(const LAS bf16x8*)(cb + (16 * kt + fr) * 264 + 32 * ks + 8 * fq); acc = MFMA16(ac, ql[ks], acc); }
                            sa[kt] = acc; }
                        float cm = -1e30f;
#pragma unroll
                        for (int kt = 0; kt < 2; ++kt)
#pragma unroll
                            for (int j = 0; j < 4; ++j) { const int kidx = __shfl(myidx, 16 * kt + 4 * fq + j); const float vv = sa[kt][j] + bB[t5_bucket(kidx - tpos) * 16 + fr]; sa[kt][j] = vv; cm = fmaxf(cm, vv); }
                        cm = fmaxf(cm, __shfl_xor(cm, 16)); cm = fmaxf(cm, __shfl_xor(cm, 32));
                        const float mnew = fmaxf(mrun, cm), alpha = __expf(mrun - mnew); mrun = mnew;
                        float ps = 0.f;
#pragma unroll
                        for (int kt = 0; kt < 2; ++kt)
#pragma unroll
                            for (int j = 0; j < 4; ++j) { const float p = __expf(sa[kt][j] - mnew); sa[kt][j] = p; ps += p; }
                        lpart = lpart * alpha + ps;
#pragma unroll
                        for (int rt = 0; rt < 16; ++rt) o[rt] *= alpha;
                        const bf16x8 pb = mk8(pk2(sa[0][0], sa[0][1]), pk2(sa[0][2], sa[0][3]), pk2(sa[1][0], sa[1][1]), pk2(sa[1][2], sa[1][3]));
#pragma unroll
                        for (int rt = 0; rt < 16; ++rt) {
                            const LAS bf16_t* cp = cb + (4 * fq) * 264 + 16 * rt + fr;
                            const unsigned e0 = cp[0], e1 = cp[264], e2 = cp[2 * 264], e3 = cp[3 * 264], e4 = cp[16 * 264], e5 = cp[17 * 264], e6 = cp[18 * 264], e7 = cp[19 * 264];
                            const bf16x8 av = mk8(e0 | (e1 << 16), e2 | (e3 << 16), e4 | (e5 << 16), e6 | (e7 << 16));
                            o[rt] = MFMA16(av, pb, o[rt]);
                        }
                        asm volatile("s_waitcnt lgkmcnt(0)" ::: "memory");
                    }
                    float l = lpart + __shfl_xor(lpart, 16); l += __shfl_xor(l, 32);
                    const float inv = 1.f / l;
#pragma unroll
                    for (int rt = 0; rt < 16; ++rt) { u32x2 w; w.x = pk2(o[rt][0] * inv, o[rt][1] * inv); w.y = pk2(o[rt][2] * inv, o[rt][3] * inv);
                        *(u32x2*)(QLAT + ((size_t)row * 16 + fr) * 256 + 16 * rt + 4 * fq) = w; }
                }
            }
#endif
            GSYNC();
#if !SKIP_DSA
            { IDS
            for (int unit = gw; unit < 16384; unit += NGW) {
                const int h = unit & 15, t0 = (unit >> 4) * 16;
                bf16x8 bo[8];
#pragma unroll
                for (int ks = 0; ks < 8; ++ks) bo[ks] = *(const bf16x8*)(QLAT + ((size_t)(t0 + fr) * 16 + h) * 256 + 32 * ks + 8 * fq);
#pragma unroll
                for (int dt = 0; dt < 4; ++dt) {
                    f32x4 acc = (f32x4){0.f, 0.f, 0.f, 0.f};
#pragma unroll
                    for (int ks = 0; ks < 8; ++ks) { const bf16x8 aw = *(const bf16x8*)(WUVT + (size_t)(h * 64 + 16 * dt + fr) * 256 + 32 * ks + 8 * fq); acc = MFMA16(aw, bo[ks], acc); }
                    u32x2 w; w.x = pk2(acc[0], acc[1]); w.y = pk2(acc[2], acc[3]);
                    *(u32x2*)(ATT + (size_t)(t0 + fr) * DM + 1024 + h * 64 + 16 * dt + 4 * fq) = w;
                }
            } }
#endif
            GSYNC();
        } else {
            { pg8::Gemm g{XN, WIN, MTOK, OD_PITCH, 2048}; pg8::StaticOrder S; S.init(MTOK, OD_PITCH, G, (int)blockIdx.x);
              pg8::EpiBf16 E{PROJ, OD_PITCH};
              pg8::gemm_phase<pg8::EpiBf16, pg8::StaticOrder, true, true>(L, g, S, E); }
            GSYNC();
#if SKIP_SB == 2
            { IDS for (size_t i = (size_t)blockIdx.x * 512 + tid; i < (size_t)MTOK * 256; i += (size_t)G * 512) { const size_t row = i >> 8, c8 = i & 255; ((u32x4*)ATT)[i] = *(const u32x4*)(PROJ + row * OD_PITCH + 4096 + c8 * 8); } }
#endif
#if !SKIP_SB
            {
                IDS
                LAS bf16_t* vb = (LAS bf16_t*)(L + wave * 8704);
                for (int unit = gw; unit < 8192; unit += NGW) {
                    const int qt = 127 - (unit >> 6), h = unit & 15, b = (unit >> 4) & 3; const int q0 = qt * 32; const size_t rowbase = (size_t)b * SEQ;
                    bf16x8 bq[2][4];
#pragma unroll
                    for (int m = 0; m < 2; ++m)
#pragma unroll
                        for (int ks = 0; ks < 4; ++ks) bq[m][ks] = *(const bf16x8*)(PROJ + (rowbase + q0 + 16 * m + fr) * OD_PITCH + h * 128 + 32 * ks + 8 * fq);
                    f32x4 o[8][2];
#pragma unroll
                    for (int dt = 0; dt < 8; ++dt) { o[dt][0] = (f32x4){0.f, 0.f, 0.f, 0.f}; o[dt][1] = (f32x4){0.f, 0.f, 0.f, 0.f}; }
                    float Lc[2] = {0.f, 0.f};
                    for (int kb = qt; kb >= 0; --kb) {
#pragma unroll
                        for (int it = 0; it < 8; ++it) { const int key = 4 * it + (lane >> 4), seg = lane & 15;
                            const u32x4 w = *(const u32x4*)(PROJ + (rowbase + 32 * kb + key) * OD_PITCH + 4096 + h * 128 + seg * 8); *(LAS u32x4*)(vb + key * 136 + seg * 8) = w; }
                        asm volatile("s_waitcnt lgkmcnt(0)" ::: "memory");
                        f32x4 z[2][2];
#pragma unroll
                        for (int kt = 0; kt < 2; ++kt) {
                            const bf16_t* kp = PROJ + (rowbase + 32 * kb + 16 * kt + fr) * OD_PITCH + 2048 + h * 128 + 8 * fq;
                            bf16x8 ak[4];
#pragma unroll
                            for (int ks = 0; ks < 4; ++ks) ak[ks] = *(const bf16x8*)(kp + 32 * ks);
#pragma unroll
                            for (int m = 0; m < 2; ++m) { f32x4 acc = (f32x4){0.f, 0.f, 0.f, 0.f};
#pragma unroll
                                for (int ks = 0; ks < 4; ++ks) acc = MFMA16(ak[ks], bq[m][ks], acc);
                                z[kt][m] = acc; }
                        }
                        const bool diag = (kb == qt);
                        bf16x8 pb[2];
#pragma unroll
                        for (int m = 0; m < 2; ++m) {
                            float lk[2][4], ls[2][4]; bool er[2][4];
#pragma unroll
                            for (int kt = 0; kt < 2; ++kt)
#pragma unroll
                                for (int j = 0; j < 4; ++j) { const float zz = z[kt][m][j] * 0.08838834764831845f; const float sp = fmaxf(zz, 0.f) + __logf(1.f + __expf(-fabsf(zz)));
                                    const bool e = !diag || (16 * kt + 4 * fq + j < 16 * m + fr); er[kt][j] = e; lk[kt][j] = e ? -sp : 0.f; ls[kt][j] = zz - sp; }
                            const float g0 = (lk[0][0] + lk[0][1]) + (lk[0][2] + lk[0][3]), g1 = (lk[1][0] + lk[1][1]) + (lk[1][2] + lk[1][3]);
                            float g0a[4], g1a[4];
#pragma unroll
                            for (int f = 0; f < 4; ++f) { g0a[f] = __shfl(g0, fr + 16 * f); g1a[f] = __shfl(g1, fr + 16 * f); }
                            const float tot0 = (g0a[0] + g0a[1]) + (g0a[2] + g0a[3]), tot1 = (g1a[0] + g1a[1]) + (g1a[2] + g1a[3]);
                            const float aft1 = (fq < 1 ? g1a[1] : 0.f) + (fq < 2 ? g1a[2] : 0.f) + (fq < 3 ? g1a[3] : 0.f);
                            const float aft0 = (fq < 1 ? g0a[1] : 0.f) + (fq < 2 ? g0a[2] : 0.f) + (fq < 3 ? g0a[3] : 0.f) + tot1;
                            float av[2][4];
#pragma unroll
                            for (int kt = 0; kt < 2; ++kt) { float suf = Lc[m] + (kt == 0 ? aft0 : aft1);
#pragma unroll
                                for (int j = 3; j >= 0; --j) { av[kt][j] = er[kt][j] ? __expf(ls[kt][j] + suf) : 0.f; suf += lk[kt][j]; } }
                            Lc[m] += tot0 + tot1;
                            pb[m] = mk8(pk2(av[0][0], av[0][1]), pk2(av[0][2], av[0][3]), pk2(av[1][0], av[1][1]), pk2(av[1][2], av[1][3]));
                        }
#pragma unroll
                        for (int dt = 0; dt < 8; ++dt) {
                            const LAS bf16_t* cp = vb + (4 * fq) * 136 + 16 * dt + fr;
                            const unsigned e0 = cp[0], e1 = cp[136], e2 = cp[2 * 136], e3 = cp[3 * 136], e4 = cp[16 * 136], e5 = cp[17 * 136], e6 = cp[18 * 136], e7 = cp[19 * 136];
                            const bf16x8 vv = mk8(e0 | (e1 << 16), e2 | (e3 << 16), e4 | (e5 << 16), e6 | (e7 << 16));
                            o[dt][0] = MFMA16(vv, pb[0], o[dt][0]); o[dt][1] = MFMA16(vv, pb[1], o[dt][1]);
                        }
                        asm volatile("s_waitcnt lgkmcnt(0)" ::: "memory");
                        if (__all(Lc[0] <= -104.f && Lc[1] <= -104.f)) break;
                    }
#pragma unroll
                    for (int m = 0; m < 2; ++m)
#pragma unroll
                        for (int dt = 0; dt < 8; ++dt) { u32x2 w; w.x = pk2(o[dt][m][0], o[dt][m][1]); w.y = pk2(o[dt][m][2], o[dt][m][3]);
                            *(u32x2*)(ATT + (rowbase + q0 + 16 * m + fr) * DM + h * 128 + 16 * dt + 4 * fq) = w; }
                }
            }
#endif
            GSYNC();
        }
        { pg8::Gemm g{ATT, WOUT, MTOK, 2048, 2048}; pg8::StaticOrder S; S.init(MTOK, 2048, G, (int)blockIdx.x);
          pg8::EpiResid E{xcur, xres, modl + 4096};
          pg8::gemm_phase<pg8::EpiResid, pg8::StaticOrder, true, true>(L, g, S, E); }
        GSYNC();
        { IDS norm_mod_phase(xres, a.in[6] + layer * DM, modl, 3 * 2048, 4 * 2048, XN, gw, NGW, lane); }
        GSYNC();
        { pg8::Gemm g{XN, WUP, MTOK, DFF2, 2048}; pg8::StaticOrder S; S.init(MTOK, DFF2, G, (int)blockIdx.x);
          pg8::EpiBf16 E{UB, DFF2};
          pg8::gemm_phase<pg8::EpiBf16, pg8::StaticOrder, true, true>(L, g, S, E); }
        GSYNC();
        { IDS conv_gate_phase(UB, a.in[16] + (size_t)layer * 3 * DFF2, a.in[17] + (size_t)layer * DFF2, GB, G, tid); }
        GSYNC();
        { pg8::Gemm g{GB, WDN, MTOK, 2048, DFF}; pg8::StaticOrder S; S.init(MTOK, 2048, G, (int)blockIdx.x);
          pg8::EpiResid E{xres, xres, modl + 5 * 2048};
          pg8::gemm_phase<pg8::EpiResid, pg8::StaticOrder, true, true>(L, g, S, E); }
        GSYNC();
    }
    { IDS
    for (int row = gw; row < MTOK; row += NGW) {
        f32x4* xr = (f32x4*)(xres + (size_t)row * DM) + lane;
        f32x4 v[8]; float ss = 0.f;
#pragma unroll
        for (int j = 0; j < 8; ++j) { v[j] = xr[64 * j]; ss += (v[j].x * v[j].x + v[j].y * v[j].y) + (v[j].z * v[j].z + v[j].w * v[j].w); }
        ss = wave_sum(ss);
        const float r = rsqrtf(ss * (1.f / DM) + EPS);
#pragma unroll
        for (int j = 0; j < 8; ++j) { const f32x4 g4 = *(const f32x4*)(a.in[19] + 4 * (64 * j + lane)); xr[64 * j] = v[j] * r * g4; }
    } }
}

extern "C" void kernel_launch(void* const* d_in, const int* in_sizes, int n_in, void* d_out, int out_size, void* d_ws, size_t ws_size, hipStream_t stream) {
    static int grid = 0;
    if (grid == 0) {
        if (n_in != 20 || out_size != MTOK * DM || ws_size < WS_END) { fprintf(stderr, "kernel_launch: unexpected shapes (n_in %d, out %d, ws %zu)\n", n_in, out_size, ws_size); grid = -1; return; }
        int dev = 0, cus = 0, per_cu = 0;
        hipGetDevice(&dev); hipDeviceGetAttribute(&cus, hipDeviceAttributeMultiprocessorCount, dev);
        if (hipFuncSetAttribute((const void*)mega_fwd, hipFuncAttributeMaxDynamicSharedMemorySize, LDS_BYTES) != hipSuccess) { fprintf(stderr, "kernel_launch: hipFuncSetAttribute failed\n"); grid = -1; return; }
        if (hipOccupancyMaxActiveBlocksPerMultiprocessor(&per_cu, (const void*)mega_fwd, 512, LDS_BYTES) != hipSuccess || per_cu < 1) per_cu = 1;
        (void)hipGetLastError();
        grid = cus * (per_cu > 1 ? 1 : per_cu);
    }
    if (grid < 0) return;
    if (hipMemsetAsync((char*)d_ws + 458752, 0, 256, stream) != hipSuccess) { fprintf(stderr, "memset failed\n"); return; }
    Args a{};
    for (int i = 0; i < 20; ++i) a.in[i] = (const float*)d_in[i];
    a.out = (float*)d_out; a.ws = (unsigned char*)d_ws;
    void* args[] = {&a};
    hipError_t e = hipLaunchCooperativeKernel((const void*)mega_fwd, dim3(grid), dim3(512), args, LDS_BYTES, stream);
    if (e != hipSuccess) fprintf(stderr, "cooperative launch failed: %s (grid %d)\n", hipGetErrorString(e), grid);
}
```

```cpp
#include <hip/hip_runtime.h>
#include <hip/hip_cooperative_groups.h>
#include <cstdio>
#include <cstdint>
namespace cg = cooperative_groups;

namespace pg8 {
#define PG8_LAS __attribute__((address_space(3)))
typedef unsigned short bf16_t;
typedef short bf16x8 __attribute__((ext_vector_type(8)));
typedef float f32x4 __attribute__((ext_vector_type(4)));
typedef unsigned u32x4 __attribute__((ext_vector_type(4)));
constexpr int BM = 256, BK = 64, HALF = 128, HTB = HALF * BK * 2  , STAGE_BYTES = 8 * HTB, NXCD = 8, WGM = 8;

__host__ __device__ __forceinline__ int lds_byte(int r, int c) { const int st = (r >> 4) * 2 + (c >> 5), rr = r & 15, cc = c & 31, ob = rr * 64 + cc * 2; return st * 1024 + (ob ^ (((ob >> 9) & 1) << 5)); }
__host__ __device__ __forceinline__ void stage_rc(int b, int& R, int& C) { const int st = b / 1024, sb = b % 1024, swz = sb ^ (((sb >> 9) & 1) << 5); R = (st >> 1) * 16 + swz / 64; C = (st & 1) * 32 + (swz % 64) / 2; }
__host__ __device__ __forceinline__ int perm32(int rho) { const int n = rho >> 4, i = rho & 15; return 8 * (i >> 2) + 4 * n + (i & 3); }

struct Unit { int pm, pn; };
struct Gemm { const bf16_t* A; const bf16_t* Bt; int M, N, K; };

struct StaticOrder {
    int nM, nN, nwg, G, c;
    __host__ __device__ void init(int M, int N, int G_, int c_) { nM = M / BM; nN = N / BM; nwg = nM * nN; G = G_; c = c_; }
    __host__ __device__ bool next(int i, Unit& u) const {
        const long L = (long)i * G + c; if (L >= nwg) return false;
        int wgid = (int)L; { const int q = nwg / NXCD, r = nwg % NXCD, xcd = wgid % NXCD, off = wgid / NXCD; wgid = (xcd < r ? xcd * (q + 1) : r * (q + 1) + (xcd - r) * q) + off; }
        const int nig = WGM * nN, gid = wgid / nig, fm = gid * WGM, gsz = (nM - fm) < WGM ? (nM - fm) : WGM;
        u.pm = fm + ((wgid % nig) % gsz); u.pn = (wgid % nig) / gsz; return true;
    }
    __device__ __forceinline__ void a_ready(const Unit&) const {}
    __device__ __forceinline__ void done(const Unit&) const {}
};

__device__ __forceinline__ unsigned cvt_pk_bf16(float lo, float hi) { unsigned r; asm volatile("v_cvt_pk_bf16_f32 %0, %1, %2" : "=v"(r) : "v"(lo), "v"(hi)); return r; }
typedef float f32x2 __attribute__((ext_vector_type(2)));
typedef unsigned u32x2v __attribute__((ext_vector_type(2)));
typedef float f32x2c __attribute__((ext_vector_type(2))); typedef __bf16 bf16x2c __attribute__((ext_vector_type(2)));
__device__ __forceinline__ unsigned pkb(float lo, float hi) { f32x2c v = {lo, hi}; bf16x2c b = __builtin_convertvector(v, bf16x2c); return __builtin_bit_cast(unsigned, b); }
struct EpiBf16 {
    static constexpr bool PERM = true, AFTER_DRAIN = false;
    bf16_t* O; int ldc;
    __device__ __forceinline__ void operator()(const f32x4 (&acc)[2][2][4][2], const Unit& u, int wr, int wc, int fr, int fq) const {
        const int row0 = u.pm * BM + wr * 64 + fr; const int col0 = u.pn * BM + wc * 32 + 8 * fq;
#pragma unroll
        for (int ai = 0; ai < 2; ++ai)
#pragma unroll
            for (int m = 0; m < 4; ++m) { bf16_t* rowp = O + (size_t)(row0 + ai * HALF + m * 16) * ldc + col0;
#pragma unroll
                for (int bj = 0; bj < 2; ++bj) { const f32x4 v0 = acc[ai][bj][m][0], v1 = acc[ai][bj][m][1];
                    u32x4 w; w.x = pkb(v0[0], v0[1]); w.y = pkb(v0[2], v0[3]); w.z = pkb(v1[0], v1[1]); w.w = pkb(v1[2], v1[3]);
                    *(u32x4*)(rowp + bj * HALF) = w; } }
    }
};
struct EpiResid {
    static constexpr bool PERM = false, AFTER_DRAIN = false;
    const float* base; float* out; const float* gate;
    __device__ __forceinline__ void operator()(const f32x4 (&acc)[2][2][4][2], const Unit& u, int wr, int wc, int fr, int fq) const {
        const int b = (u.pm * BM) >> 12; const int col0 = u.pn * BM + wc * 32 + 4 * fq; const float* gp = gate + (size_t)b * 12288 + col0;
#pragma unroll
        for (int bj = 0; bj < 2; ++bj)
#pragma unroll
            for (int n = 0; n < 2; ++n) { const f32x4 gv = *(const f32x4*)(gp + bj * HALF + n * 16);
#pragma unroll
                for (int ai = 0; ai < 2; ++ai)
#pragma unroll
                    for (int m = 0; m < 4; ++m) { const size_t off = (size_t)(u.pm * BM + ai * HALF + wr * 64 + m * 16 + fr) * 2048 + col0 + bj * HALF + n * 16;
                        const f32x4 bs = *(const f32x4*)(base + off); *(f32x4*)(out + off) = bs + gv * acc[ai][bj][m][n]; } }
    }
};
template <class Epi, class Sched, bool ALIGN_EPI = false, bool SP2 = false>
__device__ __forceinline__ void gemm_phase(PG8_LAS unsigned char* lds, const Gemm g, const Sched& S, const Epi& E) {
    int tid_o = threadIdx.x; asm volatile("" : "+v"(tid_o)); const int tid = tid_o, wid = __builtin_amdgcn_readfirstlane(tid >> 6), lane = tid & 63, wr = wid >> 2, wc = wid & 3, fr = lane & 15, fq = lane >> 4;
    const int K = g.K, nt = K / BK;
    unsigned voffA[2], voffB[2];
#pragma unroll
    for (int i = 0; i < 2; ++i) { int R, C; stage_rc(tid * 16 + i * 8192, R, C); const int Rb = Epi::PERM ? ((R & ~31) + perm32(R & 31)) : R;
        voffA[i] = (unsigned)(R * K + C) * 2u; voffB[i] = (unsigned)(Rb * K + C) * 2u; }
    const size_t kstep = (size_t)(BK * 2);
    const size_t hstep = (size_t)HALF * K * 2;
    const size_t tstep = 2 * hstep;
    const unsigned ldsw = (unsigned)wid * 1024u;
    const int aoff = lds_byte(wr * 64 + fr, fq * 8), boff = lds_byte(wc * 32 + fr, fq * 8);
#define PG8_SA(b, h) (((b) * 2 + (h)) * HTB)
#define PG8_SB(b, h) ((4 + (b) * 2 + (h)) * HTB)
#define PG8_STAGE(bufoff, gbase, voff) do { _Pragma("unroll") for (int _i = 0; _i < 2; ++_i) \
        __builtin_amdgcn_global_load_lds((const unsigned*)((const char*)(gbase) + (voff)[_i]), (PG8_LAS unsigned*)(lds + (bufoff) + ldsw + _i * 8192), 16, 0, 0); } while (0)
#define PG8_LDA(dst, b, h) do { _Pragma("unroll") for (int m = 0; m < 4; ++m) _Pragma("unroll") for (int k = 0; k < 2; ++k) dst[m][k] = *(const PG8_LAS bf16x8*)(lds + PG8_SA(b, h) + aoff + m * 2048 + k * 1024); } while (0)
#define PG8_LDB(dst, b, h) do { _Pragma("unroll") for (int n = 0; n < 2; ++n) _Pragma("unroll") for (int k = 0; k < 2; ++k) dst[n][k] = *(const PG8_LAS bf16x8*)(lds + PG8_SB(b, h) + boff + n * 2048 + k * 1024); } while (0)
#define PG8_MMA(ai, bj, At, Bt) do { __builtin_amdgcn_s_setprio(1); _Pragma("unroll") for (int m = 0; m < 4; ++m) _Pragma("unroll") for (int n = 0; n < 2; ++n) _Pragma("unroll") for (int k = 0; k < 2; ++k) \
        acc[ai][bj][m][n] = __builtin_amdgcn_mfma_f32_16x16x32_bf16(Bt[n][k], At[m][k], acc[ai][bj][m][n], 0, 0, 0); __builtin_amdgcn_s_setprio(0); } while (0)
#define PG8_WAIT_V(n) asm volatile("s_waitcnt vmcnt(" #n ")" ::: "memory")
#define PG8_WAIT_L(n) asm volatile("s_waitcnt lgkmcnt(" #n ")" ::: "memory")
#define PG8_BAR __builtin_amdgcn_s_barrier()
#define PG8_SCHED __builtin_amdgcn_sched_barrier(0)
    Unit cur, nxt; int ui = 0;
    if (!S.next(0, cur)) return;
    f32x4 acc[2][2][4][2];
#pragma unroll
    for (int a = 0; a < 2; ++a)
#pragma unroll
        for (int b = 0; b < 2; ++b)
#pragma unroll
            for (int m = 0; m < 4; ++m)
#pragma unroll
                for (int n = 0; n < 2; ++n) acc[a][b][m][n] = (f32x4){0.f, 0.f, 0.f, 0.f};
    bf16x8 At[4][2], B0[2][2], B1[2][2];
    const char* cA = (const char*)g.A + (size_t)cur.pm * tstep; const char* cB = (const char*)g.Bt + (size_t)cur.pn * tstep;
    S.a_ready(cur);
    if constexpr (SP2) {
        PG8_STAGE(PG8_SB(0, 0), cB, voffB); PG8_STAGE(PG8_SB(0, 1), cB + hstep, voffB); PG8_STAGE(PG8_SA(0, 0), cA, voffA); PG8_STAGE(PG8_SA(0, 1), cA + hstep, voffA);
        if (wr == 1) PG8_BAR;
        PG8_WAIT_V(2); PG8_BAR;
        PG8_STAGE(PG8_SB(1, 0), cB + kstep, voffB); PG8_STAGE(PG8_SA(1, 0), cA + kstep, voffA); PG8_STAGE(PG8_SB(1, 1), cB + hstep + kstep, voffB);
        PG8_WAIT_V(6); PG8_BAR;
    } else {
        PG8_STAGE(PG8_SB(0, 0), cB, voffB); PG8_STAGE(PG8_SA(0, 0), cA, voffA); PG8_STAGE(PG8_SB(0, 1), cB + hstep, voffB); PG8_STAGE(PG8_SA(0, 1), cA + hstep, voffA);
        if (wr == 1) PG8_BAR;
        PG8_WAIT_V(4); PG8_BAR;
        PG8_STAGE(PG8_SB(1, 0), cB + kstep, voffB); PG8_STAGE(PG8_SA(1, 0), cA + kstep, voffA); PG8_STAGE(PG8_SB(1, 1), cB + hstep + kstep, voffB);
        PG8_WAIT_V(6); PG8_BAR;
    }
    for (;;) {
        const bool has_next = S.next(ui + 1, nxt);
        const char* nA = has_next ? (const char*)g.A + (size_t)nxt.pm * tstep : cA; const char* nB = has_next ? (const char*)g.Bt + (size_t)nxt.pn * tstep : cB;
        for (int t = 0; t < nt; t += 2) {
            const bool last = (t == nt - 2);
            const char* a1 = cA + (size_t)(t + 1) * kstep;
            const char* a2 = last ? nA : cA + (size_t)(t + 2) * kstep; const char* b2 = last ? nB : cB + (size_t)(t + 2) * kstep;
            const char* a3 = a2 + kstep; const char* b3 = b2 + kstep;
            if (last && has_next) S.a_ready(nxt);
            if constexpr (SP2) {
            PG8_LDB(B0, 0, 0); PG8_LDB(B1, 0, 1); PG8_SCHED; PG8_LDA(At, 0, 0); PG8_STAGE(PG8_SA(1, 1), a1 + hstep, voffA);
            PG8_WAIT_V(8); PG8_WAIT_L(0); PG8_BAR; PG8_MMA(0, 0, At, B0); PG8_MMA(0, 1, At, B1); PG8_BAR; PG8_SCHED;
            PG8_LDA(At, 0, 1); PG8_STAGE(PG8_SB(0, 0), b2, voffB); PG8_STAGE(PG8_SB(0, 1), b2 + hstep, voffB); PG8_STAGE(PG8_SA(0, 0), a2, voffA);
            PG8_WAIT_V(8); PG8_WAIT_L(0); PG8_BAR; PG8_MMA(1, 0, At, B0); PG8_MMA(1, 1, At, B1); PG8_BAR; PG8_SCHED;
            PG8_LDB(B0, 1, 0); PG8_LDB(B1, 1, 1); PG8_SCHED; PG8_LDA(At, 1, 0); PG8_STAGE(PG8_SA(0, 1), a2 + hstep, voffA);
            PG8_WAIT_V(8); PG8_WAIT_L(0); PG8_BAR; PG8_MMA(0, 0, At, B0); PG8_MMA(0, 1, At, B1); PG8_BAR; PG8_SCHED;
            PG8_LDA(At, 1, 1); PG8_STAGE(PG8_SB(1, 0), b3, voffB); PG8_STAGE(PG8_SB(1, 1), b3 + hstep, voffB); PG8_STAGE(PG8_SA(1, 0), a3, voffA);
            PG8_WAIT_V(8); PG8_WAIT_L(0); PG8_BAR; PG8_MMA(1, 0, At, B0); PG8_MMA(1, 1, At, B1); PG8_BAR; PG8_SCHED;
            } else {
            PG8_LDB(B0, 0, 0); PG8_SCHED; PG8_LDA(At, 0, 0); PG8_STAGE(PG8_SA(1, 1), a1 + hstep, voffA);
            PG8_WAIT_L(8); PG8_BAR; PG8_WAIT_L(0); PG8_MMA(0, 0, At, B0); PG8_BAR; PG8_SCHED;
            PG8_LDB(B1, 0, 1); PG8_STAGE(PG8_SB(0, 0), b2, voffB);
            PG8_BAR; PG8_WAIT_L(0); PG8_MMA(0, 1, At, B1); PG8_BAR;
            PG8_LDA(At, 0, 1); PG8_STAGE(PG8_SA(0, 0), a2, voffA);
            PG8_BAR; PG8_WAIT_L(0); PG8_MMA(1, 0, At, B0); PG8_BAR; PG8_SCHED;
            PG8_STAGE(PG8_SB(0, 1), b2 + hstep, voffB);
            PG8_WAIT_V(6); PG8_BAR; PG8_MMA(1, 1, At, B1); PG8_BAR;
            PG8_LDB(B0, 1, 0); PG8_SCHED; PG8_LDA(At, 1, 0); PG8_STAGE(PG8_SA(0, 1), a2 + hstep, voffA);
            PG8_WAIT_L(8); PG8_BAR; PG8_WAIT_L(0); PG8_MMA(0, 0, At, B0); PG8_BAR; PG8_SCHED;
            PG8_LDB(B1, 1, 1); PG8_STAGE(PG8_SB(1, 0), b3, voffB);
            PG8_BAR; PG8_WAIT_L(0); PG8_MMA(0, 1, At, B1); PG8_BAR;
            PG8_LDA(At, 1, 1); PG8_STAGE(PG8_SA(1, 0), a3, voffA);
            PG8_BAR; PG8_WAIT_L(0); PG8_MMA(1, 0, At, B0); PG8_BAR; PG8_SCHED;
            PG8_STAGE(PG8_SB(1, 1), b3 + hstep, voffB);
            PG8_WAIT_V(6); PG8_BAR; PG8_MMA(1, 1, At, B1); PG8_BAR;
            }
        }
        if constexpr (ALIGN_EPI) { if (wr == 0) PG8_BAR; }
        if constexpr (!Epi::AFTER_DRAIN) { E(acc, cur, wr, wc, fr, fq); S.done(cur); }
        if (!has_next) break;
#pragma unroll
        for (int a = 0; a < 2; ++a)
#pragma unroll
            for (int b = 0; b < 2; ++b)
#pragma unroll
                for (int m = 0; m < 4; ++m)
#pragma unroll
                    for (int n = 0; n < 2; ++n) acc[a][b][m][n] = (f32x4){0.f, 0.f, 0.f, 0.f};
        cur = nxt; cA = nA; cB = nB; ++ui;
        if constexpr (ALIGN_EPI) { if (wr == 1) PG8_BAR; }
    }
    PG8_WAIT_V(0);
    if constexpr (!ALIGN_EPI) { if (wr == 0) PG8_BAR; }
    PG8_BAR;
    if constexpr (Epi::AFTER_DRAIN) { E.fused(acc, cur, wr, wc, fr, fq, lds, wid, lane); S.done(cur); }
#undef PG8_SA
#undef PG8_SB
#undef PG8_STAGE
#undef PG8_LDA
#undef PG8_LDB
#undef PG8_MMA
#undef PG8_WAIT_V
#undef PG8_WAIT_L
#undef PG8_BAR
#undef PG8_SCHED
}
}

constexpr int NB = 4, SEQ = 4096, DM = 2048, MTOK = NB * SEQ;
constexpr int EV_PITCH = 3584, EV_IN = 3400, OD_PITCH = 6144, DFF = 5632, DFF2 = 11264;
constexpr int C_QA = 0, C_KA = 1024, C_VA = 1280, C_QB = 1536, C_CLAT = 2560, C_QI = 2816, C_KI = 3328, C_WI = 3392;
constexpr float EPS = 1e-6f;
constexpr size_t MiB = 1u << 20;
constexpr size_t WS_MOD = 0, WS_WUKT = 512 * 1024, WS_WUVT = 1 * MiB, WS_WIN = 2 * MiB, WS_WOUT = 26 * MiB, WS_WUP = 34 * MiB, WS_WDN = 78 * MiB,
                 WS_XN = 100 * MiB, WS_BIG = 164 * MiB, WS_QLAT = 276 * MiB, WS_G = 516 * MiB, WS_ATT = 516 * MiB, WS_CKV = 580 * MiB,
                 WS_IDX = 588 * MiB, WS_CNT = 604 * MiB, WS_END = 692 * MiB;
constexpr int LDS_BYTES = 147456;
#ifndef SKIP_SWA
#define SKIP_SWA 0
#endif
#ifndef SKIP_DSA
#define SKIP_DSA 0
#endif
#ifndef SKIP_SB
#define SKIP_SB 0
#endif

typedef unsigned short bf16_t;
typedef short bf16x8 __attribute__((ext_vector_type(8)));
typedef float f32x4 __attribute__((ext_vector_type(4)));
typedef unsigned u32x4 __attribute__((ext_vector_type(4)));
typedef unsigned u32x2 __attribute__((ext_vector_type(2)));
#define LAS __attribute__((address_space(3)))
#define MFMA16(a, b, c) __builtin_amdgcn_mfma_f32_16x16x32_bf16((a), (b), (c), 0, 0, 0)

typedef float f32x2_t __attribute__((ext_vector_type(2))); typedef __bf16 bf16x2_t __attribute__((ext_vector_type(2)));
__device__ __forceinline__ unsigned pk2(float lo, float hi) { f32x2_t v = {lo, hi}; bf16x2_t b = __builtin_convertvector(v, bf16x2_t); return __builtin_bit_cast(unsigned, b); }
__device__ __forceinline__ float bflo(unsigned w) { return __uint_as_float(w << 16); }
__device__ __forceinline__ float bfhi(unsigned w) { return __uint_as_float(w & 0xffff0000u); }
__device__ __forceinline__ float wave_sum(float v) {
#pragma unroll
    for (int o = 1; o < 64; o <<= 1) v += __shfl_xor(v, o);
    return v;
}
__device__ __forceinline__ int wave_sum_i(int v) {
#pragma unroll
    for (int o = 1; o < 64; o <<= 1) v += __shfl_xor(v, o);
    return v;
}
__device__ __forceinline__ int t5_bucket(int rel) {
    const int n = rel < 0 ? -rel : rel; int v = n;
    if (n >= 8) v = 8 + (n >= 12) + (n >= 16) + (n >= 23) + (n >= 32) + (n >= 46) + (n >= 64) + (n >= 91);
    return (rel > 0 ? 16 : 0) + v;
}
__device__ __forceinline__ bf16x8 mk8(unsigned a, unsigned b, unsigned c, unsigned d) { u32x4 w; w.x = a; w.y = b; w.z = c; w.w = d; return __builtin_bit_cast(bf16x8, w); }

struct Args { const float* in[20]; float* out; unsigned char* ws; };

__device__ __forceinline__ void transpose_item(const float* W, int K, int N, bf16_t* WT, LAS float* scr, int item, int nblk, int lane) {
    const int kb = item / nblk, nb = item % nblk, k0 = 64 * kb, n0 = 32 * nb; const int nc = n0 + (lane & 31);
#pragma unroll
    for (int i = 0; i < 32; ++i) { const int kk = 2 * i + (lane >> 5); scr[kk * 33 + (lane & 31)] = (nc < N) ? W[(size_t)(k0 + kk) * N + nc] : 0.f; }
    asm volatile("s_waitcnt lgkmcnt(0)" ::: "memory");
    const int c = lane & 7;
#pragma unroll
    for (int j = 0; j < 4; ++j) { const int n = (lane >> 3) + 8 * j; const LAS float* s = scr + (8 * c) * 33 + n;
        u32x4 o; o.x = pk2(s[0 * 33], s[1 * 33]); o.y = pk2(s[2 * 33], s[3 * 33]); o.z = pk2(s[4 * 33], s[5 * 33]); o.w = pk2(s[6 * 33], s[7 * 33]);
        *(u32x4*)(WT + (size_t)(n0 + n) * K + k0 + 8 * c) = o; }
    asm volatile("s_waitcnt lgkmcnt(0)" ::: "memory");
}
__device__ __forceinline__ void convert_matrix(const float* W, int K, int N, int Npad, bf16_t* WT, LAS float* scr, int gw, int NGW, int lane) {
    const int nblk = Npad / 32, nitems = (K / 64) * nblk;
    for (int it = gw; it < nitems; it += NGW) transpose_item(W, K, N, WT, scr, it, nblk, lane);
}

__device__ __forceinline__ void norm_mod_phase(const float* xin, const float* g, const float* modl, int sh_off, int sc_off, bf16_t* XN, int gw, int NGW, int lane) {
    for (int row = gw; row < MTOK; row += NGW) {
        const int b = row >> 12;
        const f32x4* xr = (const f32x4*)(xin + (size_t)row * DM) + lane;
        f32x4 v[8]; float ss = 0.f;
#pragma unroll
        for (int j = 0; j < 8; ++j) { v[j] = xr[64 * j]; ss += (v[j].x * v[j].x + v[j].y * v[j].y) + (v[j].z * v[j].z + v[j].w * v[j].w); }
        ss = wave_sum(ss);
        const float r = rsqrtf(ss * (1.f / DM) + EPS);
        const float* mb = modl + (size_t)b * 12288;
#pragma unroll
        for (int j = 0; j < 8; ++j) { const int col = 4 * (64 * j + lane);
            const f32x4 g4 = *(const f32x4*)(g + col), sc = *(const f32x4*)(mb + sc_off + col), sh = *(const f32x4*)(mb + sh_off + col);
            const f32x4 y = v[j] * r * g4; const f32x4 h = y * (sc + 1.f) + sh;
            u32x2 w; w.x = pk2(h.x, h.y); w.y = pk2(h.z, h.w);
            *(u32x2*)(XN + (size_t)row * DM + col) = w; }
    }
}

__device__ __forceinline__ void conv_gate_phase(const bf16_t* U, const float* cw, const float* cb, bf16_t* Gout, int G, int tid) {
    for (int item = blockIdx.x * 512 + tid; item < 1024 * 704; item += G * 512) {
        const int cg8 = item % 704, run = item / 704; const int row0 = run * 16, c0 = cg8 * 8; const bool first = (row0 & 4095) == 0;
        float wg[3][8], wv[3][8], bg[8], bv[8];
#pragma unroll
        for (int j = 0; j < 3; ++j) {
            const f32x4 a0 = *(const f32x4*)(cw + j * DFF2 + c0), a1 = *(const f32x4*)(cw + j * DFF2 + c0 + 4);
            const f32x4 b0 = *(const f32x4*)(cw + j * DFF2 + DFF + c0), b1 = *(const f32x4*)(cw + j * DFF2 + DFF + c0 + 4);
#pragma unroll
            for (int e = 0; e < 4; ++e) { wg[j][e] = a0[e]; wg[j][4 + e] = a1[e]; wv[j][e] = b0[e]; wv[j][4 + e] = b1[e]; }
        }
        { const f32x4 a0 = *(const f32x4*)(cb + c0), a1 = *(const f32x4*)(cb + c0 + 4), b0 = *(const f32x4*)(cb + DFF + c0), b1 = *(const f32x4*)(cb + DFF + c0 + 4);
#pragma unroll
          for (int e = 0; e < 4; ++e) { bg[e] = a0[e]; bg[4 + e] = a1[e]; bv[e] = b0[e]; bv[4 + e] = b1[e]; } }
        float g2[8], g1[8], v2[8], v1[8];
#pragma unroll
        for (int e = 0; e < 8; ++e) { g2[e] = 0.f; g1[e] = 0.f; v2[e] = 0.f; v1[e] = 0.f; }
        if (!first) {
            const u32x4 a = *(const u32x4*)(U + (size_t)(row0 - 2) * DFF2 + c0), b = *(const u32x4*)(U + (size_t)(row0 - 2) * DFF2 + DFF + c0);
            const u32x4 c = *(const u32x4*)(U + (size_t)(row0 - 1) * DFF2 + c0), d = *(const u32x4*)(U + (size_t)(row0 - 1) * DFF2 + DFF + c0);
#pragma unroll
            for (int e = 0; e < 4; ++e) { g2[2 * e] = bflo(a[e]); g2[2 * e + 1] = bfhi(a[e]); v2[2 * e] = bflo(b[e]); v2[2 * e + 1] = bfhi(b[e]);
                                          g1[2 * e] = bflo(c[e]); g1[2 * e + 1] = bfhi(c[e]); v1[2 * e] = bflo(d[e]); v1[2 * e + 1] = bfhi(d[e]); }
        }
#pragma unroll 4
        for (int t = 0; t < 16; ++t) {
            const u32x4 a = *(const u32x4*)(U + (size_t)(row0 + t) * DFF2 + c0), b = *(const u32x4*)(U + (size_t)(row0 + t) * DFF2 + DFF + c0);
            float gc[8], vc[8], r[8];
#pragma unroll
            for (int e = 0; e < 4; ++e) { gc[2 * e] = bflo(a[e]); gc[2 * e + 1] = bfhi(a[e]); vc[2 * e] = bflo(b[e]); vc[2 * e + 1] = bfhi(b[e]); }
#pragma unroll
            for (int e = 0; e < 8; ++e) {
                const float gg = wg[0][e] * g2[e] + wg[1][e] * g1[e] + wg[2][e] * gc[e] + bg[e];
                const float vv = wv[0][e] * v2[e] + wv[1][e] * v1[e] + wv[2][e] * vc[e] + bv[e];
                r[e] = gg / (1.f + __expf(-gg)) * vv;
                g2[e] = g1[e]; g1[e] = gc[e]; v2[e] = v1[e]; v1[e] = vc[e];
            }
            u32x4 o; o.x = pk2(r[0], r[1]); o.y = pk2(r[2], r[3]); o.z = pk2(r[4], r[5]); o.w = pk2(r[6], r[7]);
            *(u32x4*)(Gout + (size_t)(row0 + t) * DFF + c0) = o;
        }
    }
}

__global__ void __launch_bounds__(512, 2) mega_fwd(Args a) {
    extern __shared__ __attribute__((aligned(16))) unsigned char lds[];
    cg::grid_group grid = cg::this_grid();
    LAS unsigned char* L = (LAS unsigned char*)lds;
    const int G = gridDim.x, NGW = G * 8;
    unsigned* bar_ctr = (unsigned*)(a.ws + 458752); unsigned bar_target = 0u;
#define GSYNC() do { __builtin_amdgcn_fence(__ATOMIC_RELEASE, "agent"); asm volatile("s_waitcnt vmcnt(0) lgkmcnt(0)" ::: "memory"); __syncthreads(); bar_target += (unsigned)G; \
        if (threadIdx.x == 0) { __hip_atomic_fetch_add(bar_ctr, 1u, __ATOMIC_RELEASE, __HIP_MEMORY_SCOPE_AGENT); \
            while (__hip_atomic_load(bar_ctr, __ATOMIC_ACQUIRE, __HIP_MEMORY_SCOPE_AGENT) < bar_target) __builtin_amdgcn_s_sleep(2); } \
        __syncthreads(); __builtin_amdgcn_fence(__ATOMIC_ACQUIRE, "agent"); asm volatile("s_waitcnt vmcnt(0)" ::: "memory"); } while (0)
#define IDS int tid = threadIdx.x; asm volatile("" : "+v"(tid)); const int lane = tid & 63, wave = __builtin_amdgcn_readfirstlane(tid >> 6), fr = lane & 15, fq = lane >> 4; const int gw = blockIdx.x * 8 + wave; (void)fr; (void)fq; (void)gw; (void)lane; \
            LAS float* scr = (LAS float*)(L + 65536 + wave * 8448); (void)scr;
    unsigned char* ws = a.ws;
    float* MOD = (float*)(ws + WS_MOD);
    bf16_t* WUKT = (bf16_t*)(ws + WS_WUKT); bf16_t* WUVT = (bf16_t*)(ws + WS_WUVT);
    bf16_t* WIN = (bf16_t*)(ws + WS_WIN); bf16_t* WOUT = (bf16_t*)(ws + WS_WOUT); bf16_t* WUP = (bf16_t*)(ws + WS_WUP); bf16_t* WDN = (bf16_t*)(ws + WS_WDN);
    bf16_t* XN = (bf16_t*)(ws + WS_XN); bf16_t* PROJ = (bf16_t*)(ws + WS_BIG); bf16_t* UB = (bf16_t*)(ws + WS_BIG); bf16_t* QLAT = (bf16_t*)(ws + WS_QLAT);
    bf16_t* GB = (bf16_t*)(ws + WS_G); bf16_t* ATT = (bf16_t*)(ws + WS_ATT); bf16_t* CKV = (bf16_t*)(ws + WS_CKV);
    int* IDX = (int*)(ws + WS_IDX); int* CNT = (int*)(ws + WS_CNT);
    const float* x_in = a.in[0]; const float* rel_bias = a.in[2];
    float* xres = a.out;

    grid.sync();
    {
        IDS
        LAS float* cs = (LAS float*)L; LAS float* red = cs + 8192;
        for (int it = blockIdx.x; it < 192; it += G) {
            const int i = it / 96, jc = it % 96;
            for (int idx = tid; idx < 8192; idx += 512) { const float v = a.in[1][idx]; cs[idx] = v / (1.f + expf(-v)); }
            __syncthreads();
            const int cq = tid & 31, kg = tid >> 5;
            const float* w = a.in[3] + (size_t)i * 2048 * 12288 + jc * 128 + cq * 4;
            f32x4 ac[4];
#pragma unroll
            for (int b = 0; b < 4; ++b) ac[b] = (f32x4){0.f, 0.f, 0.f, 0.f};
#pragma unroll 4
            for (int kk = 0; kk < 128; ++kk) { const int k = kg * 128 + kk; const f32x4 wv = *(const f32x4*)(w + (size_t)k * 12288);
#pragma unroll
                for (int b = 0; b < 4; ++b) ac[b] += wv * cs[b * 2048 + k]; }
#pragma unroll
            for (int b = 0; b < 4; ++b) *(LAS f32x4*)(red + (kg * 4 + b) * 128 + cq * 4) = ac[b];
            __syncthreads();
            { const int b = tid >> 7, col = tid & 127; float s = a.in[4][i * 12288 + jc * 128 + col];
#pragma unroll
              for (int k2 = 0; k2 < 16; ++k2) s += red[(k2 * 4 + b) * 128 + col];
              MOD[(size_t)(i * 4 + b) * 12288 + jc * 128 + col] = s; }
            __syncthreads();
        }
        convert_matrix(a.in[7], 2048, EV_IN, EV_PITCH, WIN, scr, gw, NGW, lane);
        convert_matrix(a.in[12], 2048, 2048, 2048, WOUT, scr, gw, NGW, lane);
        convert_matrix(a.in[15], 2048, DFF2, DFF2, WUP, scr, gw, NGW, lane);
        convert_matrix(a.in[18], DFF, 2048, 2048, WDN, scr, gw, NGW, lane);
        for (int h = 0; h < 16; ++h) {
            convert_matrix(a.in[9] + (size_t)h * 64 * 256, 64, 256, 256, WUKT + (size_t)h * 256 * 64, scr, gw, NGW, lane);
            convert_matrix(a.in[10] + (size_t)h * 256 * 64, 256, 64, 64, WUVT + (size_t)h * 64 * 256, scr, gw, NGW, lane);
        }
    }
    GSYNC();

#pragma unroll
    for (int layer = 0; layer < 2; ++layer) {
        const float* modl = MOD + (size_t)layer * 4 * 12288;
        const float* xcur = (layer == 0) ? x_in : (const float*)xres;
        { IDS
        norm_mod_phase(xcur, a.in[5] + layer * DM, modl, 0, 2048, XN, gw, NGW, lane);
        if (layer == 1) {
            convert_matrix(a.in[13], 2048, OD_PITCH, OD_PITCH, WIN, scr, gw, NGW, lane);
            convert_matrix(a.in[14], 2048, 2048, 2048, WOUT, scr, gw, NGW, lane);
            convert_matrix(a.in[15] + (size_t)2048 * DFF2, 2048, DFF2, DFF2, WUP, scr, gw, NGW, lane);
            convert_matrix(a.in[18] + (size_t)DFF * 2048, DFF, 2048, 2048, WDN, scr, gw, NGW, lane);
        } }
        GSYNC();
#if SKIP_SWA || SKIP_DSA || SKIP_SB
        { IDS for (size_t i = (size_t)blockIdx.x * 512 + tid; i < (size_t)MTOK * DM / 8; i += (size_t)G * 512) ((u32x4*)ATT)[i] = (u32x4){0u, 0u, 0u, 0u}; }
#endif
        if (layer == 0) {
            { pg8::Gemm g{XN, WIN, MTOK, EV_PITCH, 2048}; pg8::StaticOrder S; S.init(MTOK, EV_PITCH, G, (int)blockIdx.x);
              pg8::EpiBf16 E{PROJ, EV_PITCH};
              pg8::gemm_phase<pg8::EpiBf16, pg8::StaticOrder, true, true>(L, g, S, E); }
            GSYNC();
            { IDS
            for (int row = gw; row < MTOK; row += NGW) {
                const u32x2 w = *(const u32x2*)(PROJ + (size_t)row * EV_PITCH + C_CLAT + 4 * lane);
                const float x0 = bflo(w.x), x1 = bfhi(w.x), x2 = bflo(w.y), x3 = bfhi(w.y);
                const float ss = wave_sum((x0 * x0 + x1 * x1) + (x2 * x2 + x3 * x3));
                const float r = rsqrtf(ss * (1.f / 256.f) + EPS);
                const f32x4 g4 = *(const f32x4*)(a.in[8] + 4 * lane);
                u32x2 o; o.x = pk2(x0 * r * g4.x, x1 * r * g4.y); o.y = pk2(x2 * r * g4.z, x3 * r * g4.w);
                *(u32x2*)(CKV + (size_t)row * 256 + 4 * lane) = o;
            } }
            { IDS
            for (int unit = gw; unit < 16384; unit += NGW) {
                const int h = unit & 15, t0 = (unit >> 4) * 16;
                bf16x8 bq[2];
#pragma unroll
                for (int ks = 0; ks < 2; ++ks) bq[ks] = *(const bf16x8*)(PROJ + (size_t)(t0 + fr) * EV_PITCH + C_QB + h * 64 + 32 * ks + 8 * fq);
#pragma unroll 4
                for (int rt = 0; rt < 16; ++rt) {
                    f32x4 acc = (f32x4){0.f, 0.f, 0.f, 0.f};
#pragma unroll
                    for (int ks = 0; ks < 2; ++ks) { const bf16x8 aw = *(const bf16x8*)(WUKT + (size_t)(h * 256 + 16 * rt + fr) * 64 + 32 * ks + 8 * fq); acc = MFMA16(aw, bq[ks], acc); }
                    u32x2 o; o.x = pk2(acc[0] * 0.125f, acc[1] * 0.125f); o.y = pk2(acc[2] * 0.125f, acc[3] * 0.125f);
                    *(u32x2*)(QLAT + ((size_t)(t0 + fr) * 16 + h) * 256 + 16 * rt + 4 * fq) = o;
                }
            } }
#if !SKIP_DSA
            {
                IDS
                LAS float* sc = (LAS float*)L;
                __syncthreads();
                for (int unit = blockIdx.x; unit < 2048; unit += G) {
                    const int row0 = unit * 8, b = row0 >> 12, c = (row0 & 4095) >> 6, nall = (c + 1) * 64;
                    const int row = row0 + wave;
                    int* idxp = IDX + (size_t)row * 256;
                    if (nall <= 256) { for (int i = lane; i < nall; i += 64) idxp[i] = i; if (lane == 0) CNT[row] = nall; continue; }
                    const int nquads = c + 1, ntiles = nall >> 4;
                    bf16x8 qa[4][2];
#pragma unroll
                    for (int hp = 0; hp < 4; ++hp)
#pragma unroll
                        for (int ks = 0; ks < 2; ++ks) qa[hp][ks] = *(const bf16x8*)(PROJ + (size_t)(row0 + (fr & 7)) * EV_PITCH + C_QI + (2 * hp + (fr >> 3)) * 64 + 32 * ks + 8 * fq);
                    float wq[4][4];
#pragma unroll
                    for (int hp = 0; hp < 4; ++hp)
#pragma unroll
                        for (int j = 0; j < 4; ++j) wq[hp][j] = __uint_as_float((unsigned)PROJ[(size_t)(row0 + 4 * (fq & 1) + j) * EV_PITCH + C_WI + 2 * hp + (fq >> 1)] << 16);
                    const bf16_t* kbase = PROJ + ((size_t)b * SEQ + fr) * EV_PITCH + C_KI + 8 * fq;
#pragma unroll 2
                    for (int t = wave; t < ntiles; t += 8) {
                        const bf16_t* kp = kbase + (size_t)(16 * t) * EV_PITCH;
                        const bf16x8 b0 = *(const bf16x8*)kp, b1 = *(const bf16x8*)(kp + 32);
                        float part[4] = {0.f, 0.f, 0.f, 0.f};
#pragma unroll
                        for (int hp = 0; hp < 4; ++hp) {
                            f32x4 acc = (f32x4){0.f, 0.f, 0.f, 0.f};
                            acc = MFMA16(qa[hp][0], b0, acc); acc = MFMA16(qa[hp][1], b1, acc);
#pragma unroll
                            for (int j = 0; j < 4; ++j) part[j] += wq[hp][j] * fmaxf(acc[j], 0.f);
                        }
#pragma unroll
                        for (int j = 0; j < 4; ++j) part[j] += __shfl_xor(part[j], 32);
                        if (fq < 2) {
#pragma unroll
                            for (int j = 0; j < 4; ++j) sc[(4 * fq + j) * 4096 + 16 * t + fr] = part[j];
                        }
                    }
                    __syncthreads();
                    unsigned v[64];
#pragma unroll
                    for (int q = 0; q < 64; ++q) {
                        unsigned val = 0u;
                        if (q < nquads) { unsigned u = __float_as_uint(sc[wave * 4096 + 64 * q + lane]); if (u == 0x80000000u) u = 0u; val = (u & 0x80000000u) ? ~u : (u | 0x80000000u); }
                        v[q] = val;
                    }
                    unsigned T = 0u;
                    for (int bit = 31; bit >= 0; --bit) {
                        const unsigned cand = T | (1u << bit); int cnt = 0;
#pragma unroll
                        for (int q = 0; q < 64; ++q) cnt += (v[q] >= cand) ? 1 : 0;
                        cnt = wave_sum_i(cnt);
                        if (cnt >= 256) T = cand;
                    }
                    int cgt = 0;
#pragma unroll
                    for (int q = 0; q < 64; ++q) cgt += (v[q] > T) ? 1 : 0;
                    cgt = wave_sum_i(cgt);
                    int need = 256 - cgt, pos = 0;
                    const unsigned long long ltmask = (1ull << lane) - 1ull;
#pragma unroll
                    for (int q = 0; q < 64; ++q) {
                        if (q < nquads) {
                            const bool gt = v[q] > T, eq = v[q] == T;
                            const unsigned long long meq = __ballot(eq);
                            const int eqrank = __popcll(meq & ltmask);
                            const bool sel = gt || (eq && eqrank < need);
                            const unsigned long long msel = __ballot(sel);
                            if (sel) idxp[pos + __popcll(msel & ltmask)] = q * 64 + lane;
                            pos += __popcll(msel);
                            const int neq = __popcll(meq); need -= (neq < need ? neq : need);
                        }
                    }
                    if (lane == 0) CNT[row] = 256;
                    __syncthreads();
                }
            }
#endif
#if !SKIP_SWA
            {
                IDS
                LAS bf16_t* Vt = (LAS bf16_t*)L;
                LAS float* bT = (LAS float*)(L + 64 * 200 * 2);
                __syncthreads();
                for (int unit = blockIdx.x; unit < 1024; unit += G) {
                    const int b = unit >> 8, c = (unit >> 2) & 63, kvh = unit & 3;
                    const int kstart = (c >= 2 ? c - 2 : 0) * 64, nk = (c + 1) * 64 - kstart;
                    const size_t rowbase = (size_t)b * SEQ;
                    for (int idx = tid; idx < 1024; idx += 512) { const int g = idx >> 8, ri = idx & 255; bT[idx] = rel_bias[t5_bucket(ri - 191) * 32 + kvh * 4 + g]; }
                    for (int i = tid; i < nk * 8; i += 512) { const int key = i >> 3, ch = i & 7;
                        const u32x4 w = *(const u32x4*)(PROJ + (rowbase + kstart + key) * EV_PITCH + C_VA + kvh * 64 + ch * 8);
                        LAS bf16_t* vp = Vt + (ch * 8) * 200 + key;
                        vp[0 * 200] = (bf16_t)(w.x & 0xffffu); vp[1 * 200] = (bf16_t)(w.x >> 16); vp[2 * 200] = (bf16_t)(w.y & 0xffffu); vp[3 * 200] = (bf16_t)(w.y >> 16);
                        vp[4 * 200] = (bf16_t)(w.z & 0xffffu); vp[5 * 200] = (bf16_t)(w.z >> 16); vp[6 * 200] = (bf16_t)(w.w & 0xffffu); vp[7 * 200] = (bf16_t)(w.w >> 16); }
                    __syncthreads();
                    const int g = wave >> 1, qh = wave & 1, head = kvh * 4 + g, q0 = c * 64 + qh * 32;
                    const int ntile = nk >> 4;
                    bf16x8 bq[2][2];
#pragma unroll
                    for (int m = 0; m < 2; ++m)
#pragma unroll
                        for (int ks = 0; ks < 2; ++ks) bq[m][ks] = *(const bf16x8*)(PROJ + (rowbase + q0 + 16 * m + fr) * EV_PITCH + C_QA + head * 64 + 32 * ks + 8 * fq);
                    f32x4 s[12][2];
#pragma unroll
                    for (int t = 0; t < 12; ++t) {
                        if (t < ntile) {
                            const bf16_t* kp = PROJ + (rowbase + kstart + 16 * t + fr) * EV_PITCH + C_KA + kvh * 64 + 8 * fq;
                            const bf16x8 k0 = *(const bf16x8*)kp, k1 = *(const bf16x8*)(kp + 32);
#pragma unroll
                            for (int m = 0; m < 2; ++m) { f32x4 acc = (f32x4){0.f, 0.f, 0.f, 0.f}; acc = MFMA16(k0, bq[m][0], acc); acc = MFMA16(k1, bq[m][1], acc); s[t][m] = acc; }
                        } else { s[t][0] = (f32x4){0.f, 0.f, 0.f, 0.f}; s[t][1] = (f32x4){0.f, 0.f, 0.f, 0.f}; }
                    }
                    const float sink = a.in[11][head];
                    float inv[2];
#pragma unroll
                    for (int m = 0; m < 2; ++m) {
                        const int qpos = q0 + 16 * m + fr;
                        float mx = -1e30f;
#pragma unroll
                        for (int t = 0; t < 12; ++t)
                            if (t < ntile) {
#pragma unroll
                                for (int j = 0; j < 4; ++j) { const int ri = (kstart + 16 * t + 4 * fq + j) - qpos + 191; const float vv = s[t][m][j] * 0.125f + bT[g * 256 + ri]; s[t][m][j] = vv; mx = fmaxf(mx, vv); }
                            }
                        mx = fmaxf(mx, __shfl_xor(mx, 16)); mx = fmaxf(mx, __shfl_xor(mx, 32)); mx = fmaxf(mx, sink);
                        float sum = 0.f;
#pragma unroll
                        for (int t = 0; t < 12; ++t)
                            if (t < ntile) {
#pragma unroll
                                for (int j = 0; j < 4; ++j) { const float p = __expf(s[t][m][j] - mx); s[t][m][j] = p; sum += p; }
                            }
                        sum += __shfl_xor(sum, 16); sum += __shfl_xor(sum, 32);
                        inv[m] = 1.f / (sum + __expf(sink - mx));
                    }
                    f32x4 o[4][2];
#pragma unroll
                    for (int dt = 0; dt < 4; ++dt) { o[dt][0] = (f32x4){0.f, 0.f, 0.f, 0.f}; o[dt][1] = (f32x4){0.f, 0.f, 0.f, 0.f}; }
#pragma unroll
                    for (int st = 0; st < 6; ++st) {
                        if (2 * st < ntile) {
                            bf16x8 pb[2];
#pragma unroll
                            for (int m = 0; m < 2; ++m) pb[m] = mk8(pk2(s[2 * st][m][0], s[2 * st][m][1]), pk2(s[2 * st][m][2], s[2 * st][m][3]), pk2(s[2 * st + 1][m][0], s[2 * st + 1][m][1]), pk2(s[2 * st + 1][m][2], s[2 * st + 1][m][3]));
#pragma unroll
                            for (int dt = 0; dt < 4; ++dt) {
                                const LAS bf16_t* vp = Vt + (16 * dt + fr) * 200 + 32 * st + 4 * fq;
                                const u32x2 lo = *(const LAS u32x2*)vp, hi = *(const LAS u32x2*)(vp + 16);
                                const bf16x8 av = mk8(lo.x, lo.y, hi.x, hi.y);
                                o[dt][0] = MFMA16(av, pb[0], o[dt][0]); o[dt][1] = MFMA16(av, pb[1], o[dt][1]);
                            }
                        }
                    }
#pragma unroll
                    for (int m = 0; m < 2; ++m)
#pragma unroll
                        for (int dt = 0; dt < 4; ++dt) { u32x2 w; w.x = pk2(o[dt][m][0] * inv[m], o[dt][m][1] * inv[m]); w.y = pk2(o[dt][m][2] * inv[m], o[dt][m][3] * inv[m]);
                            *(u32x2*)(ATT + (rowbase + q0 + 16 * m + fr) * DM + head * 64 + 16 * dt + 4 * fq) = w; }
                    __syncthreads();
                }
            }
#endif
            GSYNC();
#if !SKIP_DSA
            {
                IDS
                LAS float* bB = (LAS float*)(L + 8 * 16896);
                if (tid < 512) bB[tid] = rel_bias[(tid >> 4) * 32 + 16 + (tid & 15)];
                __syncthreads();
                LAS bf16_t* cb = (LAS bf16_t*)(L + wave * 16896);
                for (int row = gw; row < MTOK; row += NGW) {
                    const int b = row >> 12, tpos = row & 4095; const size_t rowbase = (size_t)b * SEQ;
                    const int cnt = __builtin_amdgcn_readfirstlane(CNT[row]); const int nch = cnt >> 5;
                    bf16x8 ql[8];
#pragma unroll
                    for (int ks = 0; ks < 8; ++ks) ql[ks] = *(const bf16x8*)(QLAT + ((size_t)row * 16 + fr) * 256 + 32 * ks + 8 * fq);
                    f32x4 o[16];
#pragma unroll
                    for (int rt = 0; rt < 16; ++rt) o[rt] = (f32x4){0.f, 0.f, 0.f, 0.f};
                    float mrun = -1e30f, lpart = 0.f;
                    int nextidx = IDX[(size_t)row * 256 + (lane & 31)];
                    for (int ch = 0; ch < nch; ++ch) {
                        const int myidx = nextidx;
                        if (ch + 1 < nch) nextidx = IDX[(size_t)row * 256 + 32 * (ch + 1) + (lane & 31)];
                        { u32x4 gw[16];
#pragma unroll
                          for (int it = 0; it < 16; ++it) { const int key = 2 * it + (lane >> 5), seg = lane & 31; const int kidx = __shfl(myidx, key);
                              gw[it] = *(const u32x4*)(CKV + (rowbase + kidx) * 256 + seg * 8); }
                          __builtin_amdgcn_sched_barrier(0);
#pragma unroll
                          for (int it = 0; it < 16; ++it) { const int key = 2 * it + (lane >> 5), seg = lane & 31; *(LAS u32x4*)(cb + key * 264 + seg * 8) = gw[it]; } }
                        asm volatile("s_waitcnt lgkmcnt(0)" ::: "memory");
                        f32x4 sa[2];
#pragma unroll
                        for (int kt = 0; kt < 2; ++kt) { f32x4 acc = (f32x4){0.f, 0.f, 0.f, 0.f};
#pragma unroll
                            for (int ks = 0; ks < 8; ++ks) { const bf16x8 ac = *(const LAS bf16x8*)(cb + (16 * kt + fr) * 264 + 32 * ks + 8 * fq); acc = MFMA16(ac, ql[ks], acc); }
                            sa[kt] = acc; }
                        float cm = -1e30f;
#pragma unroll
                        for (int kt = 0; kt < 2; ++kt)
#pragma unroll
                            for (int j = 0; j < 4; ++j) { const int kidx = __shfl(myidx, 16 * kt + 4 * fq + j); const float vv = sa[kt][j] + bB[t5_bucket(kidx - tpos) * 16 + fr]; sa[kt][j] = vv; cm = fmaxf(cm, vv); }
                        cm = fmaxf(cm, __shfl_xor(cm, 16)); cm = fmaxf(cm, __shfl_xor(cm, 32));
                        const float mnew = fmaxf(mrun, cm), alpha = __expf(mrun - mnew); mrun = mnew;
                        float ps = 0.f;
#pragma unroll
                        for (int kt = 0; kt < 2; ++kt)
#pragma unroll
                            for (int j = 0; j < 4; ++j) { const float p = __expf(sa[kt][j] - mnew); sa[kt][j] = p; ps += p; }
                        lpart = lpart * alpha + ps;
#pragma unroll
                        for (int rt = 0; rt < 16; ++rt) o[rt] *= alpha;
                        const bf16x8 pb = mk8(pk2(sa[0][0], sa[0][1]), pk2(sa[0][2], sa[0][3]), pk2(sa[1][0], sa[1][1]), pk2(sa[1][2], sa[1][3]));
#pragma unroll
                        for (int rt = 0; rt < 16; ++rt) {
                            const LAS bf16_t* cp = cb + (4 * fq) * 264 + 16 * rt + fr;
                            const unsigned e0 = cp[0], e1 = cp[264], e2 = cp[2 * 264], e3 = cp[3 * 264], e4 = cp[16 * 264], e5 = cp[17 * 264], e6 = cp[18 * 264], e7 = cp[19 * 264];
                            const bf16x8 av = mk8(e0 | (e1 << 16), e2 | (e3 << 16), e4 | (e5 << 16), e6 | (e7 << 16));
                            o[rt] = MFMA16(av, pb, o[rt]);
                        }
                        asm volatile("s_waitcnt lgkmcnt(0)" ::: "memory");
                    }
                    float l = lpart + __shfl_xor(lpart, 16); l += __shfl_xor(l, 32);
                    const float inv = 1.f / l;
#pragma unroll
                    for (int rt = 0; rt < 16; ++rt) { u32x2 w; w.x = pk2(o[rt][0] * inv, o[rt][1] * inv); w.y = pk2(o[rt][2] * inv, o[rt][3] * inv);
                        *(u32x2*)(QLAT + ((size_t)row * 16 + fr) * 256 + 16 * rt + 4 * fq) = w; }
                }
            }
#endif
            GSYNC();
#if !SKIP_DSA
            { IDS
            for (int unit = gw; unit < 16384; unit += NGW) {
                const int h = unit & 15, t0 = (unit >> 4) * 16;
                bf16x8 bo[8];
#pragma unroll
                for (int ks = 0; ks < 8; ++ks) bo[ks] = *(const bf16x8*)(QLAT + ((size_t)(t0 + fr) * 16 + h) * 256 + 32 * ks + 8 * fq);
#pragma unroll
                for (int dt = 0; dt < 4; ++dt) {
                    f32x4 acc = (f32x4){0.f, 0.f, 0.f, 0.f};
#pragma unroll
                    for (int ks = 0; ks < 8; ++ks) { const bf16x8 aw = *(const bf16x8*)(WUVT + (size_t)(h * 64 + 16 * dt + fr) * 256 + 32 * ks + 8 * fq); acc = MFMA16(aw, bo[ks], acc); }
                    u32x2 w; w.x = pk2(acc[0], acc[1]); w.y = pk2(acc[2], acc[3]);
                    *(u32x2*)(ATT + (size_t)(t0 + fr) * DM + 1024 + h * 64 + 16 * dt + 4 * fq) = w;
                }
            } }
#endif
            GSYNC();
        } else {
            { pg8::Gemm g{XN, WIN, MTOK, OD_PITCH, 2048}; pg8::StaticOrder S; S.init(MTOK, OD_PITCH, G, (int)blockIdx.x);
              pg8::EpiBf16 E{PROJ, OD_PITCH};
              pg8::gemm_phase<pg8::EpiBf16, pg8::StaticOrder, true, true>(L, g, S, E); }
            GSYNC();
#if SKIP_SB == 2
            { IDS for (size_t i = (size_t)blockIdx.x * 512 + tid; i < (size_t)MTOK * 256; i += (size_t)G * 512) { const size_t row = i >> 8, c8 = i & 255; ((u32x4*)ATT)[i] = *(const u32x4*)(PROJ + row * OD_PITCH + 4096 + c8 * 8); } }
#endif
#if !SKIP_SB
            {
                IDS
                LAS bf16_t* vb = (LAS bf16_t*)(L + wave * 8704);
                for (int unit = gw; unit < 8192; unit += NGW) {
                    const int qt = 127 - (unit >> 6), h = unit & 15, b = (unit >> 4) & 3; const int q0 = qt * 32; const size_t rowbase = (size_t)b * SEQ;
                    bf16x8 bq[2][4];
#pragma unroll
                    for (int m = 0; m < 2; ++m)
#pragma unroll
                        for (int ks = 0; ks < 4; ++ks) bq[m][ks] = *(const bf16x8*)(PROJ + (rowbase + q0 + 16 * m + fr) * OD_PITCH + h * 128 + 32 * ks + 8 * fq);
                    f32x4 o[8][2];
#pragma unroll
                    for (int dt = 0; dt < 8; ++dt) { o[dt][0] = (f32x4){0.f, 0.f, 0.f, 0.f}; o[dt][1] = (f32x4){0.f, 0.f, 0.f, 0.f}; }
                    float Lc[2] = {0.f, 0.f};
                    for (int kb = qt; kb >= 0; --kb) {
                        bf16x8 akk[2][4];
                        { u32x4 gw[8];
#pragma unroll
                          for (int it = 0; it < 8; ++it) { const int key = 4 * it + (lane >> 4), seg = lane & 15;
                              gw[it] = *(const u32x4*)(PROJ + (rowbase + 32 * kb + key) * OD_PITCH + 4096 + h * 128 + seg * 8); }
#pragma unroll
                          for (int kt = 0; kt < 2; ++kt)
#pragma unroll
                              for (int ks = 0; ks < 4; ++ks) akk[kt][ks] = *(const bf16x8*)(PROJ + (rowbase + 32 * kb + 16 * kt + fr) * OD_PITCH + 2048 + h * 128 + 8 * fq + 32 * ks);
                          __builtin_amdgcn_sched_barrier(0);
#pragma unroll
                          for (int it = 0; it < 8; ++it) { const int key = 4 * it + (lane >> 4), seg = lane & 15; *(LAS u32x4*)(vb + key * 136 + seg * 8) = gw[it]; } }
                        asm volatile("s_waitcnt lgkmcnt(0)" ::: "memory");
                        f32x4 z[2][2];
#pragma unroll
                        for (int kt = 0; kt < 2; ++kt) {
                            bf16x8 ak[4];
#pragma unroll
                            for (int ks = 0; ks < 4; ++ks) ak[ks] = akk[kt][ks];
#pragma unroll
                            for (int m = 0; m < 2; ++m) { f32x4 acc = (f32x4){0.f, 0.f, 0.f, 0.f};
#pragma unroll
                                for (int ks = 0; ks < 4; ++ks) acc = MFMA16(ak[ks], bq[m][ks], acc);
                                z[kt][m] = acc; }
                        }
                        const bool diag = (kb == qt);
                        bf16x8 pb[2];
#pragma unroll
                        for (int m = 0; m < 2; ++m) {
                            float lk[2][4], ls[2][4]; bool er[2][4];
#pragma unroll
                            for (int kt = 0; kt < 2; ++kt)
#pragma unroll
                                for (int j = 0; j < 4; ++j) { const float zz = z[kt][m][j] * 0.08838834764831845f; const float sp = fmaxf(zz, 0.f) + __logf(1.f + __expf(-fabsf(zz)));
                                    const bool e = !diag || (16 * kt + 4 * fq + j < 16 * m + fr); er[kt][j] = e; lk[kt][j] = e ? -sp : 0.f; ls[kt][j] = zz - sp; }
                            const float g0 = (lk[0][0] + lk[0][1]) + (lk[0][2] + lk[0][3]), g1 = (lk[1][0] + lk[1][1]) + (lk[1][2] + lk[1][3]);
                            float g0a[4], g1a[4];
#pragma unroll
                            for (int f = 0; f < 4; ++f) { g0a[f] = __shfl(g0, fr + 16 * f); g1a[f] = __shfl(g1, fr + 16 * f); }
                            const float tot0 = (g0a[0] + g0a[1]) + (g0a[2] + g0a[3]), tot1 = (g1a[0] + g1a[1]) + (g1a[2] + g1a[3]);
                            const float aft1 = (fq < 1 ? g1a[1] : 0.f) + (fq < 2 ? g1a[2] : 0.f) + (fq < 3 ? g1a[3] : 0.f);
                            const float aft0 = (fq < 1 ? g0a[1] : 0.f) + (fq < 2 ? g0a[2] : 0.f) + (fq < 3 ? g0a[3] : 0.f) + tot1;
                            float av[2][4];
#pragma unroll
                            for (int kt = 0; kt < 2; ++kt) { float suf = Lc[m] + (kt == 0 ? aft0 : aft1);
#pragma unroll
                                for (int j = 3; j >= 0; --j) { av[kt][j] = er[kt][j] ? __expf(ls[kt][j] + suf) : 0.f; suf += lk[kt][j]; } }
                            Lc[m] += tot0 + tot1;
                            pb[m] = mk8(pk2(av[0][0], av[0][1]), pk2(av[0][2], av[0][3]), pk2(av[1][0], av[1][1]), pk2(av[1][2], av[1][3]));
                        }
#pragma unroll
                        for (int dt = 0; dt < 8; ++dt) {
                            const LAS bf16_t* cp = vb + (4 * fq) * 136 + 16 * dt + fr;
                            const unsigned e0 = cp[0], e1 = cp[136], e2 = cp[2 * 136], e3 = cp[3 * 136], e4 = cp[16 * 136], e5 = cp[17 * 136], e6 = cp[18 * 136], e7 = cp[19 * 136];
                            const bf16x8 vv = mk8(e0 | (e1 << 16), e2 | (e3 << 16), e4 | (e5 << 16), e6 | (e7 << 16));
                            o[dt][0] = MFMA16(vv, pb[0], o[dt][0]); o[dt][1] = MFMA16(vv, pb[1], o[dt][1]);
                        }
                        asm volatile("s_waitcnt lgkmcnt(0)" ::: "memory");
                        if (__all(Lc[0] <= -104.f && Lc[1] <= -104.f)) break;
                    }
#pragma unroll
                    for (int m = 0; m < 2; ++m)
#pragma unroll
                        for (int dt = 0; dt < 8; ++dt) { u32x2 w; w.x = pk2(o[dt][m][0], o[dt][m][1]); w.y = pk2(o[dt][m][2], o[dt][m][3]);
                            *(u32x2*)(ATT + (rowbase + q0 + 16 * m + fr) * DM + h * 128 + 16 * dt + 4 * fq) = w; }
                }
            }
#endif
            GSYNC();
        }
        { pg8::Gemm g{ATT, WOUT, MTOK, 2048, 2048}; pg8::StaticOrder S; S.init(MTOK, 2048, G, (int)blockIdx.x);
          pg8::EpiResid E{xcur, xres, modl + 4096};
          pg8::gemm_phase<pg8::EpiResid, pg8::StaticOrder, true, true>(L, g, S, E); }
        GSYNC();
        { IDS norm_mod_phase(xres, a.in[6] + layer * DM, modl, 3 * 2048, 4 * 2048, XN, gw, NGW, lane); }
        GSYNC();
        { pg8::Gemm g{XN, WUP, MTOK, DFF2, 2048}; pg8::StaticOrder S; S.init(MTOK, DFF2, G, (int)blockIdx.x);
          pg8::EpiBf16 E{UB, DFF2};
          pg8::gemm_phase<pg8::EpiBf16, pg8::StaticOrder, true, true>(L, g, S, E); }
        GSYNC();
        { IDS conv_gate_phase(UB, a.in[16] + (size_t)layer * 3 * DFF2, a.in[17] + (size_t)layer * DFF2, GB, G, tid); }
        GSYNC();
        { pg8::Gemm g{GB, WDN, MTOK, 2048, DFF}; pg8::StaticOrder S; S.init(MTOK, 2048, G, (int)blockIdx.x);
          pg8::EpiResid E{xres, xres, modl + 5 * 2048};
          pg8::gemm_phase<pg8::EpiResid, pg8::StaticOrder, true, true>(L, g, S, E); }
        GSYNC();
    }
    { IDS
    for (int row = gw; row < MTOK; row += NGW) {
        f32x4* xr = (f32x4*)(xres + (size_t)row * DM) + lane;
        f32x4 v[8]; float ss = 0.f;
#pragma unroll
        for (int j = 0; j < 8; ++j) { v[j] = xr[64 * j]; ss += (v[j].x * v[j].x + v[j].y * v[j].y) + (v[j].z * v[j].z + v[j].w * v[j].w); }
        ss = wave_sum(ss);
        const float r = rsqrtf(ss * (1.f / DM) + EPS);
#pragma unroll
        for (int j = 0; j < 8; ++j) { const f32x4 g4 = *(const f32x4*)(a.in[19] + 4 * (64 * j + lane)); xr[64 * j] = v[j] * r * g4; }
    } }
}

extern "C" void kernel_launch(void* const* d_in, const int* in_sizes, int n_in, void* d_out, int out_size, void* d_ws, size_t ws_size, hipStream_t stream) {
    static int grid = 0;
    if (grid == 0) {
        if (n_in != 20 || out_size != MTOK * DM || ws_size < WS_END) { fprintf(stderr, "kernel_launch: unexpected shapes (n_in %d, out %d, ws %zu)\n", n_in, out_size, ws_size); grid = -1; return; }
        int dev = 0, cus = 0, per_cu = 0;
        hipGetDevice(&dev); hipDeviceGetAttribute(&cus, hipDeviceAttributeMultiprocessorCount, dev);
        if (hipFuncSetAttribute((const void*)mega_fwd, hipFuncAttributeMaxDynamicSharedMemorySize, LDS_BYTES) != hipSuccess) { fprintf(stderr, "kernel_launch: hipFuncSetAttribute failed\n"); grid = -1; return; }
        if (hipOccupancyMaxActiveBlocksPerMultiprocessor(&per_cu, (const void*)mega_fwd, 512, LDS_BYTES) != hipSuccess || per_cu < 1) per_cu = 1;
        (void)hipGetLastError();
        grid = cus * (per_cu > 1 ? 1 : per_cu);
    }
    if (grid < 0) return;
    if (hipMemsetAsync((char*)d_ws + 458752, 0, 256, stream) != hipSuccess) { fprintf(stderr, "memset failed\n"); return; }
    Args a{};
    for (int i = 0; i < 20; ++i) a.in[i] = (const float*)d_in[i];
    a.out = (float*)d_out; a.ws = (unsigned char*)d_ws;
    void* args[] = {&a};
    hipError_t e = hipLaunchCooperativeKernel((const void*)mega_fwd, dim3(grid), dim3(512), args, LDS_BYTES, stream);
    if (e != hipSuccess) fprintf(stderr, "cooperative launch failed: %s (grid %d)\n", hipGetErrorString(e), grid);
}
```

```cpp
#include <hip/hip_runtime.h>
#include <hip/hip_cooperative_groups.h>
#include <cstdio>
#include <cstdint>
namespace cg = cooperative_groups;

namespace pg8 {
#define PG8_LAS __attribute__((address_space(3)))
typedef unsigned short bf16_t;
typedef short bf16x8 __attribute__((ext_vector_type(8)));
typedef float f32x4 __attribute__((ext_vector_type(4)));
typedef unsigned u32x4 __attribute__((ext_vector_type(4)));
constexpr int BM = 256, BK = 64, HALF = 128, HTB = HALF * BK * 2  , STAGE_BYTES = 8 * HTB, NXCD = 8, WGM = 8;

__host__ __device__ __forceinline__ int lds_byte(int r, int c) { const int st = (r >> 4) * 2 + (c >> 5), rr = r & 15, cc = c & 31, ob = rr * 64 + cc * 2; return st * 1024 + (ob ^ (((ob >> 9) & 1) << 5)); }
__host__ __device__ __forceinline__ void stage_rc(int b, int& R, int& C) { const int st = b / 1024, sb = b % 1024, swz = sb ^ (((sb >> 9) & 1) << 5); R = (st >> 1) * 16 + swz / 64; C = (st & 1) * 32 + (swz % 64) / 2; }
__host__ __device__ __forceinline__ int perm32(int rho) { const int n = rho >> 4, i = rho & 15; return 8 * (i >> 2) + 4 * n + (i & 3); }

struct Unit { int pm, pn; };
struct Gemm { const bf16_t* A; const bf16_t* Bt; int M, N, K; };

struct StaticOrder {
    int nM, nN, nwg, G, c;
    __host__ __device__ void init(int M, int N, int G_, int c_) { nM = M / BM; nN = N / BM; nwg = nM * nN; G = G_; c = c_; }
    __host__ __device__ bool next(int i, Unit& u) const {
        const long L = (long)i * G + c; if (L >= nwg) return false;
        int wgid = (int)L; { const int q = nwg / NXCD, r = nwg % NXCD, xcd = wgid % NXCD, off = wgid / NXCD; wgid = (xcd < r ? xcd * (q + 1) : r * (q + 1) + (xcd - r) * q) + off; }
        const int nig = WGM * nN, gid = wgid / nig, fm = gid * WGM, gsz = (nM - fm) < WGM ? (nM - fm) : WGM;
        u.pm = fm + ((wgid % nig) % gsz); u.pn = (wgid % nig) / gsz; return true;
    }
    __device__ __forceinline__ void a_ready(const Unit&) const {}
    __device__ __forceinline__ void done(const Unit&) const {}
};

__device__ __forceinline__ unsigned cvt_pk_bf16(float lo, float hi) { unsigned r; asm volatile("v_cvt_pk_bf16_f32 %0, %1, %2" : "=v"(r) : "v"(lo), "v"(hi)); return r; }
typedef float f32x2 __attribute__((ext_vector_type(2)));
typedef unsigned u32x2v __attribute__((ext_vector_type(2)));
typedef float f32x2c __attribute__((ext_vector_type(2))); typedef __bf16 bf16x2c __attribute__((ext_vector_type(2)));
__device__ __forceinline__ unsigned pkb(float lo, float hi) { f32x2c v = {lo, hi}; bf16x2c b = __builtin_convertvector(v, bf16x2c); return __builtin_bit_cast(unsigned, b); }
struct EpiBf16 {
    static constexpr bool PERM = true, AFTER_DRAIN = false;
    bf16_t* O; int ldc; bf16_t* O2; int o2_pn;
    __device__ __forceinline__ void operator()(const f32x4 (&acc)[2][2][4][2], const Unit& u, int wr, int wc, int fr, int fq) const {
        const int row0 = u.pm * BM + wr * 64 + fr; const int col0 = u.pn * BM + wc * 32 + 8 * fq;
#pragma unroll
        for (int ai = 0; ai < 2; ++ai)
#pragma unroll
            for (int m = 0; m < 4; ++m) { bf16_t* rowp = O + (size_t)(row0 + ai * HALF + m * 16) * ldc + col0;
#pragma unroll
                for (int bj = 0; bj < 2; ++bj) { const f32x4 v0 = acc[ai][bj][m][0], v1 = acc[ai][bj][m][1];
                    u32x4 w; w.x = pkb(v0[0], v0[1]); w.y = pkb(v0[2], v0[3]); w.z = pkb(v1[0], v1[1]); w.w = pkb(v1[2], v1[3]);
                    *(u32x4*)(rowp + bj * HALF) = w;
                    if (O2 != nullptr && bj == 0 && u.pn == o2_pn && wc < 2) *(u32x4*)(O2 + (size_t)(row0 + ai * HALF + m * 16) * 64 + wc * 32 + 8 * fq) = w; } }
    }
};

struct EpiConvGate {
    static constexpr bool PERM = true, AFTER_DRAIN = false;
    bf16_t* Gout; float* HB; const float* cw; const float* cb; PG8_LAS unsigned* halo; mutable int parity;
    __device__ __forceinline__ void operator()(const f32x4 (&acc)[2][2][4][2], const Unit& u, int wr, int wc, int fr_, int fq_) const {
        int fr = fr_, fq = fq_; asm volatile("" : "+v"(fr), "+v"(fq));
        const int lane = fq * 16 + fr;
        PG8_LAS unsigned* hb = halo + (parity & 1) * 2048; PG8_LAS float* wl = (PG8_LAS float*)(hb + 1024); ++parity;
        const int ci = wc * 32 + 8 * fq;
        const int chg = u.pn * 128 + ci;
        { const size_t hrow = (size_t)u.pm * 4 * 11264;
          if (wr == 0 && fr < 2) {
#pragma unroll
              for (int bj = 0; bj < 2; ++bj)
#pragma unroll
                  for (int n = 0; n < 2; ++n) *(f32x4*)(HB + hrow + (size_t)fr * 11264 + bj * 5632 + chg + 4 * n) = acc[0][bj][0][n];
          }
          if (wr == 1 && fr >= 14) {
#pragma unroll
              for (int bj = 0; bj < 2; ++bj)
#pragma unroll
                  for (int n = 0; n < 2; ++n) *(f32x4*)(HB + hrow + (size_t)(2 + fr - 14) * 11264 + bj * 5632 + chg + 4 * n) = acc[1][bj][3][n];
          } }
        unsigned P[2][2][4][2][2];
#pragma unroll
        for (int ai = 0; ai < 2; ++ai)
#pragma unroll
            for (int bj = 0; bj < 2; ++bj)
#pragma unroll
                for (int m = 0; m < 4; ++m)
#pragma unroll
                    for (int n = 0; n < 2; ++n) { P[ai][bj][m][n][0] = pkb(acc[ai][bj][m][n][0], acc[ai][bj][m][n][1]); P[ai][bj][m][n][1] = pkb(acc[ai][bj][m][n][2], acc[ai][bj][m][n][3]); }
        if (fr >= 14) {
#pragma unroll
            for (int ai = 0; ai < 2; ++ai)
#pragma unroll
                for (int bj = 0; bj < 2; ++bj)
#pragma unroll
                    for (int n = 0; n < 2; ++n) { PG8_LAS unsigned* d = hb + ((((ai * 2 + wr) * 2 + (fr - 14)) * 2 + bj) * 64) + (ci >> 1) + 2 * n; d[0] = P[ai][bj][3][n][0]; d[1] = P[ai][bj][3][n][1]; }
        }
        { const int t = (wr * 4 + wc) * 64 + lane;
#pragma unroll
          for (int k = 0; k < 2; ++k) { const int idx = t + 512 * k, tb = idx >> 8, bj = (idx >> 7) & 1, i = idx & 127;
              const float* src = (tb < 3 ? cw + tb * 11264 : cb) + bj * 5632 + u.pn * 128 + i; wl[idx] = *src; } }
        asm volatile("s_waitcnt vmcnt(0) lgkmcnt(0)" ::: "memory"); __builtin_amdgcn_s_barrier(); asm volatile("" ::: "memory");
        const int src1 = (lane & 48) | ((fr + 15) & 15), src2 = (lane & 48) | ((fr + 14) & 15);
        const int pwr = (wr == 1) ? 0 : 1;
        int rowv = u.pm * BM + wr * 64 + fr;
#pragma unroll
        for (int n = 0; n < 2; ++n) {
            unsigned outp[2][4][2];
#pragma unroll
            for (int h = 0; h < 2; ++h) {
                float w0[2][2], w1[2][2], w2[2][2], bb[2][2];
#pragma unroll
                for (int bj = 0; bj < 2; ++bj) { const PG8_LAS float* p0 = wl + bj * 128 + ci + 4 * n + 2 * h;
#pragma unroll
                    for (int q = 0; q < 2; ++q) { w0[bj][q] = p0[q]; w1[bj][q] = p0[256 + q]; w2[bj][q] = p0[512 + q]; bb[bj][q] = p0[768 + q]; } }
#pragma unroll
                for (int ai = 0; ai < 2; ++ai) {
                    const int pai = (wr == 1) ? ai : 0;
                    float cv[2][4][2];
#pragma unroll
                    for (int bj = 0; bj < 2; ++bj) {
                        const PG8_LAS unsigned* hp = hb + ((((pai * 2 + pwr) * 2) * 2 + bj) * 64) + (ci >> 1) + 2 * n + h; const unsigned h1 = hp[128]; const unsigned hh = fr == 0 ? hp[0] : h1;
                        unsigned x[4], r1[4], r2[4];
#pragma unroll
                        for (int m = 0; m < 4; ++m) { x[m] = P[ai][bj][m][n][h]; r1[m] = (unsigned)__builtin_amdgcn_update_dpp(0, (int)x[m], 0x121, 0xf, 0xf, false); r2[m] = (unsigned)__builtin_amdgcn_update_dpp(0, (int)x[m], 0x122, 0xf, 0xf, false); }
#pragma unroll
                        for (int m = 0; m < 4; ++m) {
                            const unsigned p1 = fr >= 1 ? r1[m] : (m >= 1 ? r1[m >= 1 ? m - 1 : 0] : h1);
                            const unsigned p2 = fr >= 2 ? r2[m] : (m >= 1 ? r2[m >= 1 ? m - 1 : 0] : hh);
                            const f32x2 xv = {__uint_as_float(x[m] << 16), __uint_as_float(x[m] & 0xffff0000u)}, p1v = {__uint_as_float(p1 << 16), __uint_as_float(p1 & 0xffff0000u)}, p2v = {__uint_as_float(p2 << 16), __uint_as_float(p2 & 0xffff0000u)};
                            const f32x2 w2v = {w2[bj][0], w2[bj][1]}, w1v = {w1[bj][0], w1[bj][1]}, w0v = {w0[bj][0], w0[bj][1]}, bv2 = {bb[bj][0], bb[bj][1]};
                            const f32x2 c2 = w2v * xv + (w1v * p1v + (w0v * p2v + bv2));
                            cv[bj][m][0] = c2.x; cv[bj][m][1] = c2.y;
                        }
                    }
#pragma unroll
                    for (int m = 0; m < 4; ++m) { const float g0 = cv[0][m][0], g1 = cv[0][m][1];
                        outp[ai][m][h] = pkb(g0 * __builtin_amdgcn_rcpf(1.f + __expf(-g0)) * cv[1][m][0], g1 * __builtin_amdgcn_rcpf(1.f + __expf(-g1)) * cv[1][m][1]); }
                }
            }
            { bf16_t* gp = Gout + (size_t)rowv * 5632 + chg + 4 * n;
#pragma unroll
              for (int ai = 0; ai < 2; ++ai)
#pragma unroll
                for (int m = 0; m < 4; ++m) {
                    if (!(ai == 0 && wr == 0 && m == 0 && fr < 2)) {
                        u32x2v w; w.x = outp[ai][m][0]; w.y = outp[ai][m][1];
                        *(u32x2v*)(gp + (size_t)(ai * HALF + m * 16) * 5632) = w;
                    }
                } }
        }
    }
};
struct EpiResid {
    static constexpr bool PERM = false, AFTER_DRAIN = false;
    const float* base; float* out; const float* gate;
    __device__ __forceinline__ void operator()(const f32x4 (&acc)[2][2][4][2], const Unit& u, int wr, int wc, int fr, int fq) const {
        const int b = (u.pm * BM) >> 12; const int col0 = u.pn * BM + wc * 32 + 4 * fq; const float* gp = gate + (size_t)b * 12288 + col0;
#pragma unroll
        for (int bj = 0; bj < 2; ++bj)
#pragma unroll
            for (int n = 0; n < 2; ++n) { const f32x4 gv = *(const f32x4*)(gp + bj * HALF + n * 16);
                const size_t off0 = (size_t)(u.pm * BM + wr * 64 + fr) * 2048 + col0 + bj * HALF + n * 16;
                f32x4 bs[2][4];
#pragma unroll
                for (int ai = 0; ai < 2; ++ai)
#pragma unroll
                    for (int m = 0; m < 4; ++m) bs[ai][m] = *(const f32x4*)(base + off0 + (size_t)(ai * HALF + m * 16) * 2048);
#pragma unroll
                for (int ai = 0; ai < 2; ++ai)
#pragma unroll
                    for (int m = 0; m < 4; ++m) *(f32x4*)(out + off0 + (size_t)(ai * HALF + m * 16) * 2048) = bs[ai][m] + gv * acc[ai][bj][m][n]; }
    }
};
template <class Epi, class Sched, bool ALIGN_EPI = false, bool SP2 = false>
__device__ __forceinline__ void gemm_phase(PG8_LAS unsigned char* lds, const Gemm g, const Sched& S, const Epi& E) {
    int tid_o = threadIdx.x; asm volatile("" : "+v"(tid_o)); const int tid = tid_o, wid = __builtin_amdgcn_readfirstlane(tid >> 6), lane = tid & 63, wr = wid >> 2, wc = wid & 3, fr = lane & 15, fq = lane >> 4;
    const int K = g.K, nt = K / BK;
    unsigned voffA[2], voffB[2];
#pragma unroll
    for (int i = 0; i < 2; ++i) { int R, C; stage_rc(tid * 16 + i * 8192, R, C); const int Rb = Epi::PERM ? ((R & ~31) + perm32(R & 31)) : R;
        voffA[i] = (unsigned)(R * K + C) * 2u; voffB[i] = (unsigned)(Rb * K + C) * 2u; }
    const size_t kstep = (size_t)(BK * 2);
    const size_t hstep = (size_t)HALF * K * 2;
    const size_t tstep = 2 * hstep;
    const unsigned ldsw = (unsigned)wid * 1024u;
    const int aoff = lds_byte(wr * 64 + fr, fq * 8), boff = lds_byte(wc * 32 + fr, fq * 8);
#define PG8_SA(b, h) (((b) * 2 + (h)) * HTB)
#define PG8_SB(b, h) ((4 + (b) * 2 + (h)) * HTB)
#define PG8_STAGE(bufoff, gbase, voff) do { _Pragma("unroll") for (int _i = 0; _i < 2; ++_i) \
        __builtin_amdgcn_global_load_lds((const unsigned*)((const char*)(gbase) + (voff)[_i]), (PG8_LAS unsigned*)(lds + (bufoff) + ldsw + _i * 8192), 16, 0, 0); } while (0)
#define PG8_LDA(dst, b, h) do { _Pragma("unroll") for (int m = 0; m < 4; ++m) _Pragma("unroll") for (int k = 0; k < 2; ++k) dst[m][k] = *(const PG8_LAS bf16x8*)(lds + PG8_SA(b, h) + aoff + m * 2048 + k * 1024); } while (0)
#define PG8_LDB(dst, b, h) do { _Pragma("unroll") for (int n = 0; n < 2; ++n) _Pragma("unroll") for (int k = 0; k < 2; ++k) dst[n][k] = *(const PG8_LAS bf16x8*)(lds + PG8_SB(b, h) + boff + n * 2048 + k * 1024); } while (0)
#define PG8_MMA(ai, bj, At, Bt) do { __builtin_amdgcn_s_setprio(1); _Pragma("unroll") for (int m = 0; m < 4; ++m) _Pragma("unroll") for (int n = 0; n < 2; ++n) _Pragma("unroll") for (int k = 0; k < 2; ++k) \
        acc[ai][bj][m][n] = __builtin_amdgcn_mfma_f32_16x16x32_bf16(Bt[n][k], At[m][k], acc[ai][bj][m][n], 0, 0, 0); __builtin_amdgcn_s_setprio(0); } while (0)
#define PG8_WAIT_V(n) asm volatile("s_waitcnt vmcnt(" #n ")" ::: "memory")
#define PG8_WAIT_L(n) asm volatile("s_waitcnt lgkmcnt(" #n ")" ::: "memory")
#define PG8_BAR __builtin_amdgcn_s_barrier()
#define PG8_SCHED __builtin_amdgcn_sched_barrier(0)
    Unit cur, nxt; int ui = 0;
    if (!S.next(0, cur)) return;
    f32x4 acc[2][2][4][2];
#pragma unroll
    for (int a = 0; a < 2; ++a)
#pragma unroll
        for (int b = 0; b < 2; ++b)
#pragma unroll
            for (int m = 0; m < 4; ++m)
#pragma unroll
                for (int n = 0; n < 2; ++n) acc[a][b][m][n] = (f32x4){0.f, 0.f, 0.f, 0.f};
    bf16x8 At[4][2], B0[2][2], B1[2][2];
    const char* cA = (const char*)g.A + (size_t)cur.pm * tstep; const char* cB = (const char*)g.Bt + (size_t)cur.pn * tstep;
    S.a_ready(cur);
    if constexpr (SP2) {
        PG8_STAGE(PG8_SB(0, 0), cB, voffB); PG8_STAGE(PG8_SB(0, 1), cB + hstep, voffB); PG8_STAGE(PG8_SA(0, 0), cA, voffA); PG8_STAGE(PG8_SA(0, 1), cA + hstep, voffA);
        if (wr == 1) PG8_BAR;
        PG8_WAIT_V(2); PG8_BAR;
        PG8_STAGE(PG8_SB(1, 0), cB + kstep, voffB); PG8_STAGE(PG8_SA(1, 0), cA + kstep, voffA); PG8_STAGE(PG8_SB(1, 1), cB + hstep + kstep, voffB);
        PG8_WAIT_V(6); PG8_BAR;
    } else {
        PG8_STAGE(PG8_SB(0, 0), cB, voffB); PG8_STAGE(PG8_SA(0, 0), cA, voffA); PG8_STAGE(PG8_SB(0, 1), cB + hstep, voffB); PG8_STAGE(PG8_SA(0, 1), cA + hstep, voffA);
        if (wr == 1) PG8_BAR;
        PG8_WAIT_V(4); PG8_BAR;
        PG8_STAGE(PG8_SB(1, 0), cB + kstep, voffB); PG8_STAGE(PG8_SA(1, 0), cA + kstep, voffA); PG8_STAGE(PG8_SB(1, 1), cB + hstep + kstep, voffB);
        PG8_WAIT_V(6); PG8_BAR;
    }
    for (;;) {
        const bool has_next = S.next(ui + 1, nxt);
        const char* nA = has_next ? (const char*)g.A + (size_t)nxt.pm * tstep : cA; const char* nB = has_next ? (const char*)g.Bt + (size_t)nxt.pn * tstep : cB;
        for (int t = 0; t < nt; t += 2) {
            const bool last = (t == nt - 2);
            const char* a1 = cA + (size_t)(t + 1) * kstep;
            const char* a2 = last ? nA : cA + (size_t)(t + 2) * kstep; const char* b2 = last ? nB : cB + (size_t)(t + 2) * kstep;
            const char* a3 = a2 + kstep; const char* b3 = b2 + kstep;
            if (last && has_next) S.a_ready(nxt);
            if constexpr (SP2) {
            PG8_LDB(B0, 0, 0); PG8_LDB(B1, 0, 1); PG8_SCHED; PG8_LDA(At, 0, 0); PG8_STAGE(PG8_SA(1, 1), a1 + hstep, voffA);
            PG8_WAIT_V(8); PG8_WAIT_L(0); PG8_BAR; PG8_MMA(0, 0, At, B0); PG8_MMA(0, 1, At, B1); PG8_BAR; PG8_SCHED;
            PG8_LDA(At, 0, 1); PG8_STAGE(PG8_SB(0, 0), b2, voffB); PG8_STAGE(PG8_SB(0, 1), b2 + hstep, voffB); PG8_STAGE(PG8_SA(0, 0), a2, voffA);
            PG8_WAIT_V(8); PG8_WAIT_L(0); PG8_BAR; PG8_MMA(1, 0, At, B0); PG8_MMA(1, 1, At, B1); PG8_BAR; PG8_SCHED;
            PG8_LDB(B0, 1, 0); PG8_LDB(B1, 1, 1); PG8_SCHED; PG8_LDA(At, 1, 0); PG8_STAGE(PG8_SA(0, 1), a2 + hstep, voffA);
            PG8_WAIT_V(8); PG8_WAIT_L(0); PG8_BAR; PG8_MMA(0, 0, At, B0); PG8_MMA(0, 1, At, B1); PG8_BAR; PG8_SCHED;
            PG8_LDA(At, 1, 1); PG8_STAGE(PG8_SB(1, 0), b3, voffB); PG8_STAGE(PG8_SB(1, 1), b3 + hstep, voffB); PG8_STAGE(PG8_SA(1, 0), a3, voffA);
            PG8_WAIT_V(8); PG8_WAIT_L(0); PG8_BAR; PG8_MMA(1, 0, At, B0); PG8_MMA(1, 1, At, B1); PG8_BAR; PG8_SCHED;
            } else {
            PG8_LDB(B0, 0, 0); PG8_SCHED; PG8_LDA(At, 0, 0); PG8_STAGE(PG8_SA(1, 1), a1 + hstep, voffA);
            PG8_WAIT_L(8); PG8_BAR; PG8_WAIT_L(0); PG8_MMA(0, 0, At, B0); PG8_BAR; PG8_SCHED;
            PG8_LDB(B1, 0, 1); PG8_STAGE(PG8_SB(0, 0), b2, voffB);
            PG8_BAR; PG8_WAIT_L(0); PG8_MMA(0, 1, At, B1); PG8_BAR;
            PG8_LDA(At, 0, 1); PG8_STAGE(PG8_SA(0, 0), a2, voffA);
            PG8_BAR; PG8_WAIT_L(0); PG8_MMA(1, 0, At, B0); PG8_BAR; PG8_SCHED;
            PG8_STAGE(PG8_SB(0, 1), b2 + hstep, voffB);
            PG8_WAIT_V(6); PG8_BAR; PG8_MMA(1, 1, At, B1); PG8_BAR;
            PG8_LDB(B0, 1, 0); PG8_SCHED; PG8_LDA(At, 1, 0); PG8_STAGE(PG8_SA(0, 1), a2 + hstep, voffA);
            PG8_WAIT_L(8); PG8_BAR; PG8_WAIT_L(0); PG8_MMA(0, 0, At, B0); PG8_BAR; PG8_SCHED;
            PG8_LDB(B1, 1, 1); PG8_STAGE(PG8_SB(1, 0), b3, voffB);
            PG8_BAR; PG8_WAIT_L(0); PG8_MMA(0, 1, At, B1); PG8_BAR;
            PG8_LDA(At, 1, 1); PG8_STAGE(PG8_SA(1, 0), a3, voffA);
            PG8_BAR; PG8_WAIT_L(0); PG8_MMA(1, 0, At, B0); PG8_BAR; PG8_SCHED;
            PG8_STAGE(PG8_SB(1, 1), b3 + hstep, voffB);
            PG8_WAIT_V(6); PG8_BAR; PG8_MMA(1, 1, At, B1); PG8_BAR;
            }
        }
        if constexpr (ALIGN_EPI) { if (wr == 0) PG8_BAR; }
        if constexpr (!Epi::AFTER_DRAIN) { E(acc, cur, wr, wc, fr, fq); S.done(cur); }
        if (!has_next) break;
#pragma unroll
        for (int a = 0; a < 2; ++a)
#pragma unroll
            for (int b = 0; b < 2; ++b)
#pragma unroll
                for (int m = 0; m < 4; ++m)
#pragma unroll
                    for (int n = 0; n < 2; ++n) acc[a][b][m][n] = (f32x4){0.f, 0.f, 0.f, 0.f};
        cur = nxt; cA = nA; cB = nB; ++ui;
        if constexpr (ALIGN_EPI) { if (wr == 1) PG8_BAR; }
    }
    PG8_WAIT_V(0);
    if constexpr (!ALIGN_EPI) { if (wr == 0) PG8_BAR; }
    PG8_BAR;
    if constexpr (Epi::AFTER_DRAIN) { E.fused(acc, cur, wr, wc, fr, fq, lds, wid, lane); S.done(cur); }
#undef PG8_SA
#undef PG8_SB
#undef PG8_STAGE
#undef PG8_LDA
#undef PG8_LDB
#undef PG8_MMA
#undef PG8_WAIT_V
#undef PG8_WAIT_L
#undef PG8_BAR
#undef PG8_SCHED
}
}

constexpr int NB = 4, SEQ = 4096, DM = 2048, MTOK = NB * SEQ;
constexpr int EV_PITCH = 3584, EV_IN = 3400, OD_PITCH = 6144, DFF = 5632, DFF2 = 11264;
constexpr int C_QA = 0, C_KA = 1024, C_VA = 1280, C_QB = 1536, C_CLAT = 2560, C_QI = 2816, C_KI = 3328, C_WI = 3392;
constexpr float EPS = 1e-6f;
constexpr float SB_CUT = 4.0e-18f;
constexpr size_t MiB = 1u << 20;
constexpr size_t WS_MOD = 0, WS_WUKT = 512 * 1024, WS_WUVT = 1 * MiB, WS_WIN = 2 * MiB, WS_WOUT = 26 * MiB, WS_WUP = 34 * MiB, WS_WDN = 78 * MiB,
                 WS_XN = 100 * MiB, WS_BIG = 164 * MiB, WS_QLAT = 276 * MiB, WS_G = 516 * MiB, WS_ATT = 516 * MiB, WS_CKV = 580 * MiB,
                 WS_IDX = 588 * MiB, WS_CNT = 604 * MiB, WS_END = 692 * MiB;
constexpr int LDS_BYTES = 156672;
#ifndef DIAG
#define DIAG 0
#endif
#ifndef DUP_UP
#define DUP_UP 0
#endif
#ifndef DUP_CONV
#define DUP_CONV 0
#endif
#ifndef DUP_P3
#define DUP_P3 0
#endif
#ifndef DUP_IDX
#define DUP_IDX 0
#endif
#ifndef SKIP_SWA
#define SKIP_SWA 0
#endif
#ifndef SKIP_DSA
#define SKIP_DSA 0
#endif
#ifndef SKIP_SB
#define SKIP_SB 0
#endif

typedef unsigned short bf16_t;
typedef short bf16x8 __attribute__((ext_vector_type(8)));
typedef float f32x4 __attribute__((ext_vector_type(4)));
typedef unsigned u32x4 __attribute__((ext_vector_type(4)));
typedef unsigned u32x2 __attribute__((ext_vector_type(2)));
#define LAS __attribute__((address_space(3)))
#define MFMA16(a, b, c) __builtin_amdgcn_mfma_f32_16x16x32_bf16((a), (b), (c), 0, 0, 0)

typedef float f32x2_t __attribute__((ext_vector_type(2))); typedef __bf16 bf16x2_t __attribute__((ext_vector_type(2)));
__device__ __forceinline__ unsigned pk2(float lo, float hi) { f32x2_t v = {lo, hi}; bf16x2_t b = __builtin_convertvector(v, bf16x2_t); return __builtin_bit_cast(unsigned, b); }
__device__ __forceinline__ float bflo(unsigned w) { return __uint_as_float(w << 16); }
__device__ __forceinline__ float bfhi(unsigned w) { return __uint_as_float(w & 0xffff0000u); }
__device__ __forceinline__ float wave_sum(float v) {
#pragma unroll
    for (int o = 1; o < 64; o <<= 1) v += __shfl_xor(v, o);
    return v;
}
__device__ __forceinline__ int wave_sum_i(int v) {
#pragma unroll
    for (int o = 1; o < 64; o <<= 1) v += __shfl_xor(v, o);
    return v;
}
__device__ __forceinline__ int t5_bucket(int rel) {
    const int n = rel < 0 ? -rel : rel; int v = n;
    if (n >= 8) v = 8 + (n >= 12) + (n >= 16) + (n >= 23) + (n >= 32) + (n >= 46) + (n >= 64) + (n >= 91);
    return (rel > 0 ? 16 : 0) + v;
}
typedef short s16x4_t __attribute__((ext_vector_type(4)));
__device__ __forceinline__ s16x4_t lds_tr4(const LAS bf16_t* p) { return __builtin_bit_cast(s16x4_t, __builtin_amdgcn_ds_read_tr16_b64_v4i16((LAS s16x4_t*)p)); }
__device__ __forceinline__ bf16x8 mk8(unsigned a, unsigned b, unsigned c, unsigned d) { u32x4 w; w.x = a; w.y = b; w.z = c; w.w = d; return __builtin_bit_cast(bf16x8, w); }

struct Args { const float* in[20]; float* out; unsigned char* ws; };

template <int ROWMAP> __device__ __forceinline__ void transpose_item(const float* W, int K, int N, bf16_t* WT, LAS float* scr, int item, int nblk, int lane) {
    const int kb = item / nblk, nb = item % nblk, k0 = 64 * kb, n0 = 64 * nb; const int nc = n0 + lane;
    float v[64];
#pragma unroll
    for (int i = 0; i < 64; ++i) v[i] = (nc < N) ? W[(size_t)(k0 + i) * N + nc] : 0.f;
#pragma unroll
    for (int i = 0; i < 64; ++i) scr[i * 65 + lane] = v[i];
    asm volatile("s_waitcnt lgkmcnt(0)" ::: "memory");
    const int c = lane & 7;
#pragma unroll
    for (int j = 0; j < 8; ++j) { const int n = (lane >> 3) + 8 * j; const LAS float* s = scr + (8 * c) * 65 + n;
        u32x4 o; o.x = pk2(s[0 * 65], s[1 * 65]); o.y = pk2(s[2 * 65], s[3 * 65]); o.z = pk2(s[4 * 65], s[5 * 65]); o.w = pk2(s[6 * 65], s[7 * 65]);
        int d = n0 + n; if (ROWMAP) { const int sc_ = d < DFF ? d : d - DFF; d = (sc_ >> 7) * 256 + (d < DFF ? 0 : 128) + (sc_ & 127); }
        *(u32x4*)(WT + (size_t)d * K + k0 + 8 * c) = o; }
    asm volatile("s_waitcnt lgkmcnt(0)" ::: "memory");
}
template <int ROWMAP = 0> __device__ __forceinline__ void convert_matrix(const float* W, int K, int N, int Npad, bf16_t* WT, LAS float* scr, int gw, int NGW, int lane) {
    const int nblk = Npad / 64, nitems = (K / 64) * nblk;
    for (int it = gw; it < nitems; it += NGW) transpose_item<ROWMAP>(W, K, N, WT, scr, it, nblk, lane);
}

__device__ __forceinline__ void norm_mod_phase(const float* xin, const float* g, const float* modl, int sh_off, int sc_off, bf16_t* XN, int gw, int NGW, int lane) {
    for (int row = gw; row < MTOK; row += 2 * NGW) {
        const int row2 = row + NGW;
        const f32x4* xr = (const f32x4*)(xin + (size_t)row * DM) + lane; const f32x4* xr2 = (const f32x4*)(xin + (size_t)row2 * DM) + lane;
        f32x4 v[8], v2[8]; float ss = 0.f, ss2 = 0.f;
#pragma unroll
        for (int j = 0; j < 8; ++j) { v[j] = xr[64 * j]; v2[j] = xr2[64 * j]; }
#pragma unroll
        for (int j = 0; j < 8; ++j) { ss += (v[j].x * v[j].x + v[j].y * v[j].y) + (v[j].z * v[j].z + v[j].w * v[j].w); ss2 += (v2[j].x * v2[j].x + v2[j].y * v2[j].y) + (v2[j].z * v2[j].z + v2[j].w * v2[j].w); }
        ss = wave_sum(ss); ss2 = wave_sum(ss2);
        const float r = rsqrtf(ss * (1.f / DM) + EPS), r2 = rsqrtf(ss2 * (1.f / DM) + EPS);
        const float* mb = modl + (size_t)(row >> 12) * 12288; const float* mb2 = modl + (size_t)(row2 >> 12) * 12288;
#pragma unroll
        for (int j = 0; j < 8; ++j) { const int col = 4 * (64 * j + lane);
            const f32x4 g4 = *(const f32x4*)(g + col);
            { const f32x4 sc = *(const f32x4*)(mb + sc_off + col), sh = *(const f32x4*)(mb + sh_off + col);
              const f32x4 y = v[j] * r * g4; const f32x4 h = y * (sc + 1.f) + sh;
              u32x2 w; w.x = pk2(h.x, h.y); w.y = pk2(h.z, h.w); *(u32x2*)(XN + (size_t)row * DM + col) = w; }
            { const f32x4 sc = *(const f32x4*)(mb2 + sc_off + col), sh = *(const f32x4*)(mb2 + sh_off + col);
              const f32x4 y = v2[j] * r2 * g4; const f32x4 h = y * (sc + 1.f) + sh;
              u32x2 w; w.x = pk2(h.x, h.y); w.y = pk2(h.z, h.w); *(u32x2*)(XN + (size_t)row2 * DM + col) = w; } }
    }
}

__device__ __forceinline__ void conv_gate_phase(const bf16_t* U, const float* cw, const float* cb, bf16_t* Gout, int G, int tid) {
    for (int item = blockIdx.x * 512 + tid; item < 1024 * 704; item += G * 512) {
        const int cg8 = item % 704, run = item / 704; const int row0 = run * 16, c0 = cg8 * 8; const bool first = (row0 & 4095) == 0;
        float wg[3][8], wv[3][8], bg[8], bv[8];
#pragma unroll
        for (int j = 0; j < 3; ++j) {
            const f32x4 a0 = *(const f32x4*)(cw + j * DFF2 + c0), a1 = *(const f32x4*)(cw + j * DFF2 + c0 + 4);
            const f32x4 b0 = *(const f32x4*)(cw + j * DFF2 + DFF + c0), b1 = *(const f32x4*)(cw + j * DFF2 + DFF + c0 + 4);
#pragma unroll
            for (int e = 0; e < 4; ++e) { wg[j][e] = a0[e]; wg[j][4 + e] = a1[e]; wv[j][e] = b0[e]; wv[j][4 + e] = b1[e]; }
        }
        { const f32x4 a0 = *(const f32x4*)(cb + c0), a1 = *(const f32x4*)(cb + c0 + 4), b0 = *(const f32x4*)(cb + DFF + c0), b1 = *(const f32x4*)(cb + DFF + c0 + 4);
#pragma unroll
          for (int e = 0; e < 4; ++e) { bg[e] = a0[e]; bg[4 + e] = a1[e]; bv[e] = b0[e]; bv[4 + e] = b1[e]; } }
        float g2[8], g1[8], v2[8], v1[8];
#pragma unroll
        for (int e = 0; e < 8; ++e) { g2[e] = 0.f; g1[e] = 0.f; v2[e] = 0.f; v1[e] = 0.f; }
        if (!first) {
            const u32x4 a = *(const u32x4*)(U + (size_t)(row0 - 2) * DFF2 + c0), b = *(const u32x4*)(U + (size_t)(row0 - 2) * DFF2 + DFF + c0);
            const u32x4 c = *(const u32x4*)(U + (size_t)(row0 - 1) * DFF2 + c0), d = *(const u32x4*)(U + (size_t)(row0 - 1) * DFF2 + DFF + c0);
#pragma unroll
            for (int e = 0; e < 4; ++e) { g2[2 * e] = bflo(a[e]); g2[2 * e + 1] = bfhi(a[e]); v2[2 * e] = bflo(b[e]); v2[2 * e + 1] = bfhi(b[e]);
                                          g1[2 * e] = bflo(c[e]); g1[2 * e + 1] = bfhi(c[e]); v1[2 * e] = bflo(d[e]); v1[2 * e + 1] = bfhi(d[e]); }
        }
#pragma unroll 8
        for (int t = 0; t < 16; ++t) {
            const u32x4 a = *(const u32x4*)(U + (size_t)(row0 + t) * DFF2 + c0), b = *(const u32x4*)(U + (size_t)(row0 + t) * DFF2 + DFF + c0);
            float gc[8], vc[8], r[8];
#pragma unroll
            for (int e = 0; e < 4; ++e) { gc[2 * e] = bflo(a[e]); gc[2 * e + 1] = bfhi(a[e]); vc[2 * e] = bflo(b[e]); vc[2 * e + 1] = bfhi(b[e]); }
#pragma unroll
            for (int e = 0; e < 8; ++e) {
                const float gg = wg[0][e] * g2[e] + wg[1][e] * g1[e] + wg[2][e] * gc[e] + bg[e];
                const float vv = wv[0][e] * v2[e] + wv[1][e] * v1[e] + wv[2][e] * vc[e] + bv[e];
                r[e] = gg / (1.f + __expf(-gg)) * vv;
                g2[e] = g1[e]; g1[e] = gc[e]; v2[e] = v1[e]; v1[e] = vc[e];
            }
            u32x4 o; o.x = pk2(r[0], r[1]); o.y = pk2(r[2], r[3]); o.z = pk2(r[4], r[5]); o.w = pk2(r[6], r[7]);
            *(u32x4*)(Gout + (size_t)(row0 + t) * DFF + c0) = o;
        }
    }
}

#define XB_TMO      128
#define XB_XCNT(j)  (256  + 64 * (j))
#define XB_XSUB(j)  (1280 + 64 * (j))
#define XB_XGEN(j)  (2304 + 64 * (j))
#define XB_TOP      3328
#define XB_TOPGEN   3392
#define XCD_BAR_WORDS 3456
#define XB_SPIN_CAP (1u << 18)

__device__ __forceinline__ unsigned xb_ld(unsigned* p)              { return __hip_atomic_load(p, __ATOMIC_RELAXED, __HIP_MEMORY_SCOPE_AGENT); }
__device__ __forceinline__ unsigned xb_add(unsigned* p, unsigned v) { return __hip_atomic_fetch_add(p, v, __ATOMIC_RELAXED, __HIP_MEMORY_SCOPE_AGENT); }
__device__ __forceinline__ unsigned xb_xcc_id() { return (unsigned)__builtin_amdgcn_s_getreg((3 << 11) | 20) & 0xFu; }
#define XB_SPIN(cond, bar) do { unsigned _sp = 0; while (cond) { __builtin_amdgcn_s_sleep(1); \
    if ((++_sp & 255u) == 0u) { if (xb_ld(&(bar)[XB_TMO])) break; if (_sp > XB_SPIN_CAP) { atomicAdd(&(bar)[XB_TMO], 1u); break; } } } } while (0)

struct XcdBarrier {
    unsigned* bar; unsigned x;
    volatile LAS unsigned* st;
};

__device__ __forceinline__ XcdBarrier xcd_barrier_post(unsigned* bar, volatile LAS unsigned* st) {
    XcdBarrier b; b.bar = bar; b.x = (unsigned)__builtin_amdgcn_readfirstlane((int)xb_xcc_id()); b.st = st;
    if (threadIdx.x == 0) (void)xb_add(&bar[XB_XCNT(b.x)], 1u);
    return b;
}
__device__ __forceinline__ void xcd_barrier_complete(unsigned* bar, unsigned x, unsigned& nloc, unsigned& nx) {
    const unsigned G = gridDim.x * gridDim.y * gridDim.z;
    unsigned sum, cnt, mine, sp = 0u;
    for (;;) {
        sum = 0u; cnt = 0u; mine = 0u;
#pragma unroll
        for (unsigned j = 0; j < 16; ++j) { const unsigned c = xb_ld(&bar[XB_XCNT(j)]); sum += c; cnt += (c > 0u) ? 1u : 0u; mine = (j == x) ? c : mine; }
        if (sum == G) break;
        __builtin_amdgcn_s_sleep(1);
        if ((++sp & 255u) == 0u) { if (xb_ld(&bar[XB_TMO])) break; if (sp > XB_SPIN_CAP) { atomicAdd(&bar[XB_TMO], 1u); break; } }
    }
    nloc = mine > 0u ? mine : 1u; nx = cnt > 0u ? cnt : 1u;
}

__device__ __forceinline__ void xcd_barrier(const XcdBarrier& b) {
    asm volatile("s_waitcnt vmcnt(0)" ::: "memory");
    __syncthreads();
    if (threadIdx.x == 0) {
        unsigned* bar = b.bar;
        __builtin_amdgcn_s_waitcnt(0);
        unsigned nloc = b.st[0], nx = b.st[1];
        if (nloc == 0u) { xcd_barrier_complete(bar, b.x, nloc, nx); b.st[0] = nloc; b.st[1] = nx; }
        const unsigned old = xb_add(&bar[XB_XSUB(b.x)], 1u);
        const unsigned gen = old / nloc;
        if (old + 1u == (gen + 1u) * nloc) {
            __builtin_amdgcn_fence(__ATOMIC_RELEASE, "agent");
            asm volatile("s_waitcnt vmcnt(0)" ::: "memory");
            const unsigned og = xb_add(&bar[XB_TOP], 1u);
            const unsigned tg = og / nx;
            if (og + 1u == (tg + 1u) * nx) xb_add(&bar[XB_TOPGEN], 1u);
            else XB_SPIN(xb_ld(&bar[XB_TOPGEN]) == tg, bar);
            __builtin_amdgcn_fence(__ATOMIC_ACQUIRE, "agent");
            xb_add(&bar[XB_XGEN(b.x)], 1u);
            asm volatile("s_waitcnt vmcnt(0)" ::: "memory");
        } else {
            XB_SPIN(xb_ld(&bar[XB_XGEN(b.x)]) == gen, bar);
            __builtin_amdgcn_fence(__ATOMIC_ACQUIRE, "agent");
            asm volatile("s_waitcnt vmcnt(0)" ::: "memory");
        }
    }
    __syncthreads();
}

__global__ void __launch_bounds__(512, 2) mega_fwd(Args a) {
    extern __shared__ __attribute__((aligned(16))) unsigned char lds[];
    cg::grid_group grid = cg::this_grid();
    LAS unsigned char* L = (LAS unsigned char*)lds;
    const int G = gridDim.x, NGW = G * 8;
    { LAS unsigned* mz = (LAS unsigned*)(L + 155648); if (threadIdx.x < 16) mz[threadIdx.x] = 0u; }
    __syncthreads();
    const XcdBarrier xbar = xcd_barrier_post((unsigned*)(a.ws + 458752), (volatile LAS unsigned*)(L + 155648));
#if DIAG
    unsigned long long* TS = (unsigned long long*)(a.ws + 460800); int ts_n = 0;
#define TSTAMP() do { if (blockIdx.x == 0 && threadIdx.x == 0) TS[ts_n] = __builtin_amdgcn_s_memrealtime(); ++ts_n; } while (0)
#else
#define TSTAMP() do { } while (0)
#endif
#define GSYNC() do { XcdBarrier xb2_; xb2_.bar = (unsigned*)(a.ws + 458752); { unsigned xx_ = xbar.x; asm volatile("" : "+s"(xx_)); xb2_.x = xx_; } xb2_.st = (volatile LAS unsigned*)(L + 155648); xcd_barrier(xb2_); TSTAMP(); } while (0)
#define IDS int tid = threadIdx.x; asm volatile("" : "+v"(tid)); const int lane = tid & 63, wave = __builtin_amdgcn_readfirstlane(tid >> 6), fr = lane & 15, fq = lane >> 4; const int gw = blockIdx.x * 8 + wave; (void)fr; (void)fq; (void)gw; (void)lane; \
            LAS float* scr = (LAS float*)(L + wave * 16640); (void)scr;
    unsigned char* ws = a.ws;
    float* MOD = (float*)(ws + WS_MOD);
    bf16_t* WUKT = (bf16_t*)(ws + WS_WUKT); bf16_t* WUVT = (bf16_t*)(ws + WS_WUVT);
    bf16_t* WIN = (bf16_t*)(ws + WS_WIN); bf16_t* WOUT = (bf16_t*)(ws + WS_WOUT); bf16_t* WUP = (bf16_t*)(ws + WS_WUP); bf16_t* WDN = (bf16_t*)(ws + WS_WDN);
    bf16_t* XN = (bf16_t*)(ws + WS_XN); bf16_t* PROJ = (bf16_t*)(ws + WS_BIG); bf16_t* UB = (bf16_t*)(ws + WS_BIG); bf16_t* QLAT = (bf16_t*)(ws + WS_QLAT);
    bf16_t* GB = (bf16_t*)(ws + WS_G); bf16_t* ATT = (bf16_t*)(ws + WS_ATT); bf16_t* CKV = (bf16_t*)(ws + WS_CKV);
    int* IDX = (int*)(ws + WS_IDX); int* CNT = (int*)(ws + WS_CNT); float* HBUF = (float*)(ws + WS_BIG); bf16_t* KIC = (bf16_t*)(ws + WS_CNT + MiB);
    const float* x_in = a.in[0]; const float* rel_bias = a.in[2];
    float* xres = a.out;

    grid.sync();
    TSTAMP();
    {
        IDS
        LAS float* cs = (LAS float*)L; LAS float* red = cs + 8192;
        for (int it = blockIdx.x; it < 256; it += G) {
            const int i = it >> 7, jc = it & 127;
            for (int idx = tid; idx < 8192; idx += 512) { const float v = a.in[1][idx]; cs[idx] = v / (1.f + expf(-v)); }
            __syncthreads();
            if (tid < 384) {
                const int cq = tid % 24, kg = tid / 24;
                const float* w = a.in[3] + (size_t)i * 2048 * 12288 + jc * 96 + cq * 4;
                f32x4 ac[4];
#pragma unroll
                for (int b = 0; b < 4; ++b) ac[b] = (f32x4){0.f, 0.f, 0.f, 0.f};
#pragma unroll 8
                for (int kk = 0; kk < 128; ++kk) { const int k = kg * 128 + kk; const f32x4 wv = *(const f32x4*)(w + (size_t)k * 12288);
#pragma unroll
                    for (int b = 0; b < 4; ++b) ac[b] += wv * cs[b * 2048 + k]; }
#pragma unroll
                for (int b = 0; b < 4; ++b) *(LAS f32x4*)(red + (kg * 4 + b) * 96 + cq * 4) = ac[b];
            }
            __syncthreads();
            if (tid < 384) { const int b = tid / 96, col = tid % 96; float s = a.in[4][i * 12288 + jc * 96 + col];
#pragma unroll
              for (int k2 = 0; k2 < 16; ++k2) s += red[(k2 * 4 + b) * 96 + col];
              MOD[(size_t)(i * 4 + b) * 12288 + jc * 96 + col] = s; }
            __syncthreads();
        }
        convert_matrix(a.in[7], 2048, EV_IN, EV_PITCH, WIN, scr, gw, NGW, lane);
        convert_matrix(a.in[12], 2048, 2048, 2048, WOUT, scr, gw, NGW, lane);
        convert_matrix<1>(a.in[15], 2048, DFF2, DFF2, WUP, scr, gw, NGW, lane);
        convert_matrix(a.in[18], DFF, 2048, 2048, WDN, scr, gw, NGW, lane);
        for (int h = 0; h < 16; ++h) {
            convert_matrix(a.in[9] + (size_t)h * 64 * 256, 64, 256, 256, WUKT + (size_t)h * 256 * 64, scr, gw, NGW, lane);
            convert_matrix(a.in[10] + (size_t)h * 256 * 64, 256, 64, 64, WUVT + (size_t)h * 64 * 256, scr, gw, NGW, lane);
        }
    }
    GSYNC();

#pragma unroll
    for (int layer = 0; layer < 2; ++layer) {
        const float* modl = MOD + (size_t)layer * 4 * 12288;
        const float* xcur = (layer == 0) ? x_in : (const float*)xres;
        { IDS
        norm_mod_phase(xcur, a.in[5] + layer * DM, modl, 0, 2048, XN, gw, NGW, lane);
        if (layer == 1) {
            convert_matrix(a.in[13], 2048, OD_PITCH, OD_PITCH, WIN, scr, gw, NGW, lane);
            convert_matrix(a.in[14], 2048, 2048, 2048, WOUT, scr, gw, NGW, lane);
            convert_matrix<1>(a.in[15] + (size_t)2048 * DFF2, 2048, DFF2, DFF2, WUP, scr, gw, NGW, lane);
            convert_matrix(a.in[18] + (size_t)DFF * 2048, DFF, 2048, 2048, WDN, scr, gw, NGW, lane);
        } }
        GSYNC();
#if SKIP_SWA || SKIP_DSA || SKIP_SB
        { IDS for (size_t i = (size_t)blockIdx.x * 512 + tid; i < (size_t)MTOK * DM / 8; i += (size_t)G * 512) ((u32x4*)ATT)[i] = (u32x4){0u, 0u, 0u, 0u}; }
#endif
        if (layer == 0) {
            { pg8::Gemm g{XN, WIN, MTOK, EV_PITCH, 2048}; pg8::StaticOrder S; S.init(MTOK, EV_PITCH, G, (int)blockIdx.x);
              pg8::EpiBf16 E{PROJ, EV_PITCH, KIC, C_KI / 256};
              pg8::gemm_phase<pg8::EpiBf16, pg8::StaticOrder, true, true>(L, g, S, E); }
            GSYNC();
            { IDS
            for (int row = gw; row < MTOK; row += NGW) {
                const u32x2 w = *(const u32x2*)(PROJ + (size_t)row * EV_PITCH + C_CLAT + 4 * lane);
                const float x0 = bflo(w.x), x1 = bfhi(w.x), x2 = bflo(w.y), x3 = bfhi(w.y);
                const float ss = wave_sum((x0 * x0 + x1 * x1) + (x2 * x2 + x3 * x3));
                const float r = rsqrtf(ss * (1.f / 256.f) + EPS);
                const f32x4 g4 = *(const f32x4*)(a.in[8] + 4 * lane);
                u32x2 o; o.x = pk2(x0 * r * g4.x, x1 * r * g4.y); o.y = pk2(x2 * r * g4.z, x3 * r * g4.w);
                *(u32x2*)(CKV + (size_t)row * 256 + 4 * lane) = o;
            } }
            { IDS
            for (int unit = gw; unit < 16384; unit += NGW) {
                const int h = unit & 15, t0 = (unit >> 4) * 16;
                bf16x8 bq[2];
#pragma unroll
                for (int ks = 0; ks < 2; ++ks) bq[ks] = *(const bf16x8*)(PROJ + (size_t)(t0 + fr) * EV_PITCH + C_QB + h * 64 + 32 * ks + 8 * fq);
#pragma unroll
                for (int rg = 0; rg < 2; ++rg) {
                    bf16x8 aw[8][2];
#pragma unroll
                    for (int r8 = 0; r8 < 8; ++r8)
#pragma unroll
                        for (int ks = 0; ks < 2; ++ks) aw[r8][ks] = *(const bf16x8*)(WUKT + (size_t)(h * 256 + 16 * (8 * rg + r8) + fr) * 64 + 32 * ks + 8 * fq);
#pragma unroll
                    for (int r8 = 0; r8 < 8; ++r8) { const int rt = 8 * rg + r8;
                        f32x4 acc = (f32x4){0.f, 0.f, 0.f, 0.f};
                        acc = MFMA16(aw[r8][0], bq[0], acc); acc = MFMA16(aw[r8][1], bq[1], acc);
                        u32x2 o; o.x = pk2(acc[0] * 0.125f, acc[1] * 0.125f); o.y = pk2(acc[2] * 0.125f, acc[3] * 0.125f);
                        *(u32x2*)(QLAT + ((size_t)(t0 + fr) * 16 + h) * 256 + 16 * rt + 4 * fq) = o; }
                }
            } }
#if !SKIP_DSA
            {
                IDS
                LAS float* sc = (LAS float*)L;
                __syncthreads();
                for (int uu = blockIdx.x; uu < 2048; uu += G) {
                    const int kk = uu / G, bi = uu - kk * G;
                    const int unit = (G == 256) ? ((kk >> 1) * 512 + ((kk & 1) ? 511 - bi : bi)) : uu;
                    const int row0 = unit * 8, b = row0 >> 12, c = (row0 & 4095) >> 6, nall = (c + 1) * 64;
                    const int row = row0 + wave;
                    int* idxp = IDX + (size_t)row * 256;
                    if (nall <= 256) { for (int i = lane; i < nall; i += 64) idxp[i] = i; if (lane == 0) CNT[row] = nall; continue; }
                    const int nquads = c + 1, ntiles = nall >> 4;
                    bf16x8 qa[4][2];
#pragma unroll
                    for (int hp = 0; hp < 4; ++hp)
#pragma unroll
                        for (int ks = 0; ks < 2; ++ks) qa[hp][ks] = *(const bf16x8*)(PROJ + (size_t)(row0 + (fr & 7)) * EV_PITCH + C_QI + (2 * hp + (fr >> 3)) * 64 + 32 * ks + 8 * fq);
                    float wq[4][4];
#pragma unroll
                    for (int hp = 0; hp < 4; ++hp)
#pragma unroll
                        for (int j = 0; j < 4; ++j) wq[hp][j] = __uint_as_float((unsigned)PROJ[(size_t)(row0 + 4 * (fq & 1) + j) * EV_PITCH + C_WI + 2 * hp + (fq >> 1)] << 16);
                    const bf16_t* kbase = KIC + ((size_t)b * SEQ + fr) * 64 + 8 * fq;
#pragma unroll 8
                    for (int t = wave; t < ntiles; t += 8) {
                        const bf16_t* kp = kbase + (size_t)(16 * t) * 64;
                        const bf16x8 b0 = *(const bf16x8*)kp, b1 = *(const bf16x8*)(kp + 32);
                        float part[4] = {0.f, 0.f, 0.f, 0.f};
#pragma unroll
                        for (int hp = 0; hp < 4; ++hp) {
                            f32x4 acc = (f32x4){0.f, 0.f, 0.f, 0.f};
                            acc = MFMA16(qa[hp][0], b0, acc); acc = MFMA16(qa[hp][1], b1, acc);
#pragma unroll
                            for (int j = 0; j < 4; ++j) part[j] += wq[hp][j] * fmaxf(acc[j], 0.f);
                        }
#pragma unroll
                        for (int j = 0; j < 4; ++j) part[j] += __shfl_xor(part[j], 32);
                        if (fq < 2) {
#pragma unroll
                            for (int j = 0; j < 4; ++j) sc[(4 * fq + j) * 4096 + 16 * t + fr] = part[j];
                        }
                    }
                    __syncthreads();
                    unsigned v[64];
#pragma unroll
                    for (int q = 0; q < 64; ++q) {
                        unsigned val = 0u;
                        if (q < nquads) { unsigned u = __float_as_uint(sc[wave * 4096 + 64 * q + lane]); if (u == 0x80000000u) u = 0u; val = (u & 0x80000000u) ? ~u : (u | 0x80000000u); }
                        v[q] = val;
                    }
                    unsigned T = 0u;
                    for (int bit = 31; bit >= 0; --bit) {
                        const unsigned cand = T | (1u << bit); int cnt = 0;
#pragma unroll
                        for (int qg = 0; qg < 4; ++qg) {
                            if (16 * qg < nquads) {
#pragma unroll
                                for (int q = 16 * qg; q < 16 * qg + 16; ++q) cnt += __popcll(__ballot(v[q] >= cand));
                            }
                        }
                        if (cnt >= 256) T = cand;
                        if (cnt == 256) break;
                    }
                    int cgt = 0;
#pragma unroll
                    for (int q = 0; q < 64; ++q) cgt += __popcll(__ballot(v[q] > T));
                    int need = 256 - cgt, pos = 0;
                    const unsigned long long ltmask = (1ull << lane) - 1ull;
#pragma unroll
                    for (int q = 0; q < 64; ++q) {
                        if (q < nquads) {
                            const bool gt = v[q] > T, eq = v[q] == T;
                            const unsigned long long meq = __ballot(eq);
                            const int eqrank = __popcll(meq & ltmask);
                            const bool sel = gt || (eq && eqrank < need);
                            const unsigned long long msel = __ballot(sel);
                            if (sel) idxp[pos + __popcll(msel & ltmask)] = q * 64 + lane;
                            pos += __popcll(msel);
                            const int neq = __popcll(meq); need -= (neq < need ? neq : need);
                        }
                    }
                    if (lane == 0) CNT[row] = 256;
                    __syncthreads();
                }
            }
#endif
#if !SKIP_SWA
            {
                IDS
                LAS bf16_t* Vt = (LAS bf16_t*)L;
                LAS float* bT = (LAS float*)(L + 64 * 200 * 2);
                LAS bf16_t* Kl = (LAS bf16_t*)(L + 64 * 200 * 2 + 4096);
                __syncthreads();
                { const int kvh0 = blockIdx.x & 3;
                  for (int idx = tid; idx < 1024; idx += 512) { const int g = idx >> 8, ri = idx & 255; bT[idx] = rel_bias[t5_bucket(ri - 191) * 32 + kvh0 * 4 + g]; } }
                for (int unit = blockIdx.x; unit < 1024; unit += G) {
                    const int b = unit >> 8, c = (unit >> 2) & 63, kvh = unit & 3;
                    const int kstart = (c >= 2 ? c - 2 : 0) * 64, nk = (c + 1) * 64 - kstart;
                    const size_t rowbase = (size_t)b * SEQ;
                    { u32x4 kx[3], vx[3];
#pragma unroll
                      for (int it = 0; it < 3; ++it) { const int i = tid + 512 * it; int key = i >> 3; const int ch = i & 7; key = key < nk ? key : nk - 1;
                          const bf16_t* src = PROJ + (rowbase + kstart + key) * EV_PITCH + kvh * 64 + ch * 8;
                          kx[it] = *(const u32x4*)(src + C_KA); vx[it] = *(const u32x4*)(src + C_VA); }
#pragma unroll
                      for (int it = 0; it < 3; ++it) { const int i = tid + 512 * it; const int key = i >> 3, ch = i & 7;
                          *(LAS u32x4*)(Kl + key * 72 + ch * 8) = kx[it];
                          const u32x4 w = vx[it]; LAS bf16_t* vp = Vt + (ch * 8) * 200 + key;
                          vp[0 * 200] = (bf16_t)(w.x & 0xffffu); vp[1 * 200] = (bf16_t)(w.x >> 16); vp[2 * 200] = (bf16_t)(w.y & 0xffffu); vp[3 * 200] = (bf16_t)(w.y >> 16);
                          vp[4 * 200] = (bf16_t)(w.z & 0xffffu); vp[5 * 200] = (bf16_t)(w.z >> 16); vp[6 * 200] = (bf16_t)(w.w & 0xffffu); vp[7 * 200] = (bf16_t)(w.w >> 16); } }
                    __syncthreads();
                    const int g = wave >> 1, qh = wave & 1, head = kvh * 4 + g, q0 = c * 64 + qh * 32;
                    const int ntile = nk >> 4;
                    const float sink = a.in[11][head];
#pragma unroll 1
                    for (int m = 0; m < 2; ++m) {
                        const int qpos = q0 + 16 * m + fr;
                        bf16x8 bq[2];
#pragma unroll
                        for (int ks = 0; ks < 2; ++ks) bq[ks] = *(const bf16x8*)(PROJ + (rowbase + qpos) * EV_PITCH + C_QA + head * 64 + 32 * ks + 8 * fq);
                        f32x4 s1[12];
                        float mx = -1e30f;
#pragma unroll
                        for (int t = 0; t < 12; ++t) {
                            if (t < ntile) {
                                const LAS bf16_t* kp = Kl + (16 * t + fr) * 72 + 8 * fq;
                                const bf16x8 k0 = *(const LAS bf16x8*)kp, k1 = *(const LAS bf16x8*)(kp + 32);
                                f32x4 acc = (f32x4){0.f, 0.f, 0.f, 0.f}; acc = MFMA16(k0, bq[0], acc); acc = MFMA16(k1, bq[1], acc);
#pragma unroll
                                for (int j = 0; j < 4; ++j) { const int ri = (kstart + 16 * t + 4 * fq + j) - qpos + 191; const float vv = acc[j] * 0.125f + bT[g * 256 + ri]; acc[j] = vv; mx = fmaxf(mx, vv); }
                                s1[t] = acc;
                            } else s1[t] = (f32x4){0.f, 0.f, 0.f, 0.f};
                        }
                        mx = fmaxf(mx, __shfl_xor(mx, 16)); mx = fmaxf(mx, __shfl_xor(mx, 32)); mx = fmaxf(mx, sink);
                        float sum = 0.f;
#pragma unroll
                        for (int t = 0; t < 12; ++t)
                            if (t < ntile) {
#pragma unroll
                                for (int j = 0; j < 4; ++j) { const float p = __expf(s1[t][j] - mx); s1[t][j] = p; sum += p; }
                            }
                        sum += __shfl_xor(sum, 16); sum += __shfl_xor(sum, 32);
                        const float inv = 1.f / (sum + __expf(sink - mx));
                        f32x4 o[4];
#pragma unroll
                        for (int dt = 0; dt < 4; ++dt) o[dt] = (f32x4){0.f, 0.f, 0.f, 0.f};
#pragma unroll
                        for (int st = 0; st < 6; ++st) {
                            if (2 * st < ntile) {
                                const bf16x8 pb = mk8(pk2(s1[2 * st][0], s1[2 * st][1]), pk2(s1[2 * st][2], s1[2 * st][3]), pk2(s1[2 * st + 1][0], s1[2 * st + 1][1]), pk2(s1[2 * st + 1][2], s1[2 * st + 1][3]));
#pragma unroll
                                for (int dt = 0; dt < 4; ++dt) {
                                    const LAS bf16_t* vp = Vt + (16 * dt + fr) * 200 + 32 * st + 4 * fq;
                                    const u32x2 lo = *(const LAS u32x2*)vp, hi = *(const LAS u32x2*)(vp + 16);
                                    o[dt] = MFMA16(mk8(lo.x, lo.y, hi.x, hi.y), pb, o[dt]);
                                }
                            }
                        }
#pragma unroll
                        for (int dt = 0; dt < 4; ++dt) { u32x2 w; w.x = pk2(o[dt][0] * inv, o[dt][1] * inv); w.y = pk2(o[dt][2] * inv, o[dt][3] * inv);
                            *(u32x2*)(ATT + (rowbase + qpos) * DM + head * 64 + 16 * dt + 4 * fq) = w; }
                    }
                    __syncthreads();
                }
            }
#endif
                        GSYNC();
#if !SKIP_DSA
            {
                IDS
                LAS float* bB = (LAS float*)(L + 8 * 16896);
                if (tid < 512) bB[tid] = rel_bias[(tid >> 4) * 32 + 16 + (tid & 15)];
                __syncthreads();
                LAS bf16_t* cb = (LAS bf16_t*)(L + wave * 16896);
                for (int row = gw; row < MTOK; row += NGW) {
                    const int b = row >> 12, tpos = row & 4095; const size_t rowbase = (size_t)b * SEQ;
                    const int cnt = __builtin_amdgcn_readfirstlane(CNT[row]); const int nch = cnt >> 5;
                    bf16x8 ql[8];
#pragma unroll
                    for (int ks = 0; ks < 8; ++ks) ql[ks] = *(const bf16x8*)(QLAT + ((size_t)row * 16 + fr) * 256 + 32 * ks + 8 * fq);
                    f32x4 o[16];
#pragma unroll
                    for (int rt = 0; rt < 16; ++rt) o[rt] = (f32x4){0.f, 0.f, 0.f, 0.f};
                    float mrun = -1e30f, lpart = 0.f;
                    int idxall[4];
#pragma unroll
                    for (int i = 0; i < 4; ++i) { const int e = 64 * i + lane; idxall[i] = (e < cnt) ? IDX[(size_t)row * 256 + e] : 0; }
                    u32x4 gw[16];
#define DSA_ISSUE(CH) do { const int c_ = (CH); const int s01_ = (c_ & 2) ? idxall[1] : idxall[0], s23_ = (c_ & 2) ? idxall[3] : idxall[2]; const int sel_ = (c_ & 4) ? s23_ : s01_; const int bl_ = 32 * (c_ & 1); \
        _Pragma("unroll") for (int it = 0; it < 16; ++it) { const int key = 2 * it + (lane >> 5), seg = lane & 31; const int kidx = __shfl(sel_, bl_ + key); \
            gw[it] = *(const u32x4*)(CKV + (rowbase + kidx) * 256 + seg * 8); } } while (0)
                    DSA_ISSUE(0);
                    for (int ch = 0; ch < nch; ++ch) {
                        const int s01 = (ch & 2) ? idxall[1] : idxall[0], s23 = (ch & 2) ? idxall[3] : idxall[2]; const int myidx = (ch & 4) ? s23 : s01; const int mybl = 32 * (ch & 1);
#pragma unroll
                        for (int it = 0; it < 16; ++it) { const int key = 2 * it + (lane >> 5), seg = lane & 31; *(LAS u32x4*)(cb + key * 264 + seg * 8) = gw[it]; }
                        asm volatile("s_waitcnt lgkmcnt(0)" ::: "memory");
                        if (ch + 1 < nch) DSA_ISSUE(ch + 1);
                        f32x4 sa[2];
#pragma unroll
                        for (int kt = 0; kt < 2; ++kt) { f32x4 acc = (f32x4){0.f, 0.f, 0.f, 0.f};
#pragma unroll
                            for (int ks = 0; ks < 8; ++ks) { const bf16x8 ac = *(const LAS bf16x8*)(cb + (16 * kt + fr) * 264 + 32 * ks + 8 * fq); acc = MFMA16(ac, ql[ks], acc); }
                            sa[kt] = acc; }
                        float cm = -1e30f;
                        const int mybucket = t5_bucket(__shfl(myidx, mybl + (lane & 31)) - tpos) * 16;
#pragma unroll
                        for (int kt = 0; kt < 2; ++kt)
#pragma unroll
                            for (int j = 0; j < 4; ++j) { const int bk = __shfl(mybucket, 16 * kt + 4 * fq + j); const float vv = sa[kt][j] + bB[bk + fr]; sa[kt][j] = vv; cm = fmaxf(cm, vv); }
                        cm = fmaxf(cm, __shfl_xor(cm, 16)); cm = fmaxf(cm, __shfl_xor(cm, 32));
                        const float mnew = fmaxf(mrun, cm), alpha = __expf(mrun - mnew); mrun = mnew;
                        float ps = 0.f;
#pragma unroll
                        for (int kt = 0; kt < 2; ++kt)
#pragma unroll
                            for (int j = 0; j < 4; ++j) { const float p = __expf(sa[kt][j] - mnew); sa[kt][j] = p; ps += p; }
                        lpart = lpart * alpha + ps;
                        if (__any(alpha != 1.f)) {
#pragma unroll
                            for (int rt = 0; rt < 16; ++rt) o[rt] *= alpha;
                        }
                        const bf16x8 pb = mk8(pk2(sa[0][0], sa[0][1]), pk2(sa[0][2], sa[0][3]), pk2(sa[1][0], sa[1][1]), pk2(sa[1][2], sa[1][3]));
#pragma unroll
                        for (int rt = 0; rt < 16; ++rt) {
                            const LAS bf16_t* cp = cb + (4 * fq + (fr >> 2)) * 264 + 16 * rt + 4 * (fr & 3);
                            const s16x4_t lo = lds_tr4(cp), hi = lds_tr4(cp + 16 * 264);
                            const bf16x8 av = __builtin_shufflevector(lo, hi, 0, 1, 2, 3, 4, 5, 6, 7);
                            o[rt] = MFMA16(av, pb, o[rt]);
                        }
                        asm volatile("s_waitcnt lgkmcnt(0)" ::: "memory");
                    }
                    float l = lpart + __shfl_xor(lpart, 16); l += __shfl_xor(l, 32);
                    const float inv = 1.f / l;
#pragma unroll
                    for (int rt = 0; rt < 16; ++rt) { u32x2 w; w.x = pk2(o[rt][0] * inv, o[rt][1] * inv); w.y = pk2(o[rt][2] * inv, o[rt][3] * inv);
                        *(u32x2*)(QLAT + ((size_t)row * 16 + fr) * 256 + 16 * rt + 4 * fq) = w; }
                }
            }
#endif
            GSYNC();
#if !SKIP_DSA
            { IDS
            for (int unit = gw; unit < 16384; unit += NGW) {
                const int h = unit & 15, t0 = (unit >> 4) * 16;
                bf16x8 bo[8];
#pragma unroll
                for (int ks = 0; ks < 8; ++ks) bo[ks] = *(const bf16x8*)(QLAT + ((size_t)(t0 + fr) * 16 + h) * 256 + 32 * ks + 8 * fq);
#pragma unroll
                for (int dt = 0; dt < 4; ++dt) {
                    f32x4 acc = (f32x4){0.f, 0.f, 0.f, 0.f};
                    bf16x8 aw[8];
#pragma unroll
                    for (int ks = 0; ks < 8; ++ks) aw[ks] = *(const bf16x8*)(WUVT + (size_t)(h * 64 + 16 * dt + fr) * 256 + 32 * ks + 8 * fq);
#pragma unroll
                    for (int ks = 0; ks < 8; ++ks) acc = MFMA16(aw[ks], bo[ks], acc);
                    u32x2 w; w.x = pk2(acc[0], acc[1]); w.y = pk2(acc[2], acc[3]);
                    *(u32x2*)(ATT + (size_t)(t0 + fr) * DM + 1024 + h * 64 + 16 * dt + 4 * fq) = w;
                }
            } }
#endif
            GSYNC();
        } else {
            { pg8::Gemm g{XN, WIN, MTOK, OD_PITCH, 2048}; pg8::StaticOrder S; S.init(MTOK, OD_PITCH, G, (int)blockIdx.x);
              pg8::EpiBf16 E{PROJ, OD_PITCH, nullptr, 0};
              pg8::gemm_phase<pg8::EpiBf16, pg8::StaticOrder, true, true>(L, g, S, E); }
            GSYNC();
#if SKIP_SB == 2
            { IDS for (size_t i = (size_t)blockIdx.x * 512 + tid; i < (size_t)MTOK * 256; i += (size_t)G * 512) { const size_t row = i >> 8, c8 = i & 255; ((u32x4*)ATT)[i] = *(const u32x4*)(PROJ + row * OD_PITCH + 4096 + c8 * 8); } }
#endif
#if !SKIP_SB
            {
                IDS
                LAS bf16_t* vb = (LAS bf16_t*)(L + wave * 8704);
                for (int unit = gw; unit < 8192; unit += NGW) {
                    const int qt = 127 - (unit >> 6), h = unit & 15, b = (unit >> 4) & 3; const int q0 = qt * 32; const size_t rowbase = (size_t)b * SEQ;
                    bf16x8 bq[2][4];
#pragma unroll
                    for (int m = 0; m < 2; ++m)
#pragma unroll
                        for (int ks = 0; ks < 4; ++ks) bq[m][ks] = *(const bf16x8*)(PROJ + (rowbase + q0 + 16 * m + fr) * OD_PITCH + h * 128 + 32 * ks + 8 * fq);
                    f32x4 o[8][2];
#pragma unroll
                    for (int dt = 0; dt < 8; ++dt) { o[dt][0] = (f32x4){0.f, 0.f, 0.f, 0.f}; o[dt][1] = (f32x4){0.f, 0.f, 0.f, 0.f}; }
                    float Pc[2] = {1.f, 1.f};
                    for (int kb = qt; kb >= 0; --kb) {
                        bf16x8 akk[2][4];
                        { u32x4 gw[8];
#pragma unroll
                          for (int it = 0; it < 8; ++it) { const int key = 4 * it + (lane >> 4), seg = lane & 15;
                              gw[it] = *(const u32x4*)(PROJ + (rowbase + 32 * kb + key) * OD_PITCH + 4096 + h * 128 + seg * 8); }
#pragma unroll
                          for (int kt = 0; kt < 2; ++kt)
#pragma unroll
                              for (int ks = 0; ks < 4; ++ks) akk[kt][ks] = *(const bf16x8*)(PROJ + (rowbase + 32 * kb + 16 * kt + fr) * OD_PITCH + 2048 + h * 128 + 8 * fq + 32 * ks);
                          __builtin_amdgcn_sched_barrier(0);
#pragma unroll
                          for (int it = 0; it < 8; ++it) { const int key = 4 * it + (lane >> 4), seg = lane & 15; *(LAS u32x4*)(vb + key * 136 + seg * 8) = gw[it]; } }
                        asm volatile("s_waitcnt lgkmcnt(0)" ::: "memory");
                        f32x4 z[2][2];
#pragma unroll
                        for (int kt = 0; kt < 2; ++kt) {
                            bf16x8 ak[4];
#pragma unroll
                            for (int ks = 0; ks < 4; ++ks) ak[ks] = akk[kt][ks];
#pragma unroll
                            for (int m = 0; m < 2; ++m) { f32x4 acc = (f32x4){0.f, 0.f, 0.f, 0.f};
#pragma unroll
                                for (int ks = 0; ks < 4; ++ks) acc = MFMA16(ak[ks], bq[m][ks], acc);
                                z[kt][m] = acc; }
                        }
                        const bool diag = (kb == qt);
                        bf16x8 pb[2];
#pragma unroll
                        for (int m = 0; m < 2; ++m) {
                            float kp[2][4], sg[2][4];
#pragma unroll
                            for (int kt = 0; kt < 2; ++kt)
#pragma unroll
                                for (int j = 0; j < 4; ++j) { const float t = __expf(z[kt][m][j] * 0.08838834764831845f); const float k1 = __builtin_amdgcn_rcpf(1.f + t);
                                    const bool e = !diag || (16 * kt + 4 * fq + j < 16 * m + fr); kp[kt][j] = e ? k1 : 1.f; sg[kt][j] = e ? t * k1 : 0.f; }
                            const float g0 = (kp[0][0] * kp[0][1]) * (kp[0][2] * kp[0][3]), g1 = (kp[1][0] * kp[1][1]) * (kp[1][2] * kp[1][3]);
                            float g0a[4], g1a[4];
#pragma unroll
                            for (int f = 0; f < 4; ++f) { g0a[f] = __shfl(g0, fr + 16 * f); g1a[f] = __shfl(g1, fr + 16 * f); }
                            const float tot0 = (g0a[0] * g0a[1]) * (g0a[2] * g0a[3]), tot1 = (g1a[0] * g1a[1]) * (g1a[2] * g1a[3]);
                            const float aft1 = (fq < 1 ? g1a[1] : 1.f) * (fq < 2 ? g1a[2] : 1.f) * (fq < 3 ? g1a[3] : 1.f);
                            const float aft0 = (fq < 1 ? g0a[1] : 1.f) * (fq < 2 ? g0a[2] : 1.f) * (fq < 3 ? g0a[3] : 1.f) * tot1;
                            float av[2][4];
#pragma unroll
                            for (int kt = 0; kt < 2; ++kt) { float suf = Pc[m] * (kt == 0 ? aft0 : aft1);
#pragma unroll
                                for (int j = 3; j >= 0; --j) { av[kt][j] = sg[kt][j] * suf; suf *= kp[kt][j]; } }
                            Pc[m] *= tot0 * tot1;
                            pb[m] = mk8(pk2(av[0][0], av[0][1]), pk2(av[0][2], av[0][3]), pk2(av[1][0], av[1][1]), pk2(av[1][2], av[1][3]));
                        }
#pragma unroll
                        for (int dt = 0; dt < 8; ++dt) {
                            const LAS bf16_t* cp = vb + (4 * fq + (fr >> 2)) * 136 + 16 * dt + 4 * (fr & 3);
                            const s16x4_t lo = lds_tr4(cp), hi = lds_tr4(cp + 16 * 136);
                            const bf16x8 vv = __builtin_shufflevector(lo, hi, 0, 1, 2, 3, 4, 5, 6, 7);
                            o[dt][0] = MFMA16(vv, pb[0], o[dt][0]); o[dt][1] = MFMA16(vv, pb[1], o[dt][1]);
                        }
                        asm volatile("s_waitcnt lgkmcnt(0)" ::: "memory");
                        if (__all(Pc[0] <= SB_CUT && Pc[1] <= SB_CUT)) break;
                    }
#pragma unroll
                    for (int m = 0; m < 2; ++m)
#pragma unroll
                        for (int dt = 0; dt < 8; ++dt) { u32x2 w; w.x = pk2(o[dt][m][0], o[dt][m][1]); w.y = pk2(o[dt][m][2], o[dt][m][3]);
                            *(u32x2*)(ATT + (rowbase + q0 + 16 * m + fr) * DM + h * 128 + 16 * dt + 4 * fq) = w; }
                }
            }
#endif
            GSYNC();
        }
        { pg8::Gemm g{ATT, WOUT, MTOK, 2048, 2048}; pg8::StaticOrder S; S.init(MTOK, 2048, G, (int)blockIdx.x);
          pg8::EpiResid E{xcur, xres, modl + 4096};
          pg8::gemm_phase<pg8::EpiResid, pg8::StaticOrder, true, true>(L, g, S, E); }
        GSYNC();
        { IDS norm_mod_phase(xres, a.in[6] + layer * DM, modl, 3 * 2048, 4 * 2048, XN, gw, NGW, lane); }
        GSYNC();
        { pg8::Gemm g{XN, WUP, MTOK, DFF2, 2048}; pg8::StaticOrder S; S.init(MTOK, DFF2, G, (int)blockIdx.x);
          pg8::EpiConvGate E{GB, HBUF, a.in[16] + (size_t)layer * 3 * DFF2, a.in[17] + (size_t)layer * DFF2, (LAS unsigned*)(L + 131072), 0};
          pg8::gemm_phase<pg8::EpiConvGate, pg8::StaticOrder, true, true>(L, g, S, E); }
        GSYNC();
        { IDS
          const float* cw = a.in[16] + (size_t)layer * 3 * DFF2; const float* cb = a.in[17] + (size_t)layer * DFF2;
          for (int item = blockIdx.x * 512 + tid; item < 64 * DFF; item += G * 512) {
              const int pm = item / DFF, ch = item - pm * DFF;
              const bool first = (pm & 15) == 0; const float fm = first ? 0.f : 1.f;
              const float* h = HBUF + (size_t)pm * 4 * DFF2; const float* hp = first ? h : h - (size_t)4 * DFF2;
              float u0[2], u1[2], um2[2], um1[2], w0[2], w1[2], w2[2], bb[2];
#pragma unroll
              for (int bj = 0; bj < 2; ++bj) { const int c = ch + bj * DFF;
                  u0[bj] = h[c]; u1[bj] = h[DFF2 + c]; um2[bj] = hp[2 * DFF2 + c]; um1[bj] = hp[3 * DFF2 + c];
                  w0[bj] = cw[c]; w1[bj] = cw[DFF2 + c]; w2[bj] = cw[2 * DFF2 + c]; bb[bj] = cb[c]; }
              float res[2];
#pragma unroll
              for (int r = 0; r < 2; ++r) {
                  float cvv[2];
#pragma unroll
                  for (int bj = 0; bj < 2; ++bj) {
                      const float xc = r == 0 ? u0[bj] : u1[bj], x1 = r == 0 ? um1[bj] * fm : u0[bj], x2 = r == 0 ? um2[bj] * fm : um1[bj] * fm;
                      cvv[bj] = w2[bj] * xc + w1[bj] * x1 + w0[bj] * x2 + bb[bj]; }
                  res[r] = cvv[0] / (1.f + __expf(-cvv[0])) * cvv[1];
              }
              GB[(size_t)(pm * 256) * DFF + ch] = (bf16_t)(pk2(res[0], 0.f) & 0xffffu);
              GB[(size_t)(pm * 256 + 1) * DFF + ch] = (bf16_t)(pk2(res[1], 0.f) & 0xffffu);
          } }
        GSYNC();
        { pg8::Gemm g{GB, WDN, MTOK, 2048, DFF}; pg8::StaticOrder S; S.init(MTOK, 2048, G, (int)blockIdx.x);
          pg8::EpiResid E{xres, xres, modl + 5 * 2048};
          pg8::gemm_phase<pg8::EpiResid, pg8::StaticOrder, true, true>(L, g, S, E); }
        GSYNC();
    }
#if DIAG
    { IDS
      float t1 = 0.f, t2 = 0.f;
      for (int k = 0; k < 20; ++k) { const float d = (float)(TS[k + 1] - TS[k]) * 0.01f; if ((DIAG_M1 >> k) & 1) t1 += d; if ((DIAG_M2 >> k) & 1) t2 += d; }
      const float vleak = __log2f(t1 + 1.f); (void)t2;
      for (size_t i = (size_t)blockIdx.x * 512 + tid; i < (size_t)MTOK * DM; i += (size_t)G * 512) xres[i] = vleak;
      return; }
#endif
    { IDS
    for (int row = gw; row < MTOK; row += NGW) {
        f32x4* xr = (f32x4*)(xres + (size_t)row * DM) + lane;
        f32x4 v[8]; float ss = 0.f;
#pragma unroll
        for (int j = 0; j < 8; ++j) { v[j] = xr[64 * j]; ss += (v[j].x * v[j].x + v[j].y * v[j].y) + (v[j].z * v[j].z + v[j].w * v[j].w); }
        ss = wave_sum(ss);
        const float r = rsqrtf(ss * (1.f / DM) + EPS);
#pragma unroll
        for (int j = 0; j < 8; ++j) { const f32x4 g4 = *(const f32x4*)(a.in[19] + 4 * (64 * j + lane)); xr[64 * j] = v[j] * r * g4; }
    } }
}

extern "C" void kernel_launch(void* const* d_in, const int* in_sizes, int n_in, void* d_out, int out_size, void* d_ws, size_t ws_size, hipStream_t stream) {
    static int grid = 0;
    if (grid == 0) {
        if (n_in != 20 || out_size != MTOK * DM || ws_size < WS_END) { fprintf(stderr, "kernel_launch: unexpected shapes (n_in %d, out %d, ws %zu)\n", n_in, out_size, ws_size); grid = -1; return; }
        int dev = 0, cus = 0, per_cu = 0;
        hipGetDevice(&dev); hipDeviceGetAttribute(&cus, hipDeviceAttributeMultiprocessorCount, dev);
        if (hipFuncSetAttribute((const void*)mega_fwd, hipFuncAttributeMaxDynamicSharedMemorySize, LDS_BYTES) != hipSuccess) { fprintf(stderr, "kernel_launch: hipFuncSetAttribute failed\n"); grid = -1; return; }
        if (hipOccupancyMaxActiveBlocksPerMultiprocessor(&per_cu, (const void*)mega_fwd, 512, LDS_BYTES) != hipSuccess || per_cu < 1) per_cu = 1;
        (void)hipGetLastError();
        grid = cus * (per_cu > 1 ? 1 : per_cu);
    }
    if (grid < 0) return;
    if (hipMemsetAsync((char*)d_ws + 458752, 0, 16384, stream) != hipSuccess) { fprintf(stderr, "memset failed\n"); return; }
    Args a{};
    for (int i = 0; i < 20; ++i) a.in[i] = (const float*)d_in[i];
    a.out = (float*)d_out; a.ws = (unsigned char*)d_ws;
    void* args[] = {&a};
    hipError_t e = hipLaunchCooperativeKernel((const void*)mega_fwd, dim3(grid), dim3(512), args, LDS_BYTES, stream);
    if (e != hipSuccess) fprintf(stderr, "cooperative launch failed: %s (grid %d)\n", hipGetErrorString(e), grid);
}
```

```cpp
#include <hip/hip_runtime.h>
#include <hip/hip_cooperative_groups.h>
#include <cstdio>
#include <cstdint>
namespace cg = cooperative_groups;

namespace pg8 {
#define PG8_LAS __attribute__((address_space(3)))
typedef unsigned short bf16_t;
typedef short bf16x8 __attribute__((ext_vector_type(8)));
typedef float f32x4 __attribute__((ext_vector_type(4)));
typedef unsigned u32x4 __attribute__((ext_vector_type(4)));
constexpr int BM = 256, BK = 64, HALF = 128, HTB = HALF * BK * 2  , STAGE_BYTES = 8 * HTB, NXCD = 8, WGM = 8;

__host__ __device__ __forceinline__ int lds_byte(int r, int c) { const int st = (r >> 4) * 2 + (c >> 5), rr = r & 15, cc = c & 31, ob = rr * 64 + cc * 2; return st * 1024 + (ob ^ (((ob >> 9) & 1) << 5)); }
__host__ __device__ __forceinline__ void stage_rc(int b, int& R, int& C) { const int st = b / 1024, sb = b % 1024, swz = sb ^ (((sb >> 9) & 1) << 5); R = (st >> 1) * 16 + swz / 64; C = (st & 1) * 32 + (swz % 64) / 2; }
__host__ __device__ __forceinline__ int perm32(int rho) { const int n = rho >> 4, i = rho & 15; return 8 * (i >> 2) + 4 * n + (i & 3); }

struct Unit { int pm, pn; };
struct Gemm { const bf16_t* A; const bf16_t* Bt; int M, N, K; };

struct StaticOrder {
    int nM, nN, nwg, G, c;
    __host__ __device__ void init(int M, int N, int G_, int c_) { nM = M / BM; nN = N / BM; nwg = nM * nN; G = G_; c = c_; }
    __host__ __device__ bool next(int i, Unit& u) const {
        const long L = (long)i * G + c; if (L >= nwg) return false;
        int wgid = (int)L; { const int q = nwg / NXCD, r = nwg % NXCD, xcd = wgid % NXCD, off = wgid / NXCD; wgid = (xcd < r ? xcd * (q + 1) : r * (q + 1) + (xcd - r) * q) + off; }
        const int nig = WGM * nN, gid = wgid / nig, fm = gid * WGM, gsz = (nM - fm) < WGM ? (nM - fm) : WGM;
        u.pm = fm + ((wgid % nig) % gsz); u.pn = (wgid % nig) / gsz; return true;
    }
    __device__ __forceinline__ void a_ready(const Unit&) const {}
    __device__ __forceinline__ void done(const Unit&) const {}
};

__device__ __forceinline__ unsigned cvt_pk_bf16(float lo, float hi) { unsigned r; asm volatile("v_cvt_pk_bf16_f32 %0, %1, %2" : "=v"(r) : "v"(lo), "v"(hi)); return r; }
typedef float f32x2 __attribute__((ext_vector_type(2)));
typedef unsigned u32x2v __attribute__((ext_vector_type(2)));
typedef float f32x2c __attribute__((ext_vector_type(2))); typedef __bf16 bf16x2c __attribute__((ext_vector_type(2)));
__device__ __forceinline__ unsigned pkb(float lo, float hi) { f32x2c v = {lo, hi}; bf16x2c b = __builtin_convertvector(v, bf16x2c); return __builtin_bit_cast(unsigned, b); }
struct EpiBf16 {
    static constexpr bool PERM = true, AFTER_DRAIN = false;
    bf16_t* O; int ldc; bf16_t* O2; int o2_pn;
    __device__ __forceinline__ void operator()(const f32x4 (&acc)[2][2][4][2], const Unit& u, int wr, int wc, int fr, int fq) const {
        const int row0 = u.pm * BM + wr * 64 + fr; const int col0 = u.pn * BM + wc * 32 + 8 * fq;
#pragma unroll
        for (int ai = 0; ai < 2; ++ai)
#pragma unroll
            for (int m = 0; m < 4; ++m) { bf16_t* rowp = O + (size_t)(row0 + ai * HALF + m * 16) * ldc + col0;
#pragma unroll
                for (int bj = 0; bj < 2; ++bj) { const f32x4 v0 = acc[ai][bj][m][0], v1 = acc[ai][bj][m][1];
                    u32x4 w; w.x = pkb(v0[0], v0[1]); w.y = pkb(v0[2], v0[3]); w.z = pkb(v1[0], v1[1]); w.w = pkb(v1[2], v1[3]);
                    *(u32x4*)(rowp + bj * HALF) = w;
                    if (O2 != nullptr && bj == 0 && u.pn == o2_pn && wc < 2) *(u32x4*)(O2 + (size_t)(row0 + ai * HALF + m * 16) * 64 + wc * 32 + 8 * fq) = w; } }
    }
};

struct EpiConvGate {
    static constexpr bool PERM = true, AFTER_DRAIN = false;
    bf16_t* Gout; float* HB; const float* cw; const float* cb; PG8_LAS unsigned* halo; mutable int parity;
    __device__ __forceinline__ void operator()(const f32x4 (&acc)[2][2][4][2], const Unit& u, int wr, int wc, int fr_, int fq_) const {
        int fr = fr_, fq = fq_; asm volatile("" : "+v"(fr), "+v"(fq));
        const int lane = fq * 16 + fr;
        PG8_LAS unsigned* hb = halo + (parity & 1) * 2048; PG8_LAS float* wl = (PG8_LAS float*)(hb + 1024); ++parity;
        const int ci = wc * 32 + 8 * fq;
        const int chg = u.pn * 128 + ci;
        { const size_t hrow = (size_t)u.pm * 4 * 11264;
          if (wr == 0 && fr < 2) {
#pragma unroll
              for (int bj = 0; bj < 2; ++bj)
#pragma unroll
                  for (int n = 0; n < 2; ++n) *(f32x4*)(HB + hrow + (size_t)fr * 11264 + bj * 5632 + chg + 4 * n) = acc[0][bj][0][n];
          }
          if (wr == 1 && fr >= 14) {
#pragma unroll
              for (int bj = 0; bj < 2; ++bj)
#pragma unroll
                  for (int n = 0; n < 2; ++n) *(f32x4*)(HB + hrow + (size_t)(2 + fr - 14) * 11264 + bj * 5632 + chg + 4 * n) = acc[1][bj][3][n];
          } }
        unsigned P[2][2][4][2][2];
#pragma unroll
        for (int ai = 0; ai < 2; ++ai)
#pragma unroll
            for (int bj = 0; bj < 2; ++bj)
#pragma unroll
                for (int m = 0; m < 4; ++m)
#pragma unroll
                    for (int n = 0; n < 2; ++n) { P[ai][bj][m][n][0] = pkb(acc[ai][bj][m][n][0], acc[ai][bj][m][n][1]); P[ai][bj][m][n][1] = pkb(acc[ai][bj][m][n][2], acc[ai][bj][m][n][3]); }
        if (fr >= 14) {
#pragma unroll
            for (int ai = 0; ai < 2; ++ai)
#pragma unroll
                for (int bj = 0; bj < 2; ++bj)
#pragma unroll
                    for (int n = 0; n < 2; ++n) { PG8_LAS unsigned* d = hb + ((((ai * 2 + wr) * 2 + (fr - 14)) * 2 + bj) * 64) + (ci >> 1) + 2 * n; d[0] = P[ai][bj][3][n][0]; d[1] = P[ai][bj][3][n][1]; }
        }
        { const int t = (wr * 4 + wc) * 64 + lane;
#pragma unroll
          for (int k = 0; k < 2; ++k) { const int idx = t + 512 * k, tb = idx >> 8, bj = (idx >> 7) & 1, i = idx & 127;
              const float* src = (tb < 3 ? cw + tb * 11264 : cb) + bj * 5632 + u.pn * 128 + i; wl[idx] = *src; } }
        asm volatile("s_waitcnt vmcnt(0) lgkmcnt(0)" ::: "memory"); __builtin_amdgcn_s_barrier(); asm volatile("" ::: "memory");
        const int src1 = (lane & 48) | ((fr + 15) & 15), src2 = (lane & 48) | ((fr + 14) & 15);
        const int pwr = (wr == 1) ? 0 : 1;
        int rowv = u.pm * BM + wr * 64 + fr;
#pragma unroll
        for (int n = 0; n < 2; ++n) {
            unsigned outp[2][4][2];
#pragma unroll
            for (int h = 0; h < 2; ++h) {
                float w0[2][2], w1[2][2], w2[2][2], bb[2][2];
#pragma unroll
                for (int bj = 0; bj < 2; ++bj) { const PG8_LAS float* p0 = wl + bj * 128 + ci + 4 * n + 2 * h;
#pragma unroll
                    for (int q = 0; q < 2; ++q) { w0[bj][q] = p0[q]; w1[bj][q] = p0[256 + q]; w2[bj][q] = p0[512 + q]; bb[bj][q] = p0[768 + q]; } }
#pragma unroll
                for (int ai = 0; ai < 2; ++ai) {
                    const int pai = (wr == 1) ? ai : 0;
                    float cv[2][4][2];
#pragma unroll
                    for (int bj = 0; bj < 2; ++bj) {
                        const PG8_LAS unsigned* hp = hb + ((((pai * 2 + pwr) * 2) * 2 + bj) * 64) + (ci >> 1) + 2 * n + h; const unsigned h1 = hp[128]; const unsigned hh = fr == 0 ? hp[0] : h1;
                        unsigned x[4], r1[4], r2[4];
#pragma unroll
                        for (int m = 0; m < 4; ++m) { x[m] = P[ai][bj][m][n][h]; r1[m] = (unsigned)__builtin_amdgcn_update_dpp(0, (int)x[m], 0x121, 0xf, 0xf, false); r2[m] = (unsigned)__builtin_amdgcn_update_dpp(0, (int)x[m], 0x122, 0xf, 0xf, false); }
#pragma unroll
                        for (int m = 0; m < 4; ++m) {
                            const unsigned p1 = fr >= 1 ? r1[m] : (m >= 1 ? r1[m >= 1 ? m - 1 : 0] : h1);
                            const unsigned p2 = fr >= 2 ? r2[m] : (m >= 1 ? r2[m >= 1 ? m - 1 : 0] : hh);
                            const f32x2 xv = {__uint_as_float(x[m] << 16), __uint_as_float(x[m] & 0xffff0000u)}, p1v = {__uint_as_float(p1 << 16), __uint_as_float(p1 & 0xffff0000u)}, p2v = {__uint_as_float(p2 << 16), __uint_as_float(p2 & 0xffff0000u)};
                            const f32x2 w2v = {w2[bj][0], w2[bj][1]}, w1v = {w1[bj][0], w1[bj][1]}, w0v = {w0[bj][0], w0[bj][1]}, bv2 = {bb[bj][0], bb[bj][1]};
                            const f32x2 c2 = w2v * xv + (w1v * p1v + (w0v * p2v + bv2));
                            cv[bj][m][0] = c2.x; cv[bj][m][1] = c2.y;
                        }
                    }
#pragma unroll
                    for (int m = 0; m < 4; ++m) { const float g0 = cv[0][m][0], g1 = cv[0][m][1];
                        outp[ai][m][h] = pkb(g0 * __builtin_amdgcn_rcpf(1.f + __expf(-g0)) * cv[1][m][0], g1 * __builtin_amdgcn_rcpf(1.f + __expf(-g1)) * cv[1][m][1]); }
                }
            }
            { bf16_t* gp = Gout + (size_t)rowv * 5632 + chg + 4 * n;
#pragma unroll
              for (int ai = 0; ai < 2; ++ai)
#pragma unroll
                for (int m = 0; m < 4; ++m) {
                    if (!(ai == 0 && wr == 0 && m == 0 && fr < 2)) {
                        u32x2v w; w.x = outp[ai][m][0]; w.y = outp[ai][m][1];
                        *(u32x2v*)(gp + (size_t)(ai * HALF + m * 16) * 5632) = w;
                    }
                } }
        }
    }
};
struct EpiResid {
    static constexpr bool PERM = false, AFTER_DRAIN = false;
    const float* base; float* out; const float* gate;
    __device__ __forceinline__ void operator()(const f32x4 (&acc)[2][2][4][2], const Unit& u, int wr, int wc, int fr, int fq) const {
        const int b = (u.pm * BM) >> 12; const int col0 = u.pn * BM + wc * 32 + 4 * fq; const float* gp = gate + (size_t)b * 12288 + col0;
#pragma unroll
        for (int bj = 0; bj < 2; ++bj)
#pragma unroll
            for (int n = 0; n < 2; ++n) { const f32x4 gv = *(const f32x4*)(gp + bj * HALF + n * 16);
                const size_t off0 = (size_t)(u.pm * BM + wr * 64 + fr) * 2048 + col0 + bj * HALF + n * 16;
                f32x4 bs[2][4];
#pragma unroll
                for (int ai = 0; ai < 2; ++ai)
#pragma unroll
                    for (int m = 0; m < 4; ++m) bs[ai][m] = *(const f32x4*)(base + off0 + (size_t)(ai * HALF + m * 16) * 2048);
#pragma unroll
                for (int ai = 0; ai < 2; ++ai)
#pragma unroll
                    for (int m = 0; m < 4; ++m) *(f32x4*)(out + off0 + (size_t)(ai * HALF + m * 16) * 2048) = bs[ai][m] + gv * acc[ai][bj][m][n]; }
    }
};
template <class Epi, class Sched, bool ALIGN_EPI = false, bool SP2 = false>
__device__ __forceinline__ void gemm_phase(PG8_LAS unsigned char* lds, const Gemm g, const Sched& S, const Epi& E) {
    int tid_o = threadIdx.x; asm volatile("" : "+v"(tid_o)); const int tid = tid_o, wid = __builtin_amdgcn_readfirstlane(tid >> 6), lane = tid & 63, wr = wid >> 2, wc = wid & 3, fr = lane & 15, fq = lane >> 4;
    const int K = g.K, nt = K / BK;
    unsigned voffA[2], voffB[2];
#pragma unroll
    for (int i = 0; i < 2; ++i) { int R, C; stage_rc(tid * 16 + i * 8192, R, C); const int Rb = Epi::PERM ? ((R & ~31) + perm32(R & 31)) : R;
        voffA[i] = (unsigned)(R * K + C) * 2u; voffB[i] = (unsigned)(Rb * K + C) * 2u; }
    const size_t kstep = (size_t)(BK * 2);
    const size_t hstep = (size_t)HALF * K * 2;
    const size_t tstep = 2 * hstep;
    const unsigned ldsw = (unsigned)wid * 1024u;
    const int aoff = lds_byte(wr * 64 + fr, fq * 8), boff = lds_byte(wc * 32 + fr, fq * 8);
#define PG8_SA(b, h) (((b) * 2 + (h)) * HTB)
#define PG8_SB(b, h) ((4 + (b) * 2 + (h)) * HTB)
#define PG8_STAGE(bufoff, gbase, voff) do { _Pragma("unroll") for (int _i = 0; _i < 2; ++_i) \
        __builtin_amdgcn_global_load_lds((const unsigned*)((const char*)(gbase) + (voff)[_i]), (PG8_LAS unsigned*)(lds + (bufoff) + ldsw + _i * 8192), 16, 0, 0); } while (0)
#define PG8_LDA(dst, b, h) do { _Pragma("unroll") for (int m = 0; m < 4; ++m) _Pragma("unroll") for (int k = 0; k < 2; ++k) dst[m][k] = *(const PG8_LAS bf16x8*)(lds + PG8_SA(b, h) + aoff + m * 2048 + k * 1024); } while (0)
#define PG8_LDB(dst, b, h) do { _Pragma("unroll") for (int n = 0; n < 2; ++n) _Pragma("unroll") for (int k = 0; k < 2; ++k) dst[n][k] = *(const PG8_LAS bf16x8*)(lds + PG8_SB(b, h) + boff + n * 2048 + k * 1024); } while (0)
#define PG8_MMA(ai, bj, At, Bt) do { __builtin_amdgcn_s_setprio(1); _Pragma("unroll") for (int m = 0; m < 4; ++m) _Pragma("unroll") for (int n = 0; n < 2; ++n) _Pragma("unroll") for (int k = 0; k < 2; ++k) \
        acc[ai][bj][m][n] = __builtin_amdgcn_mfma_f32_16x16x32_bf16(Bt[n][k], At[m][k], acc[ai][bj][m][n], 0, 0, 0); __builtin_amdgcn_s_setprio(0); } while (0)
#define PG8_WAIT_V(n) asm volatile("s_waitcnt vmcnt(" #n ")" ::: "memory")
#define PG8_WAIT_L(n) asm volatile("s_waitcnt lgkmcnt(" #n ")" ::: "memory")
#define PG8_BAR __builtin_amdgcn_s_barrier()
#define PG8_SCHED __builtin_amdgcn_sched_barrier(0)
    Unit cur, nxt; int ui = 0;
    if (!S.next(0, cur)) return;
    f32x4 acc[2][2][4][2];
#pragma unroll
    for (int a = 0; a < 2; ++a)
#pragma unroll
        for (int b = 0; b < 2; ++b)
#pragma unroll
            for (int m = 0; m < 4; ++m)
#pragma unroll
                for (int n = 0; n < 2; ++n) acc[a][b][m][n] = (f32x4){0.f, 0.f, 0.f, 0.f};
    bf16x8 At[4][2], B0[2][2], B1[2][2];
    const char* cA = (const char*)g.A + (size_t)cur.pm * tstep; const char* cB = (const char*)g.Bt + (size_t)cur.pn * tstep;
    S.a_ready(cur);
    if constexpr (SP2) {
        PG8_STAGE(PG8_SB(0, 0), cB, voffB); PG8_STAGE(PG8_SB(0, 1), cB + hstep, voffB); PG8_STAGE(PG8_SA(0, 0), cA, voffA); PG8_STAGE(PG8_SA(0, 1), cA + hstep, voffA);
        if (wr == 1) PG8_BAR;
        PG8_WAIT_V(2); PG8_BAR;
        PG8_STAGE(PG8_SB(1, 0), cB + kstep, voffB); PG8_STAGE(PG8_SA(1, 0), cA + kstep, voffA); PG8_STAGE(PG8_SB(1, 1), cB + hstep + kstep, voffB);
        PG8_WAIT_V(6); PG8_BAR;
    } else {
        PG8_STAGE(PG8_SB(0, 0), cB, voffB); PG8_STAGE(PG8_SA(0, 0), cA, voffA); PG8_STAGE(PG8_SB(0, 1), cB + hstep, voffB); PG8_STAGE(PG8_SA(0, 1), cA + hstep, voffA);
        if (wr == 1) PG8_BAR;
        PG8_WAIT_V(4); PG8_BAR;
        PG8_STAGE(PG8_SB(1, 0), cB + kstep, voffB); PG8_STAGE(PG8_SA(1, 0), cA + kstep, voffA); PG8_STAGE(PG8_SB(1, 1), cB + hstep + kstep, voffB);
        PG8_WAIT_V(6); PG8_BAR;
    }
    for (;;) {
        const bool has_next = S.next(ui + 1, nxt);
        const char* nA = has_next ? (const char*)g.A + (size_t)nxt.pm * tstep : cA; const char* nB = has_next ? (const char*)g.Bt + (size_t)nxt.pn * tstep : cB;
        for (int t = 0; t < nt; t += 2) {
            const bool last = (t == nt - 2);
            const char* a1 = cA + (size_t)(t + 1) * kstep;
            const char* a2 = last ? nA : cA + (size_t)(t + 2) * kstep; const char* b2 = last ? nB : cB + (size_t)(t + 2) * kstep;
            const char* a3 = a2 + kstep; const char* b3 = b2 + kstep;
            if (last && has_next) S.a_ready(nxt);
            if constexpr (SP2) {
            PG8_LDB(B0, 0, 0); PG8_LDB(B1, 0, 1); PG8_SCHED; PG8_LDA(At, 0, 0); PG8_STAGE(PG8_SA(1, 1), a1 + hstep, voffA);
            PG8_WAIT_V(8); PG8_WAIT_L(0); PG8_BAR; PG8_MMA(0, 0, At, B0); PG8_MMA(0, 1, At, B1); PG8_BAR; PG8_SCHED;
            PG8_LDA(At, 0, 1); PG8_STAGE(PG8_SB(0, 0), b2, voffB); PG8_STAGE(PG8_SB(0, 1), b2 + hstep, voffB); PG8_STAGE(PG8_SA(0, 0), a2, voffA);
            PG8_WAIT_V(8); PG8_WAIT_L(0); PG8_BAR; PG8_MMA(1, 0, At, B0); PG8_MMA(1, 1, At, B1); PG8_BAR; PG8_SCHED;
            PG8_LDB(B0, 1, 0); PG8_LDB(B1, 1, 1); PG8_SCHED; PG8_LDA(At, 1, 0); PG8_STAGE(PG8_SA(0, 1), a2 + hstep, voffA);
            PG8_WAIT_V(8); PG8_WAIT_L(0); PG8_BAR; PG8_MMA(0, 0, At, B0); PG8_MMA(0, 1, At, B1); PG8_BAR; PG8_SCHED;
            PG8_LDA(At, 1, 1); PG8_STAGE(PG8_SB(1, 0), b3, voffB); PG8_STAGE(PG8_SB(1, 1), b3 + hstep, voffB); PG8_STAGE(PG8_SA(1, 0), a3, voffA);
            PG8_WAIT_V(8); PG8_WAIT_L(0); PG8_BAR; PG8_MMA(1, 0, At, B0); PG8_MMA(1, 1, At, B1); PG8_BAR; PG8_SCHED;
            } else {
            PG8_LDB(B0, 0, 0); PG8_SCHED; PG8_LDA(At, 0, 0); PG8_STAGE(PG8_SA(1, 1), a1 + hstep, voffA);
            PG8_WAIT_L(8); PG8_BAR; PG8_WAIT_L(0); PG8_MMA(0, 0, At, B0); PG8_BAR; PG8_SCHED;
            PG8_LDB(B1, 0, 1); PG8_STAGE(PG8_SB(0, 0), b2, voffB);
            PG8_BAR; PG8_WAIT_L(0); PG8_MMA(0, 1, At, B1); PG8_BAR;
            PG8_LDA(At, 0, 1); PG8_STAGE(PG8_SA(0, 0), a2, voffA);
            PG8_BAR; PG8_WAIT_L(0); PG8_MMA(1, 0, At, B0); PG8_BAR; PG8_SCHED;
            PG8_STAGE(PG8_SB(0, 1), b2 + hstep, voffB);
            PG8_WAIT_V(6); PG8_BAR; PG8_MMA(1, 1, At, B1); PG8_BAR;
            PG8_LDB(B0, 1, 0); PG8_SCHED; PG8_LDA(At, 1, 0); PG8_STAGE(PG8_SA(0, 1), a2 + hstep, voffA);
            PG8_WAIT_L(8); PG8_BAR; PG8_WAIT_L(0); PG8_MMA(0, 0, At, B0); PG8_BAR; PG8_SCHED;
            PG8_LDB(B1, 1, 1); PG8_STAGE(PG8_SB(1, 0), b3, voffB);
            PG8_BAR; PG8_WAIT_L(0); PG8_MMA(0, 1, At, B1); PG8_BAR;
            PG8_LDA(At, 1, 1); PG8_STAGE(PG8_SA(1, 0), a3, voffA);
            PG8_BAR; PG8_WAIT_L(0); PG8_MMA(1, 0, At, B0); PG8_BAR; PG8_SCHED;
            PG8_STAGE(PG8_SB(1, 1), b3 + hstep, voffB);
            PG8_WAIT_V(6); PG8_BAR; PG8_MMA(1, 1, At, B1); PG8_BAR;
            }
        }
        if constexpr (ALIGN_EPI) { if (wr == 0) PG8_BAR; }
        if constexpr (!Epi::AFTER_DRAIN) { E(acc, cur, wr, wc, fr, fq); S.done(cur); }
        if (!has_next) break;
#pragma unroll
        for (int a = 0; a < 2; ++a)
#pragma unroll
            for (int b = 0; b < 2; ++b)
#pragma unroll
                for (int m = 0; m < 4; ++m)
#pragma unroll
                    for (int n = 0; n < 2; ++n) acc[a][b][m][n] = (f32x4){0.f, 0.f, 0.f, 0.f};
        cur = nxt; cA = nA; cB = nB; ++ui;
        if constexpr (ALIGN_EPI) { if (wr == 1) PG8_BAR; }
    }
    PG8_WAIT_V(0);
    if constexpr (!ALIGN_EPI) { if (wr == 0) PG8_BAR; }
    PG8_BAR;
    if constexpr (Epi::AFTER_DRAIN) { E.fused(acc, cur, wr, wc, fr, fq, lds, wid, lane); S.done(cur); }
#undef PG8_SA
#undef PG8_SB
#undef PG8_STAGE
#undef PG8_LDA
#undef PG8_LDB
#undef PG8_MMA
#undef PG8_WAIT_V
#undef PG8_WAIT_L
#undef PG8_BAR
#undef PG8_SCHED
}
}

constexpr int NB = 4, SEQ = 4096, DM = 2048, MTOK = NB * SEQ;
constexpr int EV_PITCH = 3584, EV_IN = 3400, OD_PITCH = 6144, DFF = 5632, DFF2 = 11264;
constexpr int C_QA = 0, C_KA = 1024, C_VA = 1280, C_QB = 1536, C_CLAT = 2560, C_QI = 2816, C_KI = 3328, C_WI = 3392;
constexpr float EPS = 1e-6f;
constexpr float SB_CUT = 4.0e-18f;
constexpr size_t MiB = 1u << 20;
constexpr size_t WS_MOD = 0, WS_WUKT = 512 * 1024, WS_WUVT = 1 * MiB, WS_WIN = 2 * MiB, WS_WOUT = 26 * MiB, WS_WUP = 34 * MiB, WS_WDN = 78 * MiB,
                 WS_XN = 100 * MiB, WS_BIG = 164 * MiB, WS_QLAT = 276 * MiB, WS_G = 516 * MiB, WS_ATT = 516 * MiB, WS_CKV = 580 * MiB,
                 WS_IDX = 588 * MiB, WS_CNT = 604 * MiB, WS_END = 692 * MiB;
constexpr int LDS_BYTES = 156672;
#ifndef DIAG
#define DIAG 0
#endif
#ifndef DUP_UP
#define DUP_UP 0
#endif
#ifndef DUP_CONV
#define DUP_CONV 0
#endif
#ifndef DUP_P3
#define DUP_P3 0
#endif
#ifndef DUP_IDX
#define DUP_IDX 0
#endif
#ifndef SKIP_SWA
#define SKIP_SWA 0
#endif
#ifndef SKIP_DSA
#define SKIP_DSA 0
#endif
#ifndef SKIP_SB
#define SKIP_SB 0
#endif

typedef unsigned short bf16_t;
typedef short bf16x8 __attribute__((ext_vector_type(8)));
typedef float f32x4 __attribute__((ext_vector_type(4)));
typedef unsigned u32x4 __attribute__((ext_vector_type(4)));
typedef unsigned u32x2 __attribute__((ext_vector_type(2)));
#define LAS __attribute__((address_space(3)))
#define MFMA16(a, b, c) __builtin_amdgcn_mfma_f32_16x16x32_bf16((a), (b), (c), 0, 0, 0)

typedef float f32x2_t __attribute__((ext_vector_type(2))); typedef __bf16 bf16x2_t __attribute__((ext_vector_type(2)));
__device__ __forceinline__ unsigned pk2(float lo, float hi) { f32x2_t v = {lo, hi}; bf16x2_t b = __builtin_convertvector(v, bf16x2_t); return __builtin_bit_cast(unsigned, b); }
__device__ __forceinline__ float bflo(unsigned w) { return __uint_as_float(w << 16); }
__device__ __forceinline__ float bfhi(unsigned w) { return __uint_as_float(w & 0xffff0000u); }
__device__ __forceinline__ float wave_sum(float v) {
#pragma unroll
    for (int o = 1; o < 64; o <<= 1) v += __shfl_xor(v, o);
    return v;
}
__device__ __forceinline__ int wave_sum_i(int v) {
#pragma unroll
    for (int o = 1; o < 64; o <<= 1) v += __shfl_xor(v, o);
    return v;
}
__device__ __forceinline__ int t5_bucket(int rel) {
    const int n = rel < 0 ? -rel : rel; int v = n;
    if (n >= 8) v = 8 + (n >= 12) + (n >= 16) + (n >= 23) + (n >= 32) + (n >= 46) + (n >= 64) + (n >= 91);
    return (rel > 0 ? 16 : 0) + v;
}
typedef short s16x4_t __attribute__((ext_vector_type(4)));
__device__ __forceinline__ s16x4_t lds_tr4(const LAS bf16_t* p) { return __builtin_bit_cast(s16x4_t, __builtin_amdgcn_ds_read_tr16_b64_v4i16((LAS s16x4_t*)p)); }
__device__ __forceinline__ bf16x8 mk8(unsigned a, unsigned b, unsigned c, unsigned d) { u32x4 w; w.x = a; w.y = b; w.z = c; w.w = d; return __builtin_bit_cast(bf16x8, w); }

struct Args { const float* in[20]; float* out; unsigned char* ws; };

template <int ROWMAP> __device__ __forceinline__ void transpose_item(const float* W, int K, int N, bf16_t* WT, LAS float* scr, int item, int nblk, int lane) {
    const int kb = item / nblk, nb = item % nblk, k0 = 64 * kb, n0 = 64 * nb; const int nc = n0 + lane;
    float v[64];
#pragma unroll
    for (int i = 0; i < 64; ++i) v[i] = (nc < N) ? W[(size_t)(k0 + i) * N + nc] : 0.f;
#pragma unroll
    for (int i = 0; i < 64; ++i) scr[i * 65 + lane] = v[i];
    asm volatile("s_waitcnt lgkmcnt(0)" ::: "memory");
    const int c = lane & 7;
#pragma unroll
    for (int j = 0; j < 8; ++j) { const int n = (lane >> 3) + 8 * j; const LAS float* s = scr + (8 * c) * 65 + n;
        u32x4 o; o.x = pk2(s[0 * 65], s[1 * 65]); o.y = pk2(s[2 * 65], s[3 * 65]); o.z = pk2(s[4 * 65], s[5 * 65]); o.w = pk2(s[6 * 65], s[7 * 65]);
        int d = n0 + n; if (ROWMAP) { const int sc_ = d < DFF ? d : d - DFF; d = (sc_ >> 7) * 256 + (d < DFF ? 0 : 128) + (sc_ & 127); }
        *(u32x4*)(WT + (size_t)d * K + k0 + 8 * c) = o; }
    asm volatile("s_waitcnt lgkmcnt(0)" ::: "memory");
}
template <int ROWMAP = 0> __device__ __forceinline__ void convert_matrix(const float* W, int K, int N, int Npad, bf16_t* WT, LAS float* scr, int gw, int NGW, int lane) {
    const int nblk = Npad / 64, nitems = (K / 64) * nblk;
    for (int it = gw; it < nitems; it += NGW) transpose_item<ROWMAP>(W, K, N, WT, scr, it, nblk, lane);
}

__device__ __forceinline__ void norm_mod_phase(const float* xin, const float* g, const float* modl, int sh_off, int sc_off, bf16_t* XN, int gw, int NGW, int lane) {
    for (int row = gw; row < MTOK; row += 2 * NGW) {
        const int row2 = row + NGW;
        const f32x4* xr = (const f32x4*)(xin + (size_t)row * DM) + lane; const f32x4* xr2 = (const f32x4*)(xin + (size_t)row2 * DM) + lane;
        f32x4 v[8], v2[8]; float ss = 0.f, ss2 = 0.f;
#pragma unroll
        for (int j = 0; j < 8; ++j) { v[j] = xr[64 * j]; v2[j] = xr2[64 * j]; }
#pragma unroll
        for (int j = 0; j < 8; ++j) { ss += (v[j].x * v[j].x + v[j].y * v[j].y) + (v[j].z * v[j].z + v[j].w * v[j].w); ss2 += (v2[j].x * v2[j].x + v2[j].y * v2[j].y) + (v2[j].z * v2[j].z + v2[j].w * v2[j].w); }
        ss = wave_sum(ss); ss2 = wave_sum(ss2);
        const float r = rsqrtf(ss * (1.f / DM) + EPS), r2 = rsqrtf(ss2 * (1.f / DM) + EPS);
        const float* mb = modl + (size_t)(row >> 12) * 12288; const float* mb2 = modl + (size_t)(row2 >> 12) * 12288;
#pragma unroll
        for (int j = 0; j < 8; ++j) { const int col = 4 * (64 * j + lane);
            const f32x4 g4 = *(const f32x4*)(g + col);
            { const f32x4 sc = *(const f32x4*)(mb + sc_off + col), sh = *(const f32x4*)(mb + sh_off + col);
              const f32x4 y = v[j] * r * g4; const f32x4 h = y * (sc + 1.f) + sh;
              u32x2 w; w.x = pk2(h.x, h.y); w.y = pk2(h.z, h.w); *(u32x2*)(XN + (size_t)row * DM + col) = w; }
            { const f32x4 sc = *(const f32x4*)(mb2 + sc_off + col), sh = *(const f32x4*)(mb2 + sh_off + col);
              const f32x4 y = v2[j] * r2 * g4; const f32x4 h = y * (sc + 1.f) + sh;
              u32x2 w; w.x = pk2(h.x, h.y); w.y = pk2(h.z, h.w); *(u32x2*)(XN + (size_t)row2 * DM + col) = w; } }
    }
}

__device__ __forceinline__ void conv_gate_phase(const bf16_t* U, const float* cw, const float* cb, bf16_t* Gout, int G, int tid) {
    for (int item = blockIdx.x * 512 + tid; item < 1024 * 704; item += G * 512) {
        const int cg8 = item % 704, run = item / 704; const int row0 = run * 16, c0 = cg8 * 8; const bool first = (row0 & 4095) == 0;
        float wg[3][8], wv[3][8], bg[8], bv[8];
#pragma unroll
        for (int j = 0; j < 3; ++j) {
            const f32x4 a0 = *(const f32x4*)(cw + j * DFF2 + c0), a1 = *(const f32x4*)(cw + j * DFF2 + c0 + 4);
            const f32x4 b0 = *(const f32x4*)(cw + j * DFF2 + DFF + c0), b1 = *(const f32x4*)(cw + j * DFF2 + DFF + c0 + 4);
#pragma unroll
            for (int e = 0; e < 4; ++e) { wg[j][e] = a0[e]; wg[j][4 + e] = a1[e]; wv[j][e] = b0[e]; wv[j][4 + e] = b1[e]; }
        }
        { const f32x4 a0 = *(const f32x4*)(cb + c0), a1 = *(const f32x4*)(cb + c0 + 4), b0 = *(const f32x4*)(cb + DFF + c0), b1 = *(const f32x4*)(cb + DFF + c0 + 4);
#pragma unroll
          for (int e = 0; e < 4; ++e) { bg[e] = a0[e]; bg[4 + e] = a1[e]; bv[e] = b0[e]; bv[4 + e] = b1[e]; } }
        float g2[8], g1[8], v2[8], v1[8];
#pragma unroll
        for (int e = 0; e < 8; ++e) { g2[e] = 0.f; g1[e] = 0.f; v2[e] = 0.f; v1[e] = 0.f; }
        if (!first) {
            const u32x4 a = *(const u32x4*)(U + (size_t)(row0 - 2) * DFF2 + c0), b = *(const u32x4*)(U + (size_t)(row0 - 2) * DFF2 + DFF + c0);
            const u32x4 c = *(const u32x4*)(U + (size_t)(row0 - 1) * DFF2 + c0), d = *(const u32x4*)(U + (size_t)(row0 - 1) * DFF2 + DFF + c0);
#pragma unroll
            for (int e = 0; e < 4; ++e) { g2[2 * e] = bflo(a[e]); g2[2 * e + 1] = bfhi(a[e]); v2[2 * e] = bflo(b[e]); v2[2 * e + 1] = bfhi(b[e]);
                                          g1[2 * e] = bflo(c[e]); g1[2 * e + 1] = bfhi(c[e]); v1[2 * e] = bflo(d[e]); v1[2 * e + 1] = bfhi(d[e]); }
        }
#pragma unroll 8
        for (int t = 0; t < 16; ++t) {
            const u32x4 a = *(const u32x4*)(U + (size_t)(row0 + t) * DFF2 + c0), b = *(const u32x4*)(U + (size_t)(row0 + t) * DFF2 + DFF + c0);
            float gc[8], vc[8], r[8];
#pragma unroll
            for (int e = 0; e < 4; ++e) { gc[2 * e] = bflo(a[e]); gc[2 * e + 1] = bfhi(a[e]); vc[2 * e] = bflo(b[e]); vc[2 * e + 1] = bfhi(b[e]); }
#pragma unroll
            for (int e = 0; e < 8; ++e) {
                const float gg = wg[0][e] * g2[e] + wg[1][e] * g1[e] + wg[2][e] * gc[e] + bg[e];
                const float vv = wv[0][e] * v2[e] + wv[1][e] * v1[e] + wv[2][e] * vc[e] + bv[e];
                r[e] = gg / (1.f + __expf(-gg)) * vv;
                g2[e] = g1[e]; g1[e] = gc[e]; v2[e] = v1[e]; v1[e] = vc[e];
            }
            u32x4 o; o.x = pk2(r[0], r[1]); o.y = pk2(r[2], r[3]); o.z = pk2(r[4], r[5]); o.w = pk2(r[6], r[7]);
            *(u32x4*)(Gout + (size_t)(row0 + t) * DFF + c0) = o;
        }
    }
}

#define XB_TMO      128
#define XB_XCNT(j)  (256  + 64 * (j))
#define XB_XSUB(j)  (1280 + 64 * (j))
#define XB_XGEN(j)  (2304 + 64 * (j))
#define XB_TOP      3328
#define XB_TOPGEN   3392
#define XCD_BAR_WORDS 3456
#define XB_SPIN_CAP (1u << 18)

__device__ __forceinline__ unsigned xb_ld(unsigned* p)              { return __hip_atomic_load(p, __ATOMIC_RELAXED, __HIP_MEMORY_SCOPE_AGENT); }
__device__ __forceinline__ unsigned xb_add(unsigned* p, unsigned v) { return __hip_atomic_fetch_add(p, v, __ATOMIC_RELAXED, __HIP_MEMORY_SCOPE_AGENT); }
__device__ __forceinline__ unsigned xb_xcc_id() { return (unsigned)__builtin_amdgcn_s_getreg((3 << 11) | 20) & 0xFu; }
#define XB_SPIN(cond, bar) do { unsigned _sp = 0; while (cond) { __builtin_amdgcn_s_sleep(1); \
    if ((++_sp & 255u) == 0u) { if (xb_ld(&(bar)[XB_TMO])) break; if (_sp > XB_SPIN_CAP) { atomicAdd(&(bar)[XB_TMO], 1u); break; } } } } while (0)

struct XcdBarrier {
    unsigned* bar; unsigned x;
    volatile LAS unsigned* st;
};

__device__ __forceinline__ XcdBarrier xcd_barrier_post(unsigned* bar, volatile LAS unsigned* st) {
    XcdBarrier b; b.bar = bar; b.x = (unsigned)__builtin_amdgcn_readfirstlane((int)xb_xcc_id()); b.st = st;
    if (threadIdx.x == 0) (void)xb_add(&bar[XB_XCNT(b.x)], 1u);
    return b;
}
__device__ __forceinline__ void xcd_barrier_complete(unsigned* bar, unsigned x, unsigned& nloc, unsigned& nx) {
    const unsigned G = gridDim.x * gridDim.y * gridDim.z;
    unsigned sum, cnt, mine, sp = 0u;
    for (;;) {
        sum = 0u; cnt = 0u; mine = 0u;
#pragma unroll
        for (unsigned j = 0; j < 16; ++j) { const unsigned c = xb_ld(&bar[XB_XCNT(j)]); sum += c; cnt += (c > 0u) ? 1u : 0u; mine = (j == x) ? c : mine; }
        if (sum == G) break;
        __builtin_amdgcn_s_sleep(1);
        if ((++sp & 255u) == 0u) { if (xb_ld(&bar[XB_TMO])) break; if (sp > XB_SPIN_CAP) { atomicAdd(&bar[XB_TMO], 1u); break; } }
    }
    nloc = mine > 0u ? mine : 1u; nx = cnt > 0u ? cnt : 1u;
}

__device__ __forceinline__ void xcd_barrier(const XcdBarrier& b) {
    asm volatile("s_waitcnt vmcnt(0)" ::: "memory");
    __syncthreads();
    if (threadIdx.x == 0) {
        unsigned* bar = b.bar;
        __builtin_amdgcn_s_waitcnt(0);
        unsigned nloc = b.st[0], nx = b.st[1];
        if (nloc == 0u) { xcd_barrier_complete(bar, b.x, nloc, nx); b.st[0] = nloc; b.st[1] = nx; }
        const unsigned old = xb_add(&bar[XB_XSUB(b.x)], 1u);
        const unsigned gen = old / nloc;
        if (old + 1u == (gen + 1u) * nloc) {
            __builtin_amdgcn_fence(__ATOMIC_RELEASE, "agent");
            asm volatile("s_waitcnt vmcnt(0)" ::: "memory");
            const unsigned og = xb_add(&bar[XB_TOP], 1u);
            const unsigned tg = og / nx;
            if (og + 1u == (tg + 1u) * nx) xb_add(&bar[XB_TOPGEN], 1u);
            else XB_SPIN(xb_ld(&bar[XB_TOPGEN]) == tg, bar);
            __builtin_amdgcn_fence(__ATOMIC_ACQUIRE, "agent");
            xb_add(&bar[XB_XGEN(b.x)], 1u);
            asm volatile("s_waitcnt vmcnt(0)" ::: "memory");
        } else {
            XB_SPIN(xb_ld(&bar[XB_XGEN(b.x)]) == gen, bar);
            __builtin_amdgcn_fence(__ATOMIC_ACQUIRE, "agent");
            asm volatile("s_waitcnt vmcnt(0)" ::: "memory");
        }
    }
    __syncthreads();
}

__global__ void __launch_bounds__(512, 2) mega_fwd(Args a) {
    extern __shared__ __attribute__((aligned(16))) unsigned char lds[];
    cg::grid_group grid = cg::this_grid();
    LAS unsigned char* L = (LAS unsigned char*)lds;
    const int G = gridDim.x, NGW = G * 8;
    { LAS unsigned* mz = (LAS unsigned*)(L + 155648); if (threadIdx.x < 16) mz[threadIdx.x] = 0u; }
    if (blockIdx.x == 0 && threadIdx.x < 64) { unsigned* bw = (unsigned*)(a.ws + 458752);
        for (int i = threadIdx.x; i < 4096; i += 64) __hip_atomic_store(bw + i, 0u, __ATOMIC_RELAXED, __HIP_MEMORY_SCOPE_AGENT);
        __builtin_amdgcn_fence(__ATOMIC_RELEASE, "agent"); asm volatile("s_waitcnt vmcnt(0)" ::: "memory"); }
    __syncthreads();
    grid.sync();
    const XcdBarrier xbar = xcd_barrier_post((unsigned*)(a.ws + 458752), (volatile LAS unsigned*)(L + 155648));
#if DIAG
    unsigned long long* TS = (unsigned long long*)(a.ws + 460800); int ts_n = 0;
#define TSTAMP() do { if (blockIdx.x == 0 && threadIdx.x == 0) TS[ts_n] = __builtin_amdgcn_s_memrealtime(); ++ts_n; } while (0)
#else
#define TSTAMP() do { } while (0)
#endif
#define GSYNC() do { XcdBarrier xb2_; xb2_.bar = (unsigned*)(a.ws + 458752); { unsigned xx_ = xbar.x; asm volatile("" : "+s"(xx_)); xb2_.x = xx_; } xb2_.st = (volatile LAS unsigned*)(L + 155648); xcd_barrier(xb2_); TSTAMP(); } while (0)
#define IDS int tid = threadIdx.x; asm volatile("" : "+v"(tid)); const int lane = tid & 63, wave = __builtin_amdgcn_readfirstlane(tid >> 6), fr = lane & 15, fq = lane >> 4; const int gw = blockIdx.x * 8 + wave; (void)fr; (void)fq; (void)gw; (void)lane; \
            LAS float* scr = (LAS float*)(L + wave * 16640); (void)scr;
    unsigned char* ws = a.ws;
    float* MOD = (float*)(ws + WS_MOD);
    bf16_t* WUKT = (bf16_t*)(ws + WS_WUKT); bf16_t* WUVT = (bf16_t*)(ws + WS_WUVT);
    bf16_t* WIN = (bf16_t*)(ws + WS_WIN); bf16_t* WOUT = (bf16_t*)(ws + WS_WOUT); bf16_t* WUP = (bf16_t*)(ws + WS_WUP); bf16_t* WDN = (bf16_t*)(ws + WS_WDN);
    bf16_t* XN = (bf16_t*)(ws + WS_XN); bf16_t* PROJ = (bf16_t*)(ws + WS_BIG); bf16_t* UB = (bf16_t*)(ws + WS_BIG); bf16_t* QLAT = (bf16_t*)(ws + WS_QLAT);
    bf16_t* GB = (bf16_t*)(ws + WS_G); bf16_t* ATT = (bf16_t*)(ws + WS_ATT); bf16_t* CKV = (bf16_t*)(ws + WS_CKV);
    int* IDX = (int*)(ws + WS_IDX); int* CNT = (int*)(ws + WS_CNT); float* HBUF = (float*)(ws + WS_BIG); bf16_t* KIC = (bf16_t*)(ws + WS_CNT + MiB);
    const float* x_in = a.in[0]; const float* rel_bias = a.in[2];
    float* xres = a.out;

    TSTAMP();
    {
        IDS
        LAS float* cs = (LAS float*)L; LAS float* red = cs + 8192;
        for (int it = blockIdx.x; it < 256; it += G) {
            const int i = it >> 7, jc = it & 127;
            for (int idx = tid; idx < 8192; idx += 512) { const float v = a.in[1][idx]; cs[idx] = v / (1.f + expf(-v)); }
            __syncthreads();
            if (tid < 384) {
                const int cq = tid % 24, kg = tid / 24;
                const float* w = a.in[3] + (size_t)i * 2048 * 12288 + jc * 96 + cq * 4;
                f32x4 ac[4];
#pragma unroll
                for (int b = 0; b < 4; ++b) ac[b] = (f32x4){0.f, 0.f, 0.f, 0.f};
#pragma unroll 8
                for (int kk = 0; kk < 128; ++kk) { const int k = kg * 128 + kk; const f32x4 wv = *(const f32x4*)(w + (size_t)k * 12288);
#pragma unroll
                    for (int b = 0; b < 4; ++b) ac[b] += wv * cs[b * 2048 + k]; }
#pragma unroll
                for (int b = 0; b < 4; ++b) *(LAS f32x4*)(red + (kg * 4 + b) * 96 + cq * 4) = ac[b];
            }
            __syncthreads();
            if (tid < 384) { const int b = tid / 96, col = tid % 96; float s = a.in[4][i * 12288 + jc * 96 + col];
#pragma unroll
              for (int k2 = 0; k2 < 16; ++k2) s += red[(k2 * 4 + b) * 96 + col];
              MOD[(size_t)(i * 4 + b) * 12288 + jc * 96 + col] = s; }
            __syncthreads();
        }
        convert_matrix(a.in[7], 2048, EV_IN, EV_PITCH, WIN, scr, gw, NGW, lane);
        convert_matrix(a.in[12], 2048, 2048, 2048, WOUT, scr, gw, NGW, lane);
        convert_matrix<1>(a.in[15], 2048, DFF2, DFF2, WUP, scr, gw, NGW, lane);
        convert_matrix(a.in[18], DFF, 2048, 2048, WDN, scr, gw, NGW, lane);
        for (int h = 0; h < 16; ++h) {
            convert_matrix(a.in[9] + (size_t)h * 64 * 256, 64, 256, 256, WUKT + (size_t)h * 256 * 64, scr, gw, NGW, lane);
            convert_matrix(a.in[10] + (size_t)h * 256 * 64, 256, 64, 64, WUVT + (size_t)h * 64 * 256, scr, gw, NGW, lane);
        }
    }
    GSYNC();

#pragma unroll
    for (int layer = 0; layer < 2; ++layer) {
        const float* modl = MOD + (size_t)layer * 4 * 12288;
        const float* xcur = (layer == 0) ? x_in : (const float*)xres;
        { IDS
        norm_mod_phase(xcur, a.in[5] + layer * DM, modl, 0, 2048, XN, gw, NGW, lane);
        if (layer == 1) {
            convert_matrix(a.in[13], 2048, OD_PITCH, OD_PITCH, WIN, scr, gw, NGW, lane);
            convert_matrix(a.in[14], 2048, 2048, 2048, WOUT, scr, gw, NGW, lane);
            convert_matrix<1>(a.in[15] + (size_t)2048 * DFF2, 2048, DFF2, DFF2, WUP, scr, gw, NGW, lane);
            convert_matrix(a.in[18] + (size_t)DFF * 2048, DFF, 2048, 2048, WDN, scr, gw, NGW, lane);
        } }
        GSYNC();
#if SKIP_SWA || SKIP_DSA || SKIP_SB
        { IDS for (size_t i = (size_t)blockIdx.x * 512 + tid; i < (size_t)MTOK * DM / 8; i += (size_t)G * 512) ((u32x4*)ATT)[i] = (u32x4){0u, 0u, 0u, 0u}; }
#endif
        if (layer == 0) {
            { pg8::Gemm g{XN, WIN, MTOK, EV_PITCH, 2048}; pg8::StaticOrder S; S.init(MTOK, EV_PITCH, G, (int)blockIdx.x);
              pg8::EpiBf16 E{PROJ, EV_PITCH, KIC, C_KI / 256};
              pg8::gemm_phase<pg8::EpiBf16, pg8::StaticOrder, true, true>(L, g, S, E); }
            GSYNC();
            { IDS
            for (int row = gw; row < MTOK; row += NGW) {
                const u32x2 w = *(const u32x2*)(PROJ + (size_t)row * EV_PITCH + C_CLAT + 4 * lane);
                const float x0 = bflo(w.x), x1 = bfhi(w.x), x2 = bflo(w.y), x3 = bfhi(w.y);
                const float ss = wave_sum((x0 * x0 + x1 * x1) + (x2 * x2 + x3 * x3));
                const float r = rsqrtf(ss * (1.f / 256.f) + EPS);
                const f32x4 g4 = *(const f32x4*)(a.in[8] + 4 * lane);
                u32x2 o; o.x = pk2(x0 * r * g4.x, x1 * r * g4.y); o.y = pk2(x2 * r * g4.z, x3 * r * g4.w);
                *(u32x2*)(CKV + (size_t)row * 256 + 4 * lane) = o;
            } }
            { IDS
            for (int unit = gw; unit < 16384; unit += NGW) {
                const int h = unit & 15, t0 = (unit >> 4) * 16;
                bf16x8 bq[2];
#pragma unroll
                for (int ks = 0; ks < 2; ++ks) bq[ks] = *(const bf16x8*)(PROJ + (size_t)(t0 + fr) * EV_PITCH + C_QB + h * 64 + 32 * ks + 8 * fq);
#pragma unroll
                for (int rg = 0; rg < 2; ++rg) {
                    bf16x8 aw[8][2];
#pragma unroll
                    for (int r8 = 0; r8 < 8; ++r8)
#pragma unroll
                        for (int ks = 0; ks < 2; ++ks) aw[r8][ks] = *(const bf16x8*)(WUKT + (size_t)(h * 256 + 16 * (8 * rg + r8) + fr) * 64 + 32 * ks + 8 * fq);
#pragma unroll
                    for (int r8 = 0; r8 < 8; ++r8) { const int rt = 8 * rg + r8;
                        f32x4 acc = (f32x4){0.f, 0.f, 0.f, 0.f};
                        acc = MFMA16(aw[r8][0], bq[0], acc); acc = MFMA16(aw[r8][1], bq[1], acc);
                        u32x2 o; o.x = pk2(acc[0] * 0.125f, acc[1] * 0.125f); o.y = pk2(acc[2] * 0.125f, acc[3] * 0.125f);
                        *(u32x2*)(QLAT + ((size_t)(t0 + fr) * 16 + h) * 256 + 16 * rt + 4 * fq) = o; }
                }
            } }
#if !SKIP_DSA
            {
                IDS
                LAS float* sc = (LAS float*)L;
                __syncthreads();
                for (int uu = blockIdx.x; uu < 2048; uu += G) {
                    const int kk = uu / G, bi = uu - kk * G;
                    const int unit = (G == 256) ? ((kk >> 1) * 512 + ((kk & 1) ? 511 - bi : bi)) : uu;
                    const int row0 = unit * 8, b = row0 >> 12, c = (row0 & 4095) >> 6, nall = (c + 1) * 64;
                    const int row = row0 + wave;
                    int* idxp = IDX + (size_t)row * 256;
                    if (nall <= 256) { for (int i = lane; i < nall; i += 64) idxp[i] = i; if (lane == 0) CNT[row] = nall; continue; }
                    const int nquads = c + 1, ntiles = nall >> 4;
                    bf16x8 qa[4][2];
#pragma unroll
                    for (int hp = 0; hp < 4; ++hp)
#pragma unroll
                        for (int ks = 0; ks < 2; ++ks) qa[hp][ks] = *(const bf16x8*)(PROJ + (size_t)(row0 + (fr & 7)) * EV_PITCH + C_QI + (2 * hp + (fr >> 3)) * 64 + 32 * ks + 8 * fq);
                    float wq[4][4];
#pragma unroll
                    for (int hp = 0; hp < 4; ++hp)
#pragma unroll
                        for (int j = 0; j < 4; ++j) wq[hp][j] = __uint_as_float((unsigned)PROJ[(size_t)(row0 + 4 * (fq & 1) + j) * EV_PITCH + C_WI + 2 * hp + (fq >> 1)] << 16);
                    const bf16_t* kbase = KIC + ((size_t)b * SEQ + fr) * 64 + 8 * fq;
#pragma unroll 8
                    for (int t = wave; t < ntiles; t += 8) {
                        const bf16_t* kp = kbase + (size_t)(16 * t) * 64;
                        const bf16x8 b0 = *(const bf16x8*)kp, b1 = *(const bf16x8*)(kp + 32);
                        float part[4] = {0.f, 0.f, 0.f, 0.f};
#pragma unroll
                        for (int hp = 0; hp < 4; ++hp) {
                            f32x4 acc = (f32x4){0.f, 0.f, 0.f, 0.f};
                            acc = MFMA16(qa[hp][0], b0, acc); acc = MFMA16(qa[hp][1], b1, acc);
#pragma unroll
                            for (int j = 0; j < 4; ++j) part[j] += wq[hp][j] * fmaxf(acc[j], 0.f);
                        }
#pragma unroll
                        for (int j = 0; j < 4; ++j) part[j] += __shfl_xor(part[j], 32);
                        if (fq < 2) {
#pragma unroll
                            for (int j = 0; j < 4; ++j) sc[(4 * fq + j) * 4096 + 16 * t + fr] = part[j];
                        }
                    }
                    __syncthreads();
                    unsigned v[64];
#pragma unroll
                    for (int q = 0; q < 64; ++q) {
                        unsigned val = 0u;
                        if (q < nquads) { unsigned u = __float_as_uint(sc[wave * 4096 + 64 * q + lane]); if (u == 0x80000000u) u = 0u; val = (u & 0x80000000u) ? ~u : (u | 0x80000000u); }
                        v[q] = val;
                    }
                    unsigned T = 0u;
                    for (int bit = 31; bit >= 0; --bit) {
                        const unsigned cand = T | (1u << bit); int cnt = 0;
#pragma unroll
                        for (int qg = 0; qg < 4; ++qg) {
                            if (16 * qg < nquads) {
#pragma unroll
                                for (int q = 16 * qg; q < 16 * qg + 16; ++q) cnt += __popcll(__ballot(v[q] >= cand));
                            }
                        }
                        if (cnt >= 256) T = cand;
                        if (cnt == 256) break;
                    }
                    int cgt = 0;
#pragma unroll
                    for (int q = 0; q < 64; ++q) cgt += __popcll(__ballot(v[q] > T));
                    int need = 256 - cgt, pos = 0;
                    const unsigned long long ltmask = (1ull << lane) - 1ull;
#pragma unroll
                    for (int q = 0; q < 64; ++q) {
                        if (q < nquads) {
                            const bool gt = v[q] > T, eq = v[q] == T;
                            const unsigned long long meq = __ballot(eq);
                            const int eqrank = __popcll(meq & ltmask);
                            const bool sel = gt || (eq && eqrank < need);
                            const unsigned long long msel = __ballot(sel);
                            if (sel) idxp[pos + __popcll(msel & ltmask)] = q * 64 + lane;
                            pos += __popcll(msel);
                            const int neq = __popcll(meq); need -= (neq < need ? neq : need);
                        }
                    }
                    if (lane == 0) CNT[row] = 256;
                    __syncthreads();
                }
            }
#endif
#if !SKIP_SWA
            {
                IDS
                LAS bf16_t* Vt = (LAS bf16_t*)L;
                LAS float* bT = (LAS float*)(L + 64 * 200 * 2);
                LAS bf16_t* Kl = (LAS bf16_t*)(L + 64 * 200 * 2 + 4096);
                __syncthreads();
                { const int kvh0 = blockIdx.x & 3;
                  for (int idx = tid; idx < 1024; idx += 512) { const int g = idx >> 8, ri = idx & 255; bT[idx] = rel_bias[t5_bucket(ri - 191) * 32 + kvh0 * 4 + g]; } }
                for (int unit = blockIdx.x; unit < 1024; unit += G) {
                    const int b = unit >> 8, c = (unit >> 2) & 63, kvh = unit & 3;
                    const int kstart = (c >= 2 ? c - 2 : 0) * 64, nk = (c + 1) * 64 - kstart;
                    const size_t rowbase = (size_t)b * SEQ;
                    { u32x4 kx[3], vx[3];
#pragma unroll
                      for (int it = 0; it < 3; ++it) { const int i = tid + 512 * it; int key = i >> 3; const int ch = i & 7; key = key < nk ? key : nk - 1;
                          const bf16_t* src = PROJ + (rowbase + kstart + key) * EV_PITCH + kvh * 64 + ch * 8;
                          kx[it] = *(const u32x4*)(src + C_KA); vx[it] = *(const u32x4*)(src + C_VA); }
#pragma unroll
                      for (int it = 0; it < 3; ++it) { const int i = tid + 512 * it; const int key = i >> 3, ch = i & 7;
                          *(LAS u32x4*)(Kl + key * 72 + ch * 8) = kx[it];
                          const u32x4 w = vx[it]; LAS bf16_t* vp = Vt + (ch * 8) * 200 + key;
                          vp[0 * 200] = (bf16_t)(w.x & 0xffffu); vp[1 * 200] = (bf16_t)(w.x >> 16); vp[2 * 200] = (bf16_t)(w.y & 0xffffu); vp[3 * 200] = (bf16_t)(w.y >> 16);
                          vp[4 * 200] = (bf16_t)(w.z & 0xffffu); vp[5 * 200] = (bf16_t)(w.z >> 16); vp[6 * 200] = (bf16_t)(w.w & 0xffffu); vp[7 * 200] = (bf16_t)(w.w >> 16); } }
                    __syncthreads();
                    const int g = wave >> 1, qh = wave & 1, head = kvh * 4 + g, q0 = c * 64 + qh * 32;
                    const int ntile = nk >> 4;
                    const float sink = a.in[11][head];
#pragma unroll 1
                    for (int m = 0; m < 2; ++m) {
                        const int qpos = q0 + 16 * m + fr;
                        bf16x8 bq[2];
#pragma unroll
                        for (int ks = 0; ks < 2; ++ks) bq[ks] = *(const bf16x8*)(PROJ + (rowbase + qpos) * EV_PITCH + C_QA + head * 64 + 32 * ks + 8 * fq);
                        f32x4 s1[12];
                        float mx = -1e30f;
#pragma unroll
                        for (int t = 0; t < 12; ++t) {
                            if (t < ntile) {
                                const LAS bf16_t* kp = Kl + (16 * t + fr) * 72 + 8 * fq;
                                const bf16x8 k0 = *(const LAS bf16x8*)kp, k1 = *(const LAS bf16x8*)(kp + 32);
                                f32x4 acc = (f32x4){0.f, 0.f, 0.f, 0.f}; acc = MFMA16(k0, bq[0], acc); acc = MFMA16(k1, bq[1], acc);
#pragma unroll
                                for (int j = 0; j < 4; ++j) { const int ri = (kstart + 16 * t + 4 * fq + j) - qpos + 191; const float vv = acc[j] * 0.125f + bT[g * 256 + ri]; acc[j] = vv; mx = fmaxf(mx, vv); }
                                s1[t] = acc;
                            } else s1[t] = (f32x4){0.f, 0.f, 0.f, 0.f};
                        }
                        mx = fmaxf(mx, __shfl_xor(mx, 16)); mx = fmaxf(mx, __shfl_xor(mx, 32)); mx = fmaxf(mx, sink);
                        float sum = 0.f;
#pragma unroll
                        for (int t = 0; t < 12; ++t)
                            if (t < ntile) {
#pragma unroll
                                for (int j = 0; j < 4; ++j) { const float p = __expf(s1[t][j] - mx); s1[t][j] = p; sum += p; }
                            }
                        sum += __shfl_xor(sum, 16); sum += __shfl_xor(sum, 32);
                        const float inv = 1.f / (sum + __expf(sink - mx));
                        f32x4 o[4];
#pragma unroll
                        for (int dt = 0; dt < 4; ++dt) o[dt] = (f32x4){0.f, 0.f, 0.f, 0.f};
#pragma unroll
                        for (int st = 0; st < 6; ++st) {
                            if (2 * st < ntile) {
                                const bf16x8 pb = mk8(pk2(s1[2 * st][0], s1[2 * st][1]), pk2(s1[2 * st][2], s1[2 * st][3]), pk2(s1[2 * st + 1][0], s1[2 * st + 1][1]), pk2(s1[2 * st + 1][2], s1[2 * st + 1][3]));
#pragma unroll
                                for (int dt = 0; dt < 4; ++dt) {
                                    const LAS bf16_t* vp = Vt + (16 * dt + fr) * 200 + 32 * st + 4 * fq;
                                    const u32x2 lo = *(const LAS u32x2*)vp, hi = *(const LAS u32x2*)(vp + 16);
                                    o[dt] = MFMA16(mk8(lo.x, lo.y, hi.x, hi.y), pb, o[dt]);
                                }
                            }
                        }
#pragma unroll
                        for (int dt = 0; dt < 4; ++dt) { u32x2 w; w.x = pk2(o[dt][0] * inv, o[dt][1] * inv); w.y = pk2(o[dt][2] * inv, o[dt][3] * inv);
                            *(u32x2*)(ATT + (rowbase + qpos) * DM + head * 64 + 16 * dt + 4 * fq) = w; }
                    }
                    __syncthreads();
                }
            }
#endif
                        GSYNC();
#if !SKIP_DSA
            {
                IDS
                LAS float* bB = (LAS float*)(L + 8 * 16896);
                if (tid < 512) bB[tid] = rel_bias[(tid >> 4) * 32 + 16 + (tid & 15)];
                __syncthreads();
                LAS bf16_t* cb = (LAS bf16_t*)(L + wave * 16896);
                for (int row = gw; row < MTOK; row += NGW) {
                    const int b = row >> 12, tpos = row & 4095; const size_t rowbase = (size_t)b * SEQ;
                    const int cnt = __builtin_amdgcn_readfirstlane(CNT[row]); const int nch = cnt >> 5;
                    bf16x8 ql[8];
#pragma unroll
                    for (int ks = 0; ks < 8; ++ks) ql[ks] = *(const bf16x8*)(QLAT + ((size_t)row * 16 + fr) * 256 + 32 * ks + 8 * fq);
                    f32x4 o[16];
#pragma unroll
                    for (int rt = 0; rt < 16; ++rt) o[rt] = (f32x4){0.f, 0.f, 0.f, 0.f};
                    float mrun = -1e30f, lpart = 0.f;
                    int idxall[4];
#pragma unroll
                    for (int i = 0; i < 4; ++i) { const int e = 64 * i + lane; idxall[i] = (e < cnt) ? IDX[(size_t)row * 256 + e] : 0; }
                    u32x4 gw[16];
#define DSA_ISSUE(CH) do { const int c_ = (CH); const int s01_ = (c_ & 2) ? idxall[1] : idxall[0], s23_ = (c_ & 2) ? idxall[3] : idxall[2]; const int sel_ = (c_ & 4) ? s23_ : s01_; const int bl_ = 32 * (c_ & 1); \
        _Pragma("unroll") for (int it = 0; it < 16; ++it) { const int key = 2 * it + (lane >> 5), seg = lane & 31; const int kidx = __shfl(sel_, bl_ + key); \
            gw[it] = *(const u32x4*)(CKV + (rowbase + kidx) * 256 + seg * 8); } } while (0)
                    DSA_ISSUE(0);
                    for (int ch = 0; ch < nch; ++ch) {
                        const int s01 = (ch & 2) ? idxall[1] : idxall[0], s23 = (ch & 2) ? idxall[3] : idxall[2]; const int myidx = (ch & 4) ? s23 : s01; const int mybl = 32 * (ch & 1);
#pragma unroll
                        for (int it = 0; it < 16; ++it) { const int key = 2 * it + (lane >> 5), seg = lane & 31; *(LAS u32x4*)(cb + key * 264 + seg * 8) = gw[it]; }
                        asm volatile("s_waitcnt lgkmcnt(0)" ::: "memory");
                        if (ch + 1 < nch) DSA_ISSUE(ch + 1);
                        f32x4 sa[2];
#pragma unroll
                        for (int kt = 0; kt < 2; ++kt) { f32x4 acc = (f32x4){0.f, 0.f, 0.f, 0.f};
#pragma unroll
                            for (int ks = 0; ks < 8; ++ks) { const bf16x8 ac = *(const LAS bf16x8*)(cb + (16 * kt + fr) * 264 + 32 * ks + 8 * fq); acc = MFMA16(ac, ql[ks], acc); }
                            sa[kt] = acc; }
                        float cm = -1e30f;
                        const int mybucket = t5_bucket(__shfl(myidx, mybl + (lane & 31)) - tpos) * 16;
#pragma unroll
                        for (int kt = 0; kt < 2; ++kt)
#pragma unroll
                            for (int j = 0; j < 4; ++j) { const int bk = __shfl(mybucket, 16 * kt + 4 * fq + j); const float vv = sa[kt][j] + bB[bk + fr]; sa[kt][j] = vv; cm = fmaxf(cm, vv); }
                        cm = fmaxf(cm, __shfl_xor(cm, 16)); cm = fmaxf(cm, __shfl_xor(cm, 32));
                        const float mnew = fmaxf(mrun, cm), alpha = __expf(mrun - mnew); mrun = mnew;
                        float ps = 0.f;
#pragma unroll
                        for (int kt = 0; kt < 2; ++kt)
#pragma unroll
                            for (int j = 0; j < 4; ++j) { const float p = __expf(sa[kt][j] - mnew); sa[kt][j] = p; ps += p; }
                        lpart = lpart * alpha + ps;
                        if (__any(alpha != 1.f)) {
#pragma unroll
                            for (int rt = 0; rt < 16; ++rt) o[rt] *= alpha;
                        }
                        const bf16x8 pb = mk8(pk2(sa[0][0], sa[0][1]), pk2(sa[0][2], sa[0][3]), pk2(sa[1][0], sa[1][1]), pk2(sa[1][2], sa[1][3]));
#pragma unroll
                        for (int rt = 0; rt < 16; ++rt) {
                            const LAS bf16_t* cp = cb + (4 * fq + (fr >> 2)) * 264 + 16 * rt + 4 * (fr & 3);
                            const s16x4_t lo = lds_tr4(cp), hi = lds_tr4(cp + 16 * 264);
                            const bf16x8 av = __builtin_shufflevector(lo, hi, 0, 1, 2, 3, 4, 5, 6, 7);
                            o[rt] = MFMA16(av, pb, o[rt]);
                        }
                        asm volatile("s_waitcnt lgkmcnt(0)" ::: "memory");
                    }
                    float l = lpart + __shfl_xor(lpart, 16); l += __shfl_xor(l, 32);
                    const float inv = 1.f / l;
#pragma unroll
                    for (int rt = 0; rt < 16; ++rt) { u32x2 w; w.x = pk2(o[rt][0] * inv, o[rt][1] * inv); w.y = pk2(o[rt][2] * inv, o[rt][3] * inv);
                        *(u32x2*)(QLAT + ((size_t)row * 16 + fr) * 256 + 16 * rt + 4 * fq) = w; }
                }
            }
#endif
            GSYNC();
#if !SKIP_DSA
            { IDS
            for (int unit = gw; unit < 16384; unit += NGW) {
                const int h = unit & 15, t0 = (unit >> 4) * 16;
                bf16x8 bo[8];
#pragma unroll
                for (int ks = 0; ks < 8; ++ks) bo[ks] = *(const bf16x8*)(QLAT + ((size_t)(t0 + fr) * 16 + h) * 256 + 32 * ks + 8 * fq);
#pragma unroll
                for (int dt = 0; dt < 4; ++dt) {
                    f32x4 acc = (f32x4){0.f, 0.f, 0.f, 0.f};
                    bf16x8 aw[8];
#pragma unroll
                    for (int ks = 0; ks < 8; ++ks) aw[ks] = *(const bf16x8*)(WUVT + (size_t)(h * 64 + 16 * dt + fr) * 256 + 32 * ks + 8 * fq);
#pragma unroll
                    for (int ks = 0; ks < 8; ++ks) acc = MFMA16(aw[ks], bo[ks], acc);
                    u32x2 w; w.x = pk2(acc[0], acc[1]); w.y = pk2(acc[2], acc[3]);
                    *(u32x2*)(ATT + (size_t)(t0 + fr) * DM + 1024 + h * 64 + 16 * dt + 4 * fq) = w;
                }
            } }
#endif
            GSYNC();
        } else {
            { pg8::Gemm g{XN, WIN, MTOK, OD_PITCH, 2048}; pg8::StaticOrder S; S.init(MTOK, OD_PITCH, G, (int)blockIdx.x);
              pg8::EpiBf16 E{PROJ, OD_PITCH, nullptr, 0};
              pg8::gemm_phase<pg8::EpiBf16, pg8::StaticOrder, true, true>(L, g, S, E); }
            GSYNC();
#if SKIP_SB == 2
            { IDS for (size_t i = (size_t)blockIdx.x * 512 + tid; i < (size_t)MTOK * 256; i += (size_t)G * 512) { const size_t row = i >> 8, c8 = i & 255; ((u32x4*)ATT)[i] = *(const u32x4*)(PROJ + row * OD_PITCH + 4096 + c8 * 8); } }
#endif
#if !SKIP_SB
            {
                IDS
                LAS bf16_t* vb = (LAS bf16_t*)(L + wave * 8704);
                for (int unit = gw; unit < 8192; unit += NGW) {
                    const int qt = 127 - (unit >> 6), h = unit & 15, b = (unit >> 4) & 3; const int q0 = qt * 32; const size_t rowbase = (size_t)b * SEQ;
                    bf16x8 bq[2][4];
#pragma unroll
                    for (int m = 0; m < 2; ++m)
#pragma unroll
                        for (int ks = 0; ks < 4; ++ks) bq[m][ks] = *(const bf16x8*)(PROJ + (rowbase + q0 + 16 * m + fr) * OD_PITCH + h * 128 + 32 * ks + 8 * fq);
                    f32x4 o[8][2];
#pragma unroll
                    for (int dt = 0; dt < 8; ++dt) { o[dt][0] = (f32x4){0.f, 0.f, 0.f, 0.f}; o[dt][1] = (f32x4){0.f, 0.f, 0.f, 0.f}; }
                    float Pc[2] = {1.f, 1.f};
                    for (int kb = qt; kb >= 0; --kb) {
                        bf16x8 akk[2][4];
                        { u32x4 gw[8];
#pragma unroll
                          for (int it = 0; it < 8; ++it) { const int key = 4 * it + (lane >> 4), seg = lane & 15;
                              gw[it] = *(const u32x4*)(PROJ + (rowbase + 32 * kb + key) * OD_PITCH + 4096 + h * 128 + seg * 8); }
#pragma unroll
                          for (int kt = 0; kt < 2; ++kt)
#pragma unroll
                              for (int ks = 0; ks < 4; ++ks) akk[kt][ks] = *(const bf16x8*)(PROJ + (rowbase + 32 * kb + 16 * kt + fr) * OD_PITCH + 2048 + h * 128 + 8 * fq + 32 * ks);
                          __builtin_amdgcn_sched_barrier(0);
#pragma unroll
                          for (int it = 0; it < 8; ++it) { const int key = 4 * it + (lane >> 4), seg = lane & 15; *(LAS u32x4*)(vb + key * 136 + seg * 8) = gw[it]; } }
                        asm volatile("s_waitcnt lgkmcnt(0)" ::: "memory");
                        f32x4 z[2][2];
#pragma unroll
                        for (int kt = 0; kt < 2; ++kt) {
                            bf16x8 ak[4];
#pragma unroll
                            for (int ks = 0; ks < 4; ++ks) ak[ks] = akk[kt][ks];
#pragma unroll
                            for (int m = 0; m < 2; ++m) { f32x4 acc = (f32x4){0.f, 0.f, 0.f, 0.f};
#pragma unroll
                                for (int ks = 0; ks < 4; ++ks) acc = MFMA16(ak[ks], bq[m][ks], acc);
                                z[kt][m] = acc; }
                        }
                        const bool diag = (kb == qt);
                        bf16x8 pb[2];
#pragma unroll
                        for (int m = 0; m < 2; ++m) {
                            float kp[2][4], sg[2][4];
#pragma unroll
                            for (int kt = 0; kt < 2; ++kt)
#pragma unroll
                                for (int j = 0; j < 4; ++j) { const float t = __expf(z[kt][m][j] * 0.08838834764831845f); const float k1 = __builtin_amdgcn_rcpf(1.f + t);
                                    const bool e = !diag || (16 * kt + 4 * fq + j < 16 * m + fr); kp[kt][j] = e ? k1 : 1.f; sg[kt][j] = e ? t * k1 : 0.f; }
                            const float g0 = (kp[0][0] * kp[0][1]) * (kp[0][2] * kp[0][3]), g1 = (kp[1][0] * kp[1][1]) * (kp[1][2] * kp[1][3]);
                            float g0a[4], g1a[4];
#pragma unroll
                            for (int f = 0; f < 4; ++f) { g0a[f] = __shfl(g0, fr + 16 * f); g1a[f] = __shfl(g1, fr + 16 * f); }
                            const float tot0 = (g0a[0] * g0a[1]) * (g0a[2] * g0a[3]), tot1 = (g1a[0] * g1a[1]) * (g1a[2] * g1a[3]);
                            const float aft1 = (fq < 1 ? g1a[1] : 1.f) * (fq < 2 ? g1a[2] : 1.f) * (fq < 3 ? g1a[3] : 1.f);
                            const float aft0 = (fq < 1 ? g0a[1] : 1.f) * (fq < 2 ? g0a[2] : 1.f) * (fq < 3 ? g0a[3] : 1.f) * tot1;
                            float av[2][4];
#pragma unroll
                            for (int kt = 0; kt < 2; ++kt) { float suf = Pc[m] * (kt == 0 ? aft0 : aft1);
#pragma unroll
                                for (int j = 3; j >= 0; --j) { av[kt][j] = sg[kt][j] * suf; suf *= kp[kt][j]; } }
                            Pc[m] *= tot0 * tot1;
                            pb[m] = mk8(pk2(av[0][0], av[0][1]), pk2(av[0][2], av[0][3]), pk2(av[1][0], av[1][1]), pk2(av[1][2], av[1][3]));
                        }
#pragma unroll
                        for (int dt = 0; dt < 8; ++dt) {
                            const LAS bf16_t* cp = vb + (4 * fq + (fr >> 2)) * 136 + 16 * dt + 4 * (fr & 3);
                            const s16x4_t lo = lds_tr4(cp), hi = lds_tr4(cp + 16 * 136);
                            const bf16x8 vv = __builtin_shufflevector(lo, hi, 0, 1, 2, 3, 4, 5, 6, 7);
                            o[dt][0] = MFMA16(vv, pb[0], o[dt][0]); o[dt][1] = MFMA16(vv, pb[1], o[dt][1]);
                        }
                        asm volatile("s_waitcnt lgkmcnt(0)" ::: "memory");
                        if (__all(Pc[0] <= SB_CUT && Pc[1] <= SB_CUT)) break;
                    }
#pragma unroll
                    for (int m = 0; m < 2; ++m)
#pragma unroll
                        for (int dt = 0; dt < 8; ++dt) { u32x2 w; w.x = pk2(o[dt][m][0], o[dt][m][1]); w.y = pk2(o[dt][m][2], o[dt][m][3]);
                            *(u32x2*)(ATT + (rowbase + q0 + 16 * m + fr) * DM + h * 128 + 16 * dt + 4 * fq) = w; }
                }
            }
#endif
            GSYNC();
        }
        { pg8::Gemm g{ATT, WOUT, MTOK, 2048, 2048}; pg8::StaticOrder S; S.init(MTOK, 2048, G, (int)blockIdx.x);
          pg8::EpiResid E{xcur, xres, modl + 4096};
          pg8::gemm_phase<pg8::EpiResid, pg8::StaticOrder, true, true>(L, g, S, E); }
        GSYNC();
        { IDS norm_mod_phase(xres, a.in[6] + layer * DM, modl, 3 * 2048, 4 * 2048, XN, gw, NGW, lane); }
        GSYNC();
        { pg8::Gemm g{XN, WUP, MTOK, DFF2, 2048}; pg8::StaticOrder S; S.init(MTOK, DFF2, G, (int)blockIdx.x);
          pg8::EpiConvGate E{GB, HBUF, a.in[16] + (size_t)layer * 3 * DFF2, a.in[17] + (size_t)layer * DFF2, (LAS unsigned*)(L + 131072), 0};
          pg8::gemm_phase<pg8::EpiConvGate, pg8::StaticOrder, true, true>(L, g, S, E); }
        GSYNC();
        { IDS
          const float* cw = a.in[16] + (size_t)layer * 3 * DFF2; const float* cb = a.in[17] + (size_t)layer * DFF2;
          for (int item = blockIdx.x * 512 + tid; item < 64 * DFF; item += G * 512) {
              const int pm = item / DFF, ch = item - pm * DFF;
              const bool first = (pm & 15) == 0; const float fm = first ? 0.f : 1.f;
              const float* h = HBUF + (size_t)pm * 4 * DFF2; const float* hp = first ? h : h - (size_t)4 * DFF2;
              float u0[2], u1[2], um2[2], um1[2], w0[2], w1[2], w2[2], bb[2];
#pragma unroll
              for (int bj = 0; bj < 2; ++bj) { const int c = ch + bj * DFF;
                  u0[bj] = h[c]; u1[bj] = h[DFF2 + c]; um2[bj] = hp[2 * DFF2 + c]; um1[bj] = hp[3 * DFF2 + c];
                  w0[bj] = cw[c]; w1[bj] = cw[DFF2 + c]; w2[bj] = cw[2 * DFF2 + c]; bb[bj] = cb[c]; }
              float res[2];
#pragma unroll
              for (int r = 0; r < 2; ++r) {
                  float cvv[2];
#pragma unroll
                  for (int bj = 0; bj < 2; ++bj) {
                      const float xc = r == 0 ? u0[bj] : u1[bj], x1 = r == 0 ? um1[bj] * fm : u0[bj], x2 = r == 0 ? um2[bj] * fm : um1[bj] * fm;
                      cvv[bj] = w2[bj] * xc + w1[bj] * x1 + w0[bj] * x2 + bb[bj]; }
                  res[r] = cvv[0] / (1.f + __expf(-cvv[0])) * cvv[1];
              }
              GB[(size_t)(pm * 256) * DFF + ch] = (bf16_t)(pk2(res[0], 0.f) & 0xffffu);
              GB[(size_t)(pm * 256 + 1) * DFF + ch] = (bf16_t)(pk2(res[1], 0.f) & 0xffffu);
          } }
        GSYNC();
        { pg8::Gemm g{GB, WDN, MTOK, 2048, DFF}; pg8::StaticOrder S; S.init(MTOK, 2048, G, (int)blockIdx.x);
          pg8::EpiResid E{xres, xres, modl + 5 * 2048};
          pg8::gemm_phase<pg8::EpiResid, pg8::StaticOrder, true, true>(L, g, S, E); }
        GSYNC();
    }
#if DIAG
    { IDS
      float t1 = 0.f, t2 = 0.f;
      for (int k = 0; k < 20; ++k) { const float d = (float)(TS[k + 1] - TS[k]) * 0.01f; if ((DIAG_M1 >> k) & 1) t1 += d; if ((DIAG_M2 >> k) & 1) t2 += d; }
      const float vleak = __log2f(t1 + 1.f); (void)t2;
      for (size_t i = (size_t)blockIdx.x * 512 + tid; i < (size_t)MTOK * DM; i += (size_t)G * 512) xres[i] = vleak;
      return; }
#endif
    { IDS
    for (int row = gw; row < MTOK; row += NGW) {
        f32x4* xr = (f32x4*)(xres + (size_t)row * DM) + lane;
        f32x4 v[8]; float ss = 0.f;
#pragma unroll
        for (int j = 0; j < 8; ++j) { v[j] = xr[64 * j]; ss += (v[j].x * v[j].x + v[j].y * v[j].y) + (v[j].z * v[j].z + v[j].w * v[j].w); }
        ss = wave_sum(ss);
        const float r = rsqrtf(ss * (1.f / DM) + EPS);
#pragma unroll
        for (int j = 0; j < 8; ++j) { const f32x4 g4 = *(const f32x4*)(a.in[19] + 4 * (64 * j + lane)); xr[64 * j] = v[j] * r * g4; }
    } }
}

extern "C" void kernel_launch(void* const* d_in, const int* in_sizes, int n_in, void* d_out, int out_size, void* d_ws, size_t ws_size, hipStream_t stream) {
    static int grid = 0;
    if (grid == 0) {
        if (n_in != 20 || out_size != MTOK * DM || ws_size < WS_END) { fprintf(stderr, "kernel_launch: unexpected shapes (n_in %d, out %d, ws %zu)\n", n_in, out_size, ws_size); grid = -1; return; }
        int dev = 0, cus = 0, per_cu = 0;
        hipGetDevice(&dev); hipDeviceGetAttribute(&cus, hipDeviceAttributeMultiprocessorCount, dev);
        if (hipFuncSetAttribute((const void*)mega_fwd, hipFuncAttributeMaxDynamicSharedMemorySize, LDS_BYTES) != hipSuccess) { fprintf(stderr, "kernel_launch: hipFuncSetAttribute failed\n"); grid = -1; return; }
        if (hipOccupancyMaxActiveBlocksPerMultiprocessor(&per_cu, (const void*)mega_fwd, 512, LDS_BYTES) != hipSuccess || per_cu < 1) per_cu = 1;
        (void)hipGetLastError();
        grid = cus * (per_cu > 1 ? 1 : per_cu);
    }
    if (grid < 0) return;
    Args a{};
    for (int i = 0; i < 20; ++i) a.in[i] = (const float*)d_in[i];
    a.out = (float*)d_out; a.ws = (unsigned char*)d_ws;
    void* args[] = {&a};
    hipError_t e = hipLaunchCooperativeKernel((const void*)mega_fwd, dim3(grid), dim3(512), args, LDS_BYTES, stream);
    if (e != hipSuccess) fprintf(stderr, "cooperative launch failed: %s (grid %d)\n", hipGetErrorString(e), grid);
}
```

```cpp
#include <hip/hip_runtime.h>
#include <hip/hip_cooperative_groups.h>
#include <cstdio>
#include <cstdint>
namespace cg = cooperative_groups;

namespace pg8 {
#define PG8_LAS __attribute__((address_space(3)))
typedef unsigned short bf16_t;
typedef short bf16x8 __attribute__((ext_vector_type(8)));
typedef float f32x4 __attribute__((ext_vector_type(4)));
typedef unsigned u32x4 __attribute__((ext_vector_type(4)));
constexpr int BM = 256, BK = 64, HALF = 128, HTB = HALF * BK * 2  , STAGE_BYTES = 8 * HTB, NXCD = 8, WGM = 8;

__host__ __device__ __forceinline__ int lds_byte(int r, int c) { const int st = (r >> 4) * 2 + (c >> 5), rr = r & 15, cc = c & 31, ob = rr * 64 + cc * 2; return st * 1024 + (ob ^ (((ob >> 9) & 1) << 5)); }
__host__ __device__ __forceinline__ void stage_rc(int b, int& R, int& C) { const int st = b / 1024, sb = b % 1024, swz = sb ^ (((sb >> 9) & 1) << 5); R = (st >> 1) * 16 + swz / 64; C = (st & 1) * 32 + (swz % 64) / 2; }
__host__ __device__ __forceinline__ int perm32(int rho) { const int n = rho >> 4, i = rho & 15; return 8 * (i >> 2) + 4 * n + (i & 3); }

struct Unit { int pm, pn; };
struct Gemm { const bf16_t* A; const bf16_t* Bt; int M, N, K; };

struct StaticOrder {
    int nM, nN, nwg, G, c;
    __host__ __device__ void init(int M, int N, int G_, int c_) { nM = M / BM; nN = N / BM; nwg = nM * nN; G = G_; c = c_; }
    __host__ __device__ bool next(int i, Unit& u) const {
        const long L = (long)i * G + c; if (L >= nwg) return false;
        int wgid = (int)L; { const int q = nwg / NXCD, r = nwg % NXCD, xcd = wgid % NXCD, off = wgid / NXCD; wgid = (xcd < r ? xcd * (q + 1) : r * (q + 1) + (xcd - r) * q) + off; }
        const int nig = WGM * nN, gid = wgid / nig, fm = gid * WGM, gsz = (nM - fm) < WGM ? (nM - fm) : WGM;
        u.pm = fm + ((wgid % nig) % gsz); u.pn = (wgid % nig) / gsz; return true;
    }
    __device__ __forceinline__ void a_ready(const Unit&) const {}
    __device__ __forceinline__ void done(const Unit&) const {}
};

__device__ __forceinline__ unsigned cvt_pk_bf16(float lo, float hi) { unsigned r; asm volatile("v_cvt_pk_bf16_f32 %0, %1, %2" : "=v"(r) : "v"(lo), "v"(hi)); return r; }
typedef float f32x2 __attribute__((ext_vector_type(2)));
typedef unsigned u32x2v __attribute__((ext_vector_type(2)));
typedef float f32x2c __attribute__((ext_vector_type(2))); typedef __bf16 bf16x2c __attribute__((ext_vector_type(2)));
__device__ __forceinline__ unsigned pkb(float lo, float hi) { f32x2c v = {lo, hi}; bf16x2c b = __builtin_convertvector(v, bf16x2c); return __builtin_bit_cast(unsigned, b); }
struct EpiBf16 {
    static constexpr bool PERM = true, AFTER_DRAIN = false;
    bf16_t* O; int ldc; bf16_t* O2; int o2_pn;
    __device__ __forceinline__ void operator()(const f32x4 (&acc)[2][2][4][2], const Unit& u, int wr, int wc, int fr, int fq) const {
        const int row0 = u.pm * BM + wr * 64 + fr; const int col0 = u.pn * BM + wc * 32 + 8 * fq;
#pragma unroll
        for (int ai = 0; ai < 2; ++ai)
#pragma unroll
            for (int m = 0; m < 4; ++m) { bf16_t* rowp = O + (size_t)(row0 + ai * HALF + m * 16) * ldc + col0;
#pragma unroll
                for (int bj = 0; bj < 2; ++bj) { const f32x4 v0 = acc[ai][bj][m][0], v1 = acc[ai][bj][m][1];
                    u32x4 w; w.x = pkb(v0[0], v0[1]); w.y = pkb(v0[2], v0[3]); w.z = pkb(v1[0], v1[1]); w.w = pkb(v1[2], v1[3]);
                    *(u32x4*)(rowp + bj * HALF) = w;
                    if (O2 != nullptr && bj == 0 && u.pn == o2_pn && wc < 2) *(u32x4*)(O2 + (size_t)(row0 + ai * HALF + m * 16) * 64 + wc * 32 + 8 * fq) = w; } }
    }
};

struct EpiConvGate {
    static constexpr bool PERM = true, AFTER_DRAIN = false;
    bf16_t* Gout; float* HB; const float* cw; const float* cb; PG8_LAS unsigned* halo; mutable int parity;
    __device__ __forceinline__ void operator()(const f32x4 (&acc)[2][2][4][2], const Unit& u, int wr, int wc, int fr_, int fq_) const {
        int fr = fr_, fq = fq_; asm volatile("" : "+v"(fr), "+v"(fq));
        const int lane = fq * 16 + fr;
        PG8_LAS unsigned* hb = halo + (parity & 1) * 2048; PG8_LAS float* wl = (PG8_LAS float*)(hb + 1024); ++parity;
        const int ci = wc * 32 + 8 * fq;
        const int chg = u.pn * 128 + ci;
        { const size_t hrow = (size_t)u.pm * 4 * 11264;
          if (wr == 0 && fr < 2) {
#pragma unroll
              for (int bj = 0; bj < 2; ++bj)
#pragma unroll
                  for (int n = 0; n < 2; ++n) *(f32x4*)(HB + hrow + (size_t)fr * 11264 + bj * 5632 + chg + 4 * n) = acc[0][bj][0][n];
          }
          if (wr == 1 && fr >= 14) {
#pragma unroll
              for (int bj = 0; bj < 2; ++bj)
#pragma unroll
                  for (int n = 0; n < 2; ++n) *(f32x4*)(HB + hrow + (size_t)(2 + fr - 14) * 11264 + bj * 5632 + chg + 4 * n) = acc[1][bj][3][n];
          } }
        unsigned P[2][2][4][2][2];
#pragma unroll
        for (int ai = 0; ai < 2; ++ai)
#pragma unroll
            for (int bj = 0; bj < 2; ++bj)
#pragma unroll
                for (int m = 0; m < 4; ++m)
#pragma unroll
                    for (int n = 0; n < 2; ++n) { P[ai][bj][m][n][0] = pkb(acc[ai][bj][m][n][0], acc[ai][bj][m][n][1]); P[ai][bj][m][n][1] = pkb(acc[ai][bj][m][n][2], acc[ai][bj][m][n][3]); }
        if (fr >= 14) {
#pragma unroll
            for (int ai = 0; ai < 2; ++ai)
#pragma unroll
                for (int bj = 0; bj < 2; ++bj)
#pragma unroll
                    for (int n = 0; n < 2; ++n) { PG8_LAS unsigned* d = hb + ((((ai * 2 + wr) * 2 + (fr - 14)) * 2 + bj) * 64) + (ci >> 1) + 2 * n; d[0] = P[ai][bj][3][n][0]; d[1] = P[ai][bj][3][n][1]; }
        }
        { const int t = (wr * 4 + wc) * 64 + lane;
#pragma unroll
          for (int k = 0; k < 2; ++k) { const int idx = t + 512 * k, tb = idx >> 8, bj = (idx >> 7) & 1, i = idx & 127;
              const float* src = (tb < 3 ? cw + tb * 11264 : cb) + bj * 5632 + u.pn * 128 + i; wl[idx] = *src; } }
        asm volatile("s_waitcnt vmcnt(0) lgkmcnt(0)" ::: "memory"); __builtin_amdgcn_s_barrier(); asm volatile("" ::: "memory");
        const int src1 = (lane & 48) | ((fr + 15) & 15), src2 = (lane & 48) | ((fr + 14) & 15);
        const int pwr = (wr == 1) ? 0 : 1;
        int rowv = u.pm * BM + wr * 64 + fr;
#pragma unroll
        for (int n = 0; n < 2; ++n) {
            unsigned outp[2][4][2];
#pragma unroll
            for (int h = 0; h < 2; ++h) {
                float w0[2][2], w1[2][2], w2[2][2], bb[2][2];
#pragma unroll
                for (int bj = 0; bj < 2; ++bj) { const PG8_LAS float* p0 = wl + bj * 128 + ci + 4 * n + 2 * h;
#pragma unroll
                    for (int q = 0; q < 2; ++q) { w0[bj][q] = p0[q]; w1[bj][q] = p0[256 + q]; w2[bj][q] = p0[512 + q]; bb[bj][q] = p0[768 + q]; } }
#pragma unroll
                for (int ai = 0; ai < 2; ++ai) {
                    const int pai = (wr == 1) ? ai : 0;
                    float cv[2][4][2];
#pragma unroll
                    for (int bj = 0; bj < 2; ++bj) {
                        const PG8_LAS unsigned* hp = hb + ((((pai * 2 + pwr) * 2) * 2 + bj) * 64) + (ci >> 1) + 2 * n + h; const unsigned h1 = hp[128]; const unsigned hh = fr == 0 ? hp[0] : h1;
                        unsigned x[4], r1[4], r2[4];
#pragma unroll
                        for (int m = 0; m < 4; ++m) { x[m] = P[ai][bj][m][n][h]; r1[m] = (unsigned)__builtin_amdgcn_update_dpp(0, (int)x[m], 0x121, 0xf, 0xf, false); r2[m] = (unsigned)__builtin_amdgcn_update_dpp(0, (int)x[m], 0x122, 0xf, 0xf, false); }
#pragma unroll
                        for (int m = 0; m < 4; ++m) {
                            const unsigned p1 = fr >= 1 ? r1[m] : (m >= 1 ? r1[m >= 1 ? m - 1 : 0] : h1);
                            const unsigned p2 = fr >= 2 ? r2[m] : (m >= 1 ? r2[m >= 1 ? m - 1 : 0] : hh);
                            const f32x2 xv = {__uint_as_float(x[m] << 16), __uint_as_float(x[m] & 0xffff0000u)}, p1v = {__uint_as_float(p1 << 16), __uint_as_float(p1 & 0xffff0000u)}, p2v = {__uint_as_float(p2 << 16), __uint_as_float(p2 & 0xffff0000u)};
                            const f32x2 w2v = {w2[bj][0], w2[bj][1]}, w1v = {w1[bj][0], w1[bj][1]}, w0v = {w0[bj][0], w0[bj][1]}, bv2 = {bb[bj][0], bb[bj][1]};
                            const f32x2 c2 = w2v * xv + (w1v * p1v + (w0v * p2v + bv2));
                            cv[bj][m][0] = c2.x; cv[bj][m][1] = c2.y;
                        }
                    }
#pragma unroll
                    for (int m = 0; m < 4; ++m) { const float g0 = cv[0][m][0], g1 = cv[0][m][1];
                        outp[ai][m][h] = pkb(g0 * __builtin_amdgcn_rcpf(1.f + __expf(-g0)) * cv[1][m][0], g1 * __builtin_amdgcn_rcpf(1.f + __expf(-g1)) * cv[1][m][1]); }
                }
            }
            { bf16_t* gp = Gout + (size_t)rowv * 5632 + chg + 4 * n;
#pragma unroll
              for (int ai = 0; ai < 2; ++ai)
#pragma unroll
                for (int m = 0; m < 4; ++m) {
                    if (!(ai == 0 && wr == 0 && m == 0 && fr < 2)) {
                        u32x2v w; w.x = outp[ai][m][0]; w.y = outp[ai][m][1];
                        *(u32x2v*)(gp + (size_t)(ai * HALF + m * 16) * 5632) = w;
                    }
                } }
        }
    }
};
struct EpiResid {
    static constexpr bool PERM = false, AFTER_DRAIN = false;
    const float* base; float* out; const float* gate;
    __device__ __forceinline__ void operator()(const f32x4 (&acc)[2][2][4][2], const Unit& u, int wr, int wc, int fr, int fq) const {
        const int b = (u.pm * BM) >> 12; const int col0 = u.pn * BM + wc * 32 + 4 * fq; const float* gp = gate + (size_t)b * 12288 + col0;
#pragma unroll
        for (int bj = 0; bj < 2; ++bj)
#pragma unroll
            for (int n = 0; n < 2; ++n) { const f32x4 gv = *(const f32x4*)(gp + bj * HALF + n * 16);
                const size_t off0 = (size_t)(u.pm * BM + wr * 64 + fr) * 2048 + col0 + bj * HALF + n * 16;
                f32x4 bs[2][4];
#pragma unroll
                for (int ai = 0; ai < 2; ++ai)
#pragma unroll
                    for (int m = 0; m < 4; ++m) bs[ai][m] = *(const f32x4*)(base + off0 + (size_t)(ai * HALF + m * 16) * 2048);
#pragma unroll
                for (int ai = 0; ai < 2; ++ai)
#pragma unroll
                    for (int m = 0; m < 4; ++m) *(f32x4*)(out + off0 + (size_t)(ai * HALF + m * 16) * 2048) = bs[ai][m] + gv * acc[ai][bj][m][n]; }
    }
};
template <class Epi, class Sched, bool ALIGN_EPI = false, bool SP2 = false>
__device__ __forceinline__ void gemm_phase(PG8_LAS unsigned char* lds, const Gemm g, const Sched& S, const Epi& E) {
    int tid_o = threadIdx.x; asm volatile("" : "+v"(tid_o)); const int tid = tid_o, wid = __builtin_amdgcn_readfirstlane(tid >> 6), lane = tid & 63, wr = wid >> 2, wc = wid & 3, fr = lane & 15, fq = lane >> 4;
    const int K = g.K, nt = K / BK;
    unsigned voffA[2], voffB[2];
#pragma unroll
    for (int i = 0; i < 2; ++i) { int R, C; stage_rc(tid * 16 + i * 8192, R, C); const int Rb = Epi::PERM ? ((R & ~31) + perm32(R & 31)) : R;
        voffA[i] = (unsigned)(R * K + C) * 2u; voffB[i] = (unsigned)(Rb * K + C) * 2u; }
    const size_t kstep = (size_t)(BK * 2);
    const size_t hstep = (size_t)HALF * K * 2;
    const size_t tstep = 2 * hstep;
    const unsigned ldsw = (unsigned)wid * 1024u;
    const int aoff = lds_byte(wr * 64 + fr, fq * 8), boff = lds_byte(wc * 32 + fr, fq * 8);
#define PG8_SA(b, h) (((b) * 2 + (h)) * HTB)
#define PG8_SB(b, h) ((4 + (b) * 2 + (h)) * HTB)
#define PG8_STAGE(bufoff, gbase, voff) do { _Pragma("unroll") for (int _i = 0; _i < 2; ++_i) \
        __builtin_amdgcn_global_load_lds((const unsigned*)((const char*)(gbase) + (voff)[_i]), (PG8_LAS unsigned*)(lds + (bufoff) + ldsw + _i * 8192), 16, 0, 0); } while (0)
#define PG8_LDA(dst, b, h) do { _Pragma("unroll") for (int m = 0; m < 4; ++m) _Pragma("unroll") for (int k = 0; k < 2; ++k) dst[m][k] = *(const PG8_LAS bf16x8*)(lds + PG8_SA(b, h) + aoff + m * 2048 + k * 1024); } while (0)
#define PG8_LDB(dst, b, h) do { _Pragma("unroll") for (int n = 0; n < 2; ++n) _Pragma("unroll") for (int k = 0; k < 2; ++k) dst[n][k] = *(const PG8_LAS bf16x8*)(lds + PG8_SB(b, h) + boff + n * 2048 + k * 1024); } while (0)
#define PG8_MMA(ai, bj, At, Bt) do { __builtin_amdgcn_s_setprio(1); _Pragma("unroll") for (int m = 0; m < 4; ++m) _Pragma("unroll") for (int n = 0; n < 2; ++n) _Pragma("unroll") for (int k = 0; k < 2; ++k) \
        acc[ai][bj][m][n] = __builtin_amdgcn_mfma_f32_16x16x32_bf16(Bt[n][k], At[m][k], acc[ai][bj][m][n], 0, 0, 0); __builtin_amdgcn_s_setprio(0); } while (0)
#define PG8_WAIT_V(n) asm volatile("s_waitcnt vmcnt(" #n ")" ::: "memory")
#define PG8_WAIT_L(n) asm volatile("s_waitcnt lgkmcnt(" #n ")" ::: "memory")
#define PG8_BAR __builtin_amdgcn_s_barrier()
#define PG8_SCHED __builtin_amdgcn_sched_barrier(0)
    Unit cur, nxt; int ui = 0;
    if (!S.next(0, cur)) return;
    f32x4 acc[2][2][4][2];
#pragma unroll
    for (int a = 0; a < 2; ++a)
#pragma unroll
        for (int b = 0; b < 2; ++b)
#pragma unroll
            for (int m = 0; m < 4; ++m)
#pragma unroll
                for (int n = 0; n < 2; ++n) acc[a][b][m][n] = (f32x4){0.f, 0.f, 0.f, 0.f};
    bf16x8 At[4][2], B0[2][2], B1[2][2];
    const char* cA = (const char*)g.A + (size_t)cur.pm * tstep; const char* cB = (const char*)g.Bt + (size_t)cur.pn * tstep;
    S.a_ready(cur);
    if constexpr (SP2) {
        PG8_STAGE(PG8_SB(0, 0), cB, voffB); PG8_STAGE(PG8_SB(0, 1), cB + hstep, voffB); PG8_STAGE(PG8_SA(0, 0), cA, voffA); PG8_STAGE(PG8_SA(0, 1), cA + hstep, voffA);
        if (wr == 1) PG8_BAR;
        PG8_WAIT_V(2); PG8_BAR;
        PG8_STAGE(PG8_SB(1, 0), cB + kstep, voffB); PG8_STAGE(PG8_SA(1, 0), cA + kstep, voffA); PG8_STAGE(PG8_SB(1, 1), cB + hstep + kstep, voffB);
        PG8_WAIT_V(6); PG8_BAR;
    } else {
        PG8_STAGE(PG8_SB(0, 0), cB, voffB); PG8_STAGE(PG8_SA(0, 0), cA, voffA); PG8_STAGE(PG8_SB(0, 1), cB + hstep, voffB); PG8_STAGE(PG8_SA(0, 1), cA + hstep, voffA);
        if (wr == 1) PG8_BAR;
        PG8_WAIT_V(4); PG8_BAR;
        PG8_STAGE(PG8_SB(1, 0), cB + kstep, voffB); PG8_STAGE(PG8_SA(1, 0), cA + kstep, voffA); PG8_STAGE(PG8_SB(1, 1), cB + hstep + kstep, voffB);
        PG8_WAIT_V(6); PG8_BAR;
    }
    for (;;) {
        const bool has_next = S.next(ui + 1, nxt);
        const char* nA = has_next ? (const char*)g.A + (size_t)nxt.pm * tstep : cA; const char* nB = has_next ? (const char*)g.Bt + (size_t)nxt.pn * tstep : cB;
        for (int t = 0; t < nt; t += 2) {
            const bool last = (t == nt - 2);
            const char* a1 = cA + (size_t)(t + 1) * kstep;
            const char* a2 = last ? nA : cA + (size_t)(t + 2) * kstep; const char* b2 = last ? nB : cB + (size_t)(t + 2) * kstep;
            const char* a3 = a2 + kstep; const char* b3 = b2 + kstep;
            if (last && has_next) S.a_ready(nxt);
            if constexpr (SP2) {
            PG8_LDB(B0, 0, 0); PG8_LDB(B1, 0, 1); PG8_SCHED; PG8_LDA(At, 0, 0); PG8_STAGE(PG8_SA(1, 1), a1 + hstep, voffA);
            PG8_WAIT_V(8); PG8_WAIT_L(0); PG8_BAR; PG8_MMA(0, 0, At, B0); PG8_MMA(0, 1, At, B1); PG8_BAR; PG8_SCHED;
            PG8_LDA(At, 0, 1); PG8_STAGE(PG8_SB(0, 0), b2, voffB); PG8_STAGE(PG8_SB(0, 1), b2 + hstep, voffB); PG8_STAGE(PG8_SA(0, 0), a2, voffA);
            PG8_WAIT_V(8); PG8_WAIT_L(0); PG8_BAR; PG8_MMA(1, 0, At, B0); PG8_MMA(1, 1, At, B1); PG8_BAR; PG8_SCHED;
            PG8_LDB(B0, 1, 0); PG8_LDB(B1, 1, 1); PG8_SCHED; PG8_LDA(At, 1, 0); PG8_STAGE(PG8_SA(0, 1), a2 + hstep, voffA);
            PG8_WAIT_V(8); PG8_WAIT_L(0); PG8_BAR; PG8_MMA(0, 0, At, B0); PG8_MMA(0, 1, At, B1); PG8_BAR; PG8_SCHED;
            PG8_LDA(At, 1, 1); PG8_STAGE(PG8_SB(1, 0), b3, voffB); PG8_STAGE(PG8_SB(1, 1), b3 + hstep, voffB); PG8_STAGE(PG8_SA(1, 0), a3, voffA);
            PG8_WAIT_V(8); PG8_WAIT_L(0); PG8_BAR; PG8_MMA(1, 0, At, B0); PG8_MMA(1, 1, At, B1); PG8_BAR; PG8_SCHED;
            } else {
            PG8_LDB(B0, 0, 0); PG8_SCHED; PG8_LDA(At, 0, 0); PG8_STAGE(PG8_SA(1, 1), a1 + hstep, voffA);
            PG8_WAIT_L(8); PG8_BAR; PG8_WAIT_L(0); PG8_MMA(0, 0, At, B0); PG8_BAR; PG8_SCHED;
            PG8_LDB(B1, 0, 1); PG8_STAGE(PG8_SB(0, 0), b2, voffB);
            PG8_BAR; PG8_WAIT_L(0); PG8_MMA(0, 1, At, B1); PG8_BAR;
            PG8_LDA(At, 0, 1); PG8_STAGE(PG8_SA(0, 0), a2, voffA);
            PG8_BAR; PG8_WAIT_L(0); PG8_MMA(1, 0, At, B0); PG8_BAR; PG8_SCHED;
            PG8_STAGE(PG8_SB(0, 1), b2 + hstep, voffB);
            PG8_WAIT_V(6); PG8_BAR; PG8_MMA(1, 1, At, B1); PG8_BAR;
            PG8_LDB(B0, 1, 0); PG8_SCHED; PG8_LDA(At, 1, 0); PG8_STAGE(PG8_SA(0, 1), a2 + hstep, voffA);
            PG8_WAIT_L(8); PG8_BAR; PG8_WAIT_L(0); PG8_MMA(0, 0, At, B0); PG8_BAR; PG8_SCHED;
            PG8_LDB(B1, 1, 1); PG8_STAGE(PG8_SB(1, 0), b3, voffB);
            PG8_BAR; PG8_WAIT_L(0); PG8_MMA(0, 1, At, B1); PG8_BAR;
            PG8_LDA(At, 1, 1); PG8_STAGE(PG8_SA(1, 0), a3, voffA);
            PG8_BAR; PG8_WAIT_L(0); PG8_MMA(1, 0, At, B0); PG8_BAR; PG8_SCHED;
            PG8_STAGE(PG8_SB(1, 1), b3 + hstep, voffB);
            PG8_WAIT_V(6); PG8_BAR; PG8_MMA(1, 1, At, B1); PG8_BAR;
            }
        }
        if constexpr (ALIGN_EPI) { if (wr == 0) PG8_BAR; }
        if constexpr (!Epi::AFTER_DRAIN) { E(acc, cur, wr, wc, fr, fq); S.done(cur); }
        if (!has_next) break;
#pragma unroll
        for (int a = 0; a < 2; ++a)
#pragma unroll
            for (int b = 0; b < 2; ++b)
#pragma unroll
                for (int m = 0; m < 4; ++m)
#pragma unroll
                    for (int n = 0; n < 2; ++n) acc[a][b][m][n] = (f32x4){0.f, 0.f, 0.f, 0.f};
        cur = nxt; cA = nA; cB = nB; ++ui;
        if constexpr (ALIGN_EPI) { if (wr == 1) PG8_BAR; }
    }
    PG8_WAIT_V(0);
    if constexpr (!ALIGN_EPI) { if (wr == 0) PG8_BAR; }
    PG8_BAR;
    if constexpr (Epi::AFTER_DRAIN) { E.fused(acc, cur, wr, wc, fr, fq, lds, wid, lane); S.done(cur); }
#undef PG8_SA
#undef PG8_SB
#undef PG8_STAGE
#undef PG8_LDA
#undef PG8_LDB
#undef PG8_MMA
#undef PG8_WAIT_V
#undef PG8_WAIT_L
#undef PG8_BAR
#undef PG8_SCHED
}
}

constexpr int NB = 4, SEQ = 4096, DM = 2048, MTOK = NB * SEQ;
constexpr int EV_PITCH = 3584, EV_IN = 3400, OD_PITCH = 6144, DFF = 5632, DFF2 = 11264;
constexpr int C_QA = 0, C_KA = 1024, C_VA = 1280, C_QB = 1536, C_CLAT = 2560, C_QI = 2816, C_KI = 3328, C_WI = 3392;
constexpr float EPS = 1e-6f;
constexpr float SB_CUT = 4.0e-18f;
constexpr size_t MiB = 1u << 20;
constexpr size_t WS_MOD = 0, WS_WUKT = 512 * 1024, WS_WUVT = 1 * MiB, WS_WIN = 2 * MiB, WS_WOUT = 26 * MiB, WS_WUP = 34 * MiB, WS_WDN = 78 * MiB,
                 WS_XN = 100 * MiB, WS_BIG = 164 * MiB, WS_QLAT = 276 * MiB, WS_G = 516 * MiB, WS_ATT = 516 * MiB, WS_CKV = 580 * MiB,
                 WS_IDX = 588 * MiB, WS_CNT = 604 * MiB, WS_END = 692 * MiB;
constexpr int LDS_BYTES = 156672;
#ifndef DIAG
#define DIAG 0
#endif
#ifndef DUP_UP
#define DUP_UP 0
#endif
#ifndef DUP_CONV
#define DUP_CONV 0
#endif
#ifndef DUP_P3
#define DUP_P3 0
#endif
#ifndef DUP_IDX
#define DUP_IDX 0
#endif
#ifndef SKIP_SWA
#define SKIP_SWA 0
#endif
#ifndef SKIP_DSA
#define SKIP_DSA 0
#endif
#ifndef SKIP_SB
#define SKIP_SB 0
#endif

typedef unsigned short bf16_t;
typedef short bf16x8 __attribute__((ext_vector_type(8)));
typedef float f32x4 __attribute__((ext_vector_type(4)));
typedef unsigned u32x4 __attribute__((ext_vector_type(4)));
typedef unsigned u32x2 __attribute__((ext_vector_type(2)));
#define LAS __attribute__((address_space(3)))
#define MFMA16(a, b, c) __builtin_amdgcn_mfma_f32_16x16x32_bf16((a), (b), (c), 0, 0, 0)

typedef float f32x2_t __attribute__((ext_vector_type(2))); typedef __bf16 bf16x2_t __attribute__((ext_vector_type(2)));
__device__ __forceinline__ unsigned pk2(float lo, float hi) { f32x2_t v = {lo, hi}; bf16x2_t b = __builtin_convertvector(v, bf16x2_t); return __builtin_bit_cast(unsigned, b); }
__device__ __forceinline__ float bflo(unsigned w) { return __uint_as_float(w << 16); }
__device__ __forceinline__ float bfhi(unsigned w) { return __uint_as_float(w & 0xffff0000u); }
__device__ __forceinline__ float wave_sum(float v) {
#pragma unroll
    for (int o = 1; o < 64; o <<= 1) v += __shfl_xor(v, o);
    return v;
}
__device__ __forceinline__ int wave_sum_i(int v) {
#pragma unroll
    for (int o = 1; o < 64; o <<= 1) v += __shfl_xor(v, o);
    return v;
}
__device__ __forceinline__ int t5_bucket(int rel) {
    const int n = rel < 0 ? -rel : rel; int v = n;
    if (n >= 8) v = 8 + (n >= 12) + (n >= 16) + (n >= 23) + (n >= 32) + (n >= 46) + (n >= 64) + (n >= 91);
    return (rel > 0 ? 16 : 0) + v;
}
typedef short s16x4_t __attribute__((ext_vector_type(4)));
__device__ __forceinline__ s16x4_t lds_tr4(const LAS bf16_t* p) { return __builtin_bit_cast(s16x4_t, __builtin_amdgcn_ds_read_tr16_b64_v4i16((LAS s16x4_t*)p)); }
__device__ __forceinline__ bf16x8 mk8(unsigned a, unsigned b, unsigned c, unsigned d) { u32x4 w; w.x = a; w.y = b; w.z = c; w.w = d; return __builtin_bit_cast(bf16x8, w); }

struct Args { const float* in[20]; float* out; unsigned char* ws; };

template <int ROWMAP> __device__ __forceinline__ void transpose_item(const float* W, int K, int N, bf16_t* WT, LAS float* scr, int item, int nblk, int lane) {
    const int kb = item / nblk, nb = item % nblk, k0 = 64 * kb, n0 = 64 * nb; const int nc = n0 + lane;
    float v[64];
#pragma unroll
    for (int i = 0; i < 64; ++i) v[i] = (nc < N) ? W[(size_t)(k0 + i) * N + nc] : 0.f;
#pragma unroll
    for (int i = 0; i < 64; ++i) scr[i * 65 + lane] = v[i];
    asm volatile("s_waitcnt lgkmcnt(0)" ::: "memory");
    const int c = lane & 7;
#pragma unroll
    for (int j = 0; j < 8; ++j) { const int n = (lane >> 3) + 8 * j; const LAS float* s = scr + (8 * c) * 65 + n;
        u32x4 o; o.x = pk2(s[0 * 65], s[1 * 65]); o.y = pk2(s[2 * 65], s[3 * 65]); o.z = pk2(s[4 * 65], s[5 * 65]); o.w = pk2(s[6 * 65], s[7 * 65]);
        int d = n0 + n; if (ROWMAP) { const int sc_ = d < DFF ? d : d - DFF; d = (sc_ >> 7) * 256 + (d < DFF ? 0 : 128) + (sc_ & 127); }
        *(u32x4*)(WT + (size_t)d * K + k0 + 8 * c) = o; }
    asm volatile("s_waitcnt lgkmcnt(0)" ::: "memory");
}
template <int ROWMAP = 0> __device__ __forceinline__ void convert_matrix(const float* W, int K, int N, int Npad, bf16_t* WT, LAS float* scr, int gw, int NGW, int lane) {
    const int nblk = Npad / 64, nitems = (K / 64) * nblk;
    for (int it = gw; it < nitems; it += NGW) transpose_item<ROWMAP>(W, K, N, WT, scr, it, nblk, lane);
}

__device__ __forceinline__ void norm_mod_phase(const float* xin, const float* g, const float* modl, int sh_off, int sc_off, bf16_t* XN, int gw, int NGW, int lane) {
    for (int row = gw; row < MTOK; row += 2 * NGW) {
        const int row2 = row + NGW;
        const f32x4* xr = (const f32x4*)(xin + (size_t)row * DM) + lane; const f32x4* xr2 = (const f32x4*)(xin + (size_t)row2 * DM) + lane;
        f32x4 v[8], v2[8]; float ss = 0.f, ss2 = 0.f;
#pragma unroll
        for (int j = 0; j < 8; ++j) { v[j] = xr[64 * j]; v2[j] = xr2[64 * j]; }
#pragma unroll
        for (int j = 0; j < 8; ++j) { ss += (v[j].x * v[j].x + v[j].y * v[j].y) + (v[j].z * v[j].z + v[j].w * v[j].w); ss2 += (v2[j].x * v2[j].x + v2[j].y * v2[j].y) + (v2[j].z * v2[j].z + v2[j].w * v2[j].w); }
        ss = wave_sum(ss); ss2 = wave_sum(ss2);
        const float r = rsqrtf(ss * (1.f / DM) + EPS), r2 = rsqrtf(ss2 * (1.f / DM) + EPS);
        const float* mb = modl + (size_t)(row >> 12) * 12288; const float* mb2 = modl + (size_t)(row2 >> 12) * 12288;
#pragma unroll
        for (int j = 0; j < 8; ++j) { const int col = 4 * (64 * j + lane);
            const f32x4 g4 = *(const f32x4*)(g + col);
            { const f32x4 sc = *(const f32x4*)(mb + sc_off + col), sh = *(const f32x4*)(mb + sh_off + col);
              const f32x4 y = v[j] * r * g4; const f32x4 h = y * (sc + 1.f) + sh;
              u32x2 w; w.x = pk2(h.x, h.y); w.y = pk2(h.z, h.w); *(u32x2*)(XN + (size_t)row * DM + col) = w; }
            { const f32x4 sc = *(const f32x4*)(mb2 + sc_off + col), sh = *(const f32x4*)(mb2 + sh_off + col);
              const f32x4 y = v2[j] * r2 * g4; const f32x4 h = y * (sc + 1.f) + sh;
              u32x2 w; w.x = pk2(h.x, h.y); w.y = pk2(h.z, h.w); *(u32x2*)(XN + (size_t)row2 * DM + col) = w; } }
    }
}

__device__ __forceinline__ void conv_gate_phase(const bf16_t* U, const float* cw, const float* cb, bf16_t* Gout, int G, int tid) {
    for (int item = blockIdx.x * 512 + tid; item < 1024 * 704; item += G * 512) {
        const int cg8 = item % 704, run = item / 704; const int row0 = run * 16, c0 = cg8 * 8; const bool first = (row0 & 4095) == 0;
        float wg[3][8], wv[3][8], bg[8], bv[8];
#pragma unroll
        for (int j = 0; j < 3; ++j) {
            const f32x4 a0 = *(const f32x4*)(cw + j * DFF2 + c0), a1 = *(const f32x4*)(cw + j * DFF2 + c0 + 4);
            const f32x4 b0 = *(const f32x4*)(cw + j * DFF2 + DFF + c0), b1 = *(const f32x4*)(cw + j * DFF2 + DFF + c0 + 4);
#pragma unroll
            for (int e = 0; e < 4; ++e) { wg[j][e] = a0[e]; wg[j][4 + e] = a1[e]; wv[j][e] = b0[e]; wv[j][4 + e] = b1[e]; }
        }
        { const f32x4 a0 = *(const f32x4*)(cb + c0), a1 = *(const f32x4*)(cb + c0 + 4), b0 = *(const f32x4*)(cb + DFF + c0), b1 = *(const f32x4*)(cb + DFF + c0 + 4);
#pragma unroll
          for (int e = 0; e < 4; ++e) { bg[e] = a0[e]; bg[4 + e] = a1[e]; bv[e] = b0[e]; bv[4 + e] = b1[e]; } }
        float g2[8], g1[8], v2[8], v1[8];
#pragma unroll
        for (int e = 0; e < 8; ++e) { g2[e] = 0.f; g1[e] = 0.f; v2[e] = 0.f; v1[e] = 0.f; }
        if (!first) {
            const u32x4 a = *(const u32x4*)(U + (size_t)(row0 - 2) * DFF2 + c0), b = *(const u32x4*)(U + (size_t)(row0 - 2) * DFF2 + DFF + c0);
            const u32x4 c = *(const u32x4*)(U + (size_t)(row0 - 1) * DFF2 + c0), d = *(const u32x4*)(U + (size_t)(row0 - 1) * DFF2 + DFF + c0);
#pragma unroll
            for (int e = 0; e < 4; ++e) { g2[2 * e] = bflo(a[e]); g2[2 * e + 1] = bfhi(a[e]); v2[2 * e] = bflo(b[e]); v2[2 * e + 1] = bfhi(b[e]);
                                          g1[2 * e] = bflo(c[e]); g1[2 * e + 1] = bfhi(c[e]); v1[2 * e] = bflo(d[e]); v1[2 * e + 1] = bfhi(d[e]); }
        }
#pragma unroll 8
        for (int t = 0; t < 16; ++t) {
            const u32x4 a = *(const u32x4*)(U + (size_t)(row0 + t) * DFF2 + c0), b = *(const u32x4*)(U + (size_t)(row0 + t) * DFF2 + DFF + c0);
            float gc[8], vc[8], r[8];
#pragma unroll
            for (int e = 0; e < 4; ++e) { gc[2 * e] = bflo(a[e]); gc[2 * e + 1] = bfhi(a[e]); vc[2 * e] = bflo(b[e]); vc[2 * e + 1] = bfhi(b[e]); }
#pragma unroll
            for (int e = 0; e < 8; ++e) {
                const float gg = wg[0][e] * g2[e] + wg[1][e] * g1[e] + wg[2][e] * gc[e] + bg[e];
                const float vv = wv[0][e] * v2[e] + wv[1][e] * v1[e] + wv[2][e] * vc[e] + bv[e];
                r[e] = gg / (1.f + __expf(-gg)) * vv;
                g2[e] = g1[e]; g1[e] = gc[e]; v2[e] = v1[e]; v1[e] = vc[e];
            }
            u32x4 o; o.x = pk2(r[0], r[1]); o.y = pk2(r[2], r[3]); o.z = pk2(r[4], r[5]); o.w = pk2(r[6], r[7]);
            *(u32x4*)(Gout + (size_t)(row0 + t) * DFF + c0) = o;
        }
    }
}

#define XB_TMO      128
#define XB_XCNT(j)  (256  + 64 * (j))
#define XB_XSUB(j)  (1280 + 64 * (j))
#define XB_XGEN(j)  (2304 + 64 * (j))
#define XB_TOP      3328
#define XB_TOPGEN   3392
#define XCD_BAR_WORDS 3456
#define XB_SPIN_CAP (1u << 18)

__device__ __forceinline__ unsigned xb_ld(unsigned* p)              { return __hip_atomic_load(p, __ATOMIC_RELAXED, __HIP_MEMORY_SCOPE_AGENT); }
__device__ __forceinline__ unsigned xb_add(unsigned* p, unsigned v) { return __hip_atomic_fetch_add(p, v, __ATOMIC_RELAXED, __HIP_MEMORY_SCOPE_AGENT); }
__device__ __forceinline__ unsigned xb_xcc_id() { return (unsigned)__builtin_amdgcn_s_getreg((3 << 11) | 20) & 0xFu; }
#define XB_SPIN(cond, bar) do { unsigned _sp = 0; while (cond) { __builtin_amdgcn_s_sleep(1); \
    if ((++_sp & 255u) == 0u) { if (xb_ld(&(bar)[XB_TMO])) break; if (_sp > XB_SPIN_CAP) { atomicAdd(&(bar)[XB_TMO], 1u); break; } } } } while (0)

struct XcdBarrier {
    unsigned* bar; unsigned x;
    volatile LAS unsigned* st;
};

__device__ __forceinline__ XcdBarrier xcd_barrier_post(unsigned* bar, volatile LAS unsigned* st) {
    XcdBarrier b; b.bar = bar; b.x = (unsigned)__builtin_amdgcn_readfirstlane((int)xb_xcc_id()); b.st = st;
    if (threadIdx.x == 0) (void)xb_add(&bar[XB_XCNT(b.x)], 1u);
    return b;
}
__device__ __forceinline__ void xcd_barrier_complete(unsigned* bar, unsigned x, unsigned& nloc, unsigned& nx) {
    const unsigned G = gridDim.x * gridDim.y * gridDim.z;
    unsigned sum, cnt, mine, sp = 0u;
    for (;;) {
        sum = 0u; cnt = 0u; mine = 0u;
#pragma unroll
        for (unsigned j = 0; j < 16; ++j) { const unsigned c = xb_ld(&bar[XB_XCNT(j)]); sum += c; cnt += (c > 0u) ? 1u : 0u; mine = (j == x) ? c : mine; }
        if (sum == G) break;
        __builtin_amdgcn_s_sleep(1);
        if ((++sp & 255u) == 0u) { if (xb_ld(&bar[XB_TMO])) break; if (sp > XB_SPIN_CAP) { atomicAdd(&bar[XB_TMO], 1u); break; } }
    }
    nloc = mine > 0u ? mine : 1u; nx = cnt > 0u ? cnt : 1u;
}

__device__ __forceinline__ void xcd_barrier(const XcdBarrier& b) {
    asm volatile("s_waitcnt vmcnt(0)" ::: "memory");
    __syncthreads();
    if (threadIdx.x == 0) {
        unsigned* bar = b.bar;
        __builtin_amdgcn_s_waitcnt(0);
        unsigned nloc = b.st[0], nx = b.st[1];
        if (nloc == 0u) { xcd_barrier_complete(bar, b.x, nloc, nx); b.st[0] = nloc; b.st[1] = nx; }
        const unsigned old = xb_add(&bar[XB_XSUB(b.x)], 1u);
        const unsigned gen = old / nloc;
        if (old + 1u == (gen + 1u) * nloc) {
            __builtin_amdgcn_fence(__ATOMIC_RELEASE, "agent");
            asm volatile("s_waitcnt vmcnt(0)" ::: "memory");
            const unsigned og = xb_add(&bar[XB_TOP], 1u);
            const unsigned tg = og / nx;
            if (og + 1u == (tg + 1u) * nx) xb_add(&bar[XB_TOPGEN], 1u);
            else XB_SPIN(xb_ld(&bar[XB_TOPGEN]) == tg, bar);
            __builtin_amdgcn_fence(__ATOMIC_ACQUIRE, "agent");
            xb_add(&bar[XB_XGEN(b.x)], 1u);
            asm volatile("s_waitcnt vmcnt(0)" ::: "memory");
        } else {
            XB_SPIN(xb_ld(&bar[XB_XGEN(b.x)]) == gen, bar);
            __builtin_amdgcn_fence(__ATOMIC_ACQUIRE, "agent");
            asm volatile("s_waitcnt vmcnt(0)" ::: "memory");
        }
    }
    __syncthreads();
}

__global__ void __launch_bounds__(512, 2) mega_fwd(Args a) {
    extern __shared__ __attribute__((aligned(16))) unsigned char lds[];
    cg::grid_group grid = cg::this_grid();
    LAS unsigned char* L = (LAS unsigned char*)lds;
    const int G = gridDim.x, NGW = G * 8;
    { LAS unsigned* mz = (LAS unsigned*)(L + 155648); if (threadIdx.x < 16) mz[threadIdx.x] = 0u; }
    if (blockIdx.x == 0 && threadIdx.x < 64) { unsigned* bw = (unsigned*)(a.ws + 458752);
        for (int i = threadIdx.x; i < 4096; i += 64) __hip_atomic_store(bw + i, 0u, __ATOMIC_RELAXED, __HIP_MEMORY_SCOPE_AGENT);
        __builtin_amdgcn_fence(__ATOMIC_RELEASE, "agent"); asm volatile("s_waitcnt vmcnt(0)" ::: "memory"); }
    __syncthreads();
    grid.sync();
    const XcdBarrier xbar = xcd_barrier_post((unsigned*)(a.ws + 458752), (volatile LAS unsigned*)(L + 155648));
#if DIAG
    unsigned long long* TS = (unsigned long long*)(a.ws + 460800); int ts_n = 0;
#define TSTAMP() do { if (blockIdx.x == 0 && threadIdx.x == 0) TS[ts_n] = __builtin_amdgcn_s_memrealtime(); ++ts_n; } while (0)
#else
#define TSTAMP() do { } while (0)
#endif
#define GSYNC() do { XcdBarrier xb2_; xb2_.bar = (unsigned*)(a.ws + 458752); { unsigned xx_ = xbar.x; asm volatile("" : "+s"(xx_)); xb2_.x = xx_; } xb2_.st = (volatile LAS unsigned*)(L + 155648); xcd_barrier(xb2_); TSTAMP(); } while (0)
#define IDS int tid = threadIdx.x; asm volatile("" : "+v"(tid)); const int lane = tid & 63, wave = __builtin_amdgcn_readfirstlane(tid >> 6), fr = lane & 15, fq = lane >> 4; const int gw = blockIdx.x * 8 + wave; (void)fr; (void)fq; (void)gw; (void)lane; \
            LAS float* scr = (LAS float*)(L + wave * 16640); (void)scr;
    unsigned char* ws = a.ws;
    float* MOD = (float*)(ws + WS_MOD);
    bf16_t* WUKT = (bf16_t*)(ws + WS_WUKT); bf16_t* WUVT = (bf16_t*)(ws + WS_WUVT);
    bf16_t* WIN = (bf16_t*)(ws + WS_WIN); bf16_t* WOUT = (bf16_t*)(ws + WS_WOUT); bf16_t* WUP = (bf16_t*)(ws + WS_WUP); bf16_t* WDN = (bf16_t*)(ws + WS_WDN);
    bf16_t* XN = (bf16_t*)(ws + WS_XN); bf16_t* PROJ = (bf16_t*)(ws + WS_BIG); bf16_t* UB = (bf16_t*)(ws + WS_BIG); bf16_t* QLAT = (bf16_t*)(ws + WS_QLAT);
    bf16_t* GB = (bf16_t*)(ws + WS_G); bf16_t* ATT = (bf16_t*)(ws + WS_ATT); bf16_t* CKV = (bf16_t*)(ws + WS_CKV);
    int* IDX = (int*)(ws + WS_IDX); int* CNT = (int*)(ws + WS_CNT); float* HBUF = (float*)(ws + WS_BIG); bf16_t* KIC = (bf16_t*)(ws + WS_CNT + MiB);
    const float* x_in = a.in[0]; const float* rel_bias = a.in[2];
    float* xres = a.out;

    TSTAMP();
    {
        IDS
        LAS float* cs = (LAS float*)L; LAS float* red = cs + 8192;
        for (int it = blockIdx.x; it < 256; it += G) {
            const int i = it >> 7, jc = it & 127;
            for (int idx = tid; idx < 8192; idx += 512) { const float v = a.in[1][idx]; cs[idx] = v / (1.f + expf(-v)); }
            __syncthreads();
            if (tid < 384) {
                const int cq = tid % 24, kg = tid / 24;
                const float* w = a.in[3] + (size_t)i * 2048 * 12288 + jc * 96 + cq * 4;
                f32x4 ac[4];
#pragma unroll
                for (int b = 0; b < 4; ++b) ac[b] = (f32x4){0.f, 0.f, 0.f, 0.f};
#pragma unroll 8
                for (int kk = 0; kk < 128; ++kk) { const int k = kg * 128 + kk; const f32x4 wv = *(const f32x4*)(w + (size_t)k * 12288);
#pragma unroll
                    for (int b = 0; b < 4; ++b) ac[b] += wv * cs[b * 2048 + k]; }
#pragma unroll
                for (int b = 0; b < 4; ++b) *(LAS f32x4*)(red + (kg * 4 + b) * 96 + cq * 4) = ac[b];
            }
            __syncthreads();
            if (tid < 384) { const int b = tid / 96, col = tid % 96; float s = a.in[4][i * 12288 + jc * 96 + col];
#pragma unroll
              for (int k2 = 0; k2 < 16; ++k2) s += red[(k2 * 4 + b) * 96 + col];
              MOD[(size_t)(i * 4 + b) * 12288 + jc * 96 + col] = s; }
            __syncthreads();
        }
        convert_matrix(a.in[7], 2048, EV_IN, EV_PITCH, WIN, scr, gw, NGW, lane);
        convert_matrix(a.in[12], 2048, 2048, 2048, WOUT, scr, gw, NGW, lane);
        convert_matrix<1>(a.in[15], 2048, DFF2, DFF2, WUP, scr, gw, NGW, lane);
        convert_matrix(a.in[18], DFF, 2048, 2048, WDN, scr, gw, NGW, lane);
        for (int h = 0; h < 16; ++h) {
            convert_matrix(a.in[9] + (size_t)h * 64 * 256, 64, 256, 256, WUKT + (size_t)h * 256 * 64, scr, gw, NGW, lane);
            convert_matrix(a.in[10] + (size_t)h * 256 * 64, 256, 64, 64, WUVT + (size_t)h * 64 * 256, scr, gw, NGW, lane);
        }
    }
    GSYNC();

#pragma unroll
    for (int layer = 0; layer < 2; ++layer) {
        const float* modl = MOD + (size_t)layer * 4 * 12288;
        const float* xcur = (layer == 0) ? x_in : (const float*)xres;
        { IDS
        norm_mod_phase(xcur, a.in[5] + layer * DM, modl, 0, 2048, XN, gw, NGW, lane);
        if (layer == 1) {
            convert_matrix(a.in[13], 2048, OD_PITCH, OD_PITCH, WIN, scr, gw, NGW, lane);
            convert_matrix(a.in[14], 2048, 2048, 2048, WOUT, scr, gw, NGW, lane);
            convert_matrix<1>(a.in[15] + (size_t)2048 * DFF2, 2048, DFF2, DFF2, WUP, scr, gw, NGW, lane);
            convert_matrix(a.in[18] + (size_t)DFF * 2048, DFF, 2048, 2048, WDN, scr, gw, NGW, lane);
        } }
        GSYNC();
#if SKIP_SWA || SKIP_DSA || SKIP_SB
        { IDS for (size_t i = (size_t)blockIdx.x * 512 + tid; i < (size_t)MTOK * DM / 8; i += (size_t)G * 512) ((u32x4*)ATT)[i] = (u32x4){0u, 0u, 0u, 0u}; }
#endif
        if (layer == 0) {
            { pg8::Gemm g{XN, WIN, MTOK, EV_PITCH, 2048}; pg8::StaticOrder S; S.init(MTOK, EV_PITCH, G, (int)blockIdx.x);
              pg8::EpiBf16 E{PROJ, EV_PITCH, KIC, C_KI / 256};
              pg8::gemm_phase<pg8::EpiBf16, pg8::StaticOrder, true, true>(L, g, S, E); }
            GSYNC();
            { IDS
            for (int row = gw; row < MTOK; row += NGW) {
                const u32x2 w = *(const u32x2*)(PROJ + (size_t)row * EV_PITCH + C_CLAT + 4 * lane);
                const float x0 = bflo(w.x), x1 = bfhi(w.x), x2 = bflo(w.y), x3 = bfhi(w.y);
                const float ss = wave_sum((x0 * x0 + x1 * x1) + (x2 * x2 + x3 * x3));
                const float r = rsqrtf(ss * (1.f / 256.f) + EPS);
                const f32x4 g4 = *(const f32x4*)(a.in[8] + 4 * lane);
                u32x2 o; o.x = pk2(x0 * r * g4.x, x1 * r * g4.y); o.y = pk2(x2 * r * g4.z, x3 * r * g4.w);
                *(u32x2*)(CKV + (size_t)row * 256 + 4 * lane) = o;
            } }
            { IDS
            for (int unit = gw; unit < 16384; unit += NGW) {
                const int h = unit & 15, t0 = (unit >> 4) * 16;
                bf16x8 bq[2];
#pragma unroll
                for (int ks = 0; ks < 2; ++ks) bq[ks] = *(const bf16x8*)(PROJ + (size_t)(t0 + fr) * EV_PITCH + C_QB + h * 64 + 32 * ks + 8 * fq);
#pragma unroll
                for (int rg = 0; rg < 2; ++rg) {
                    bf16x8 aw[8][2];
#pragma unroll
                    for (int r8 = 0; r8 < 8; ++r8)
#pragma unroll
                        for (int ks = 0; ks < 2; ++ks) aw[r8][ks] = *(const bf16x8*)(WUKT + (size_t)(h * 256 + 16 * (8 * rg + r8) + fr) * 64 + 32 * ks + 8 * fq);
#pragma unroll
                    for (int r8 = 0; r8 < 8; ++r8) { const int rt = 8 * rg + r8;
                        f32x4 acc = (f32x4){0.f, 0.f, 0.f, 0.f};
                        acc = MFMA16(aw[r8][0], bq[0], acc); acc = MFMA16(aw[r8][1], bq[1], acc);
                        u32x2 o; o.x = pk2(acc[0] * 0.125f, acc[1] * 0.125f); o.y = pk2(acc[2] * 0.125f, acc[3] * 0.125f);
                        *(u32x2*)(QLAT + ((size_t)(t0 + fr) * 16 + h) * 256 + 16 * rt + 4 * fq) = o; }
                }
            } }
#if !SKIP_DSA
            {
                IDS
                LAS float* sc = (LAS float*)L;
                __syncthreads();
                for (int uu = blockIdx.x; uu < 2048; uu += G) {
                    const int kk = uu / G, bi = uu - kk * G;
                    const int unit = (G == 256) ? ((kk >> 1) * 512 + ((kk & 1) ? 511 - bi : bi)) : uu;
                    const int row0 = unit * 8, b = row0 >> 12, c = (row0 & 4095) >> 6, nall = (c + 1) * 64;
                    const int row = row0 + wave;
                    int* idxp = IDX + (size_t)row * 256;
                    if (nall <= 256) { for (int i = lane; i < nall; i += 64) idxp[i] = i; if (lane == 0) CNT[row] = nall; continue; }
                    const int nquads = c + 1, ntiles = nall >> 4;
                    bf16x8 qa[4][2];
#pragma unroll
                    for (int hp = 0; hp < 4; ++hp)
#pragma unroll
                        for (int ks = 0; ks < 2; ++ks) qa[hp][ks] = *(const bf16x8*)(PROJ + (size_t)(row0 + (fr & 7)) * EV_PITCH + C_QI + (2 * hp + (fr >> 3)) * 64 + 32 * ks + 8 * fq);
                    float wq[4][4];
#pragma unroll
                    for (int j = 0; j < 4; ++j) { const u32x4 ww = *(const u32x4*)(PROJ + (size_t)(row0 + 4 * (fq & 1) + j) * EV_PITCH + C_WI);
#pragma unroll
                        for (int hp = 0; hp < 4; ++hp) wq[hp][j] = (fq >> 1) ? bfhi(ww[hp]) : bflo(ww[hp]); }
                    const bf16_t* kbase = KIC + ((size_t)b * SEQ + fr) * 64 + 8 * fq;
#pragma unroll 8
                    for (int t = wave; t < ntiles; t += 8) {
                        const bf16_t* kp = kbase + (size_t)(16 * t) * 64;
                        const bf16x8 b0 = *(const bf16x8*)kp, b1 = *(const bf16x8*)(kp + 32);
                        float part[4] = {0.f, 0.f, 0.f, 0.f};
#pragma unroll
                        for (int hp = 0; hp < 4; ++hp) {
                            f32x4 acc = (f32x4){0.f, 0.f, 0.f, 0.f};
                            acc = MFMA16(qa[hp][0], b0, acc); acc = MFMA16(qa[hp][1], b1, acc);
#pragma unroll
                            for (int j = 0; j < 4; ++j) part[j] += wq[hp][j] * fmaxf(acc[j], 0.f);
                        }
#pragma unroll
                        for (int j = 0; j < 4; ++j) part[j] += __shfl_xor(part[j], 32);
                        if (fq < 2) {
#pragma unroll
                            for (int j = 0; j < 4; ++j) sc[(4 * fq + j) * 4096 + 16 * t + fr] = part[j];
                        }
                    }
                    __syncthreads();
                    unsigned v[64];
#pragma unroll
                    for (int q = 0; q < 64; ++q) {
                        unsigned val = 0u;
                        if (q < nquads) { unsigned u = __float_as_uint(sc[wave * 4096 + 64 * q + lane]); if (u == 0x80000000u) u = 0u; val = (u & 0x80000000u) ? ~u : (u | 0x80000000u); }
                        v[q] = val;
                    }
                    unsigned T = 0u;
                    for (int bit = 31; bit >= 0; --bit) {
                        const unsigned cand = T | (1u << bit); int cnt = 0;
#pragma unroll
                        for (int qg = 0; qg < 4; ++qg) {
                            if (16 * qg < nquads) {
#pragma unroll
                                for (int q = 16 * qg; q < 16 * qg + 16; ++q) cnt += __popcll(__ballot(v[q] >= cand));
                            }
                        }
                        if (cnt >= 256) T = cand;
                        if (cnt == 256) break;
                    }
                    int cgt = 0;
#pragma unroll
                    for (int q = 0; q < 64; ++q) cgt += __popcll(__ballot(v[q] > T));
                    int need = 256 - cgt, pos = 0;
                    const unsigned long long ltmask = (1ull << lane) - 1ull;
#pragma unroll
                    for (int q = 0; q < 64; ++q) {
                        if (q < nquads) {
                            const bool gt = v[q] > T, eq = v[q] == T;
                            const unsigned long long meq = __ballot(eq);
                            const int eqrank = __popcll(meq & ltmask);
                            const bool sel = gt || (eq && eqrank < need);
                            const unsigned long long msel = __ballot(sel);
                            if (sel) idxp[pos + __popcll(msel & ltmask)] = q * 64 + lane;
                            pos += __popcll(msel);
                            const int neq = __popcll(meq); need -= (neq < need ? neq : need);
                        }
                    }
                    if (lane == 0) CNT[row] = 256;
                    __syncthreads();
                }
            }
#endif
#if !SKIP_SWA
            {
                IDS
                LAS bf16_t* Vt = (LAS bf16_t*)L;
                LAS float* bT = (LAS float*)(L + 64 * 200 * 2);
                LAS bf16_t* Kl = (LAS bf16_t*)(L + 64 * 200 * 2 + 4096);
                __syncthreads();
                { const int kvh0 = blockIdx.x & 3;
                  for (int idx = tid; idx < 1024; idx += 512) { const int g = idx >> 8, ri = idx & 255; bT[idx] = rel_bias[t5_bucket(ri - 191) * 32 + kvh0 * 4 + g]; } }
                for (int unit = blockIdx.x; unit < 1024; unit += G) {
                    const int b = unit >> 8, c = (unit >> 2) & 63, kvh = unit & 3;
                    const int kstart = (c >= 2 ? c - 2 : 0) * 64, nk = (c + 1) * 64 - kstart;
                    const size_t rowbase = (size_t)b * SEQ;
                    bf16x8 bq0[2], bq1[2];
                    { const int g_ = wave >> 1, qh_ = wave & 1, head_ = kvh * 4 + g_, q0_ = c * 64 + qh_ * 32;
#pragma unroll
                      for (int ks = 0; ks < 2; ++ks) { bq0[ks] = *(const bf16x8*)(PROJ + (rowbase + q0_ + fr) * EV_PITCH + C_QA + head_ * 64 + 32 * ks + 8 * fq);
                                                       bq1[ks] = *(const bf16x8*)(PROJ + (rowbase + q0_ + 16 + fr) * EV_PITCH + C_QA + head_ * 64 + 32 * ks + 8 * fq); } }
                    { u32x4 kx[3], vx[3];
#pragma unroll
                      for (int it = 0; it < 3; ++it) { const int i = tid + 512 * it; int key = i >> 3; const int ch = i & 7; key = key < nk ? key : nk - 1;
                          const bf16_t* src = PROJ + (rowbase + kstart + key) * EV_PITCH + kvh * 64 + ch * 8;
                          kx[it] = *(const u32x4*)(src + C_KA); vx[it] = *(const u32x4*)(src + C_VA); }
#pragma unroll
                      for (int it = 0; it < 3; ++it) { const int i = tid + 512 * it; const int key = i >> 3, ch = i & 7;
                          *(LAS u32x4*)(Kl + key * 72 + ch * 8) = kx[it];
                          const u32x4 w = vx[it]; LAS bf16_t* vp = Vt + (ch * 8) * 200 + key;
                          vp[0 * 200] = (bf16_t)(w.x & 0xffffu); vp[1 * 200] = (bf16_t)(w.x >> 16); vp[2 * 200] = (bf16_t)(w.y & 0xffffu); vp[3 * 200] = (bf16_t)(w.y >> 16);
                          vp[4 * 200] = (bf16_t)(w.z & 0xffffu); vp[5 * 200] = (bf16_t)(w.z >> 16); vp[6 * 200] = (bf16_t)(w.w & 0xffffu); vp[7 * 200] = (bf16_t)(w.w >> 16); } }
                    __syncthreads();
                    const int g = wave >> 1, qh = wave & 1, head = kvh * 4 + g, q0 = c * 64 + qh * 32;
                    const int ntile = nk >> 4;
                    const float sink = a.in[11][head];
#pragma unroll 1
                    for (int m = 0; m < 2; ++m) {
                        const int qpos = q0 + 16 * m + fr;
                        bf16x8 bq[2];
#pragma unroll
                        for (int ks = 0; ks < 2; ++ks) bq[ks] = m ? bq1[ks] : bq0[ks];
                        f32x4 s1[12];
                        float mx = -1e30f;
#pragma unroll
                        for (int t = 0; t < 12; ++t) {
                            if (t < ntile) {
                                const LAS bf16_t* kp = Kl + (16 * t + fr) * 72 + 8 * fq;
                                const bf16x8 k0 = *(const LAS bf16x8*)kp, k1 = *(const LAS bf16x8*)(kp + 32);
                                f32x4 acc = (f32x4){0.f, 0.f, 0.f, 0.f}; acc = MFMA16(k0, bq[0], acc); acc = MFMA16(k1, bq[1], acc);
#pragma unroll
                                for (int j = 0; j < 4; ++j) { const int ri = (kstart + 16 * t + 4 * fq + j) - qpos + 191; const float vv = acc[j] * 0.125f + bT[g * 256 + ri]; acc[j] = vv; mx = fmaxf(mx, vv); }
                                s1[t] = acc;
                            } else s1[t] = (f32x4){0.f, 0.f, 0.f, 0.f};
                        }
                        mx = fmaxf(mx, __shfl_xor(mx, 16)); mx = fmaxf(mx, __shfl_xor(mx, 32)); mx = fmaxf(mx, sink);
                        float sum = 0.f;
#pragma unroll
                        for (int t = 0; t < 12; ++t)
                            if (t < ntile) {
#pragma unroll
                                for (int j = 0; j < 4; ++j) { const float p = __expf(s1[t][j] - mx); s1[t][j] = p; sum += p; }
                            }
                        sum += __shfl_xor(sum, 16); sum += __shfl_xor(sum, 32);
                        const float inv = 1.f / (sum + __expf(sink - mx));
                        f32x4 o[4];
#pragma unroll
                        for (int dt = 0; dt < 4; ++dt) o[dt] = (f32x4){0.f, 0.f, 0.f, 0.f};
#pragma unroll
                        for (int st = 0; st < 6; ++st) {
                            if (2 * st < ntile) {
                                const bf16x8 pb = mk8(pk2(s1[2 * st][0], s1[2 * st][1]), pk2(s1[2 * st][2], s1[2 * st][3]), pk2(s1[2 * st + 1][0], s1[2 * st + 1][1]), pk2(s1[2 * st + 1][2], s1[2 * st + 1][3]));
#pragma unroll
                                for (int dt = 0; dt < 4; ++dt) {
                                    const LAS bf16_t* vp = Vt + (16 * dt + fr) * 200 + 32 * st + 4 * fq;
                                    const u32x2 lo = *(const LAS u32x2*)vp, hi = *(const LAS u32x2*)(vp + 16);
                                    o[dt] = MFMA16(mk8(lo.x, lo.y, hi.x, hi.y), pb, o[dt]);
                                }
                            }
                        }
#pragma unroll
                        for (int dt = 0; dt < 4; ++dt) { u32x2 w; w.x = pk2(o[dt][0] * inv, o[dt][1] * inv); w.y = pk2(o[dt][2] * inv, o[dt][3] * inv);
                            *(u32x2*)(ATT + (rowbase + qpos) * DM + head * 64 + 16 * dt + 4 * fq) = w; }
                    }
                    __syncthreads();
                }
            }
#endif
                        GSYNC();
#if !SKIP_DSA
            {
                IDS
                LAS float* bB = (LAS float*)(L + 8 * 16896);
                if (tid < 512) bB[tid] = rel_bias[(tid >> 4) * 32 + 16 + (tid & 15)];
                __syncthreads();
                LAS bf16_t* cb = (LAS bf16_t*)(L + wave * 16896);
                for (int row = gw; row < MTOK; row += NGW) {
                    const int b = row >> 12, tpos = row & 4095; const size_t rowbase = (size_t)b * SEQ;
                    const int cnt = __builtin_amdgcn_readfirstlane(CNT[row]); const int nch = cnt >> 5;
                    bf16x8 ql[8];
#pragma unroll
                    for (int ks = 0; ks < 8; ++ks) ql[ks] = *(const bf16x8*)(QLAT + ((size_t)row * 16 + fr) * 256 + 32 * ks + 8 * fq);
                    f32x4 o[16];
#pragma unroll
                    for (int rt = 0; rt < 16; ++rt) o[rt] = (f32x4){0.f, 0.f, 0.f, 0.f};
                    float mrun = -1e30f, lpart = 0.f;
                    int idxall[4];
#pragma unroll
                    for (int i = 0; i < 4; ++i) { const int e = 64 * i + lane; idxall[i] = (e < cnt) ? IDX[(size_t)row * 256 + e] : 0; }
                    u32x4 gw[16];
#define DSA_ISSUE(CH) do { const int c_ = (CH); const int s01_ = (c_ & 2) ? idxall[1] : idxall[0], s23_ = (c_ & 2) ? idxall[3] : idxall[2]; const int sel_ = (c_ & 4) ? s23_ : s01_; const int bl_ = 32 * (c_ & 1); \
        _Pragma("unroll") for (int it = 0; it < 16; ++it) { const int key = 2 * it + (lane >> 5), seg = lane & 31; const int kidx = __shfl(sel_, bl_ + key); \
            gw[it] = *(const u32x4*)(CKV + (rowbase + kidx) * 256 + seg * 8); } } while (0)
                    DSA_ISSUE(0);
                    for (int ch = 0; ch < nch; ++ch) {
                        const int s01 = (ch & 2) ? idxall[1] : idxall[0], s23 = (ch & 2) ? idxall[3] : idxall[2]; const int myidx = (ch & 4) ? s23 : s01; const int mybl = 32 * (ch & 1);
#pragma unroll
                        for (int it = 0; it < 16; ++it) { const int key = 2 * it + (lane >> 5), seg = lane & 31; *(LAS u32x4*)(cb + key * 264 + seg * 8) = gw[it]; }
                        asm volatile("s_waitcnt lgkmcnt(0)" ::: "memory");
                        if (ch + 1 < nch) DSA_ISSUE(ch + 1);
                        f32x4 sa[2];
#pragma unroll
                        for (int kt = 0; kt < 2; ++kt) { f32x4 acc = (f32x4){0.f, 0.f, 0.f, 0.f};
#pragma unroll
                            for (int ks = 0; ks < 8; ++ks) { const bf16x8 ac = *(const LAS bf16x8*)(cb + (16 * kt + fr) * 264 + 32 * ks + 8 * fq); acc = MFMA16(ac, ql[ks], acc); }
                            sa[kt] = acc; }
                        float cm = -1e30f;
                        const int mybucket = t5_bucket(__shfl(myidx, mybl + (lane & 31)) - tpos) * 16;
#pragma unroll
                        for (int kt = 0; kt < 2; ++kt)
#pragma unroll
                            for (int j = 0; j < 4; ++j) { const int bk = __shfl(mybucket, 16 * kt + 4 * fq + j); const float vv = sa[kt][j] + bB[bk + fr]; sa[kt][j] = vv; cm = fmaxf(cm, vv); }
                        cm = fmaxf(cm, __shfl_xor(cm, 16)); cm = fmaxf(cm, __shfl_xor(cm, 32));
                        const float mnew = fmaxf(mrun, cm), alpha = __expf(mrun - mnew); mrun = mnew;
                        float ps = 0.f;
#pragma unroll
                        for (int kt = 0; kt < 2; ++kt)
#pragma unroll
                            for (int j = 0; j < 4; ++j) { const float p = __expf(sa[kt][j] - mnew); sa[kt][j] = p; ps += p; }
                        lpart = lpart * alpha + ps;
                        if (__any(alpha != 1.f)) {
#pragma unroll
                            for (int rt = 0; rt < 16; ++rt) o[rt] *= alpha;
                        }
                        const bf16x8 pb = mk8(pk2(sa[0][0], sa[0][1]), pk2(sa[0][2], sa[0][3]), pk2(sa[1][0], sa[1][1]), pk2(sa[1][2], sa[1][3]));
#pragma unroll
                        for (int rt = 0; rt < 16; ++rt) {
                            const LAS bf16_t* cp = cb + (4 * fq + (fr >> 2)) * 264 + 16 * rt + 4 * (fr & 3);
                            const s16x4_t lo = lds_tr4(cp), hi = lds_tr4(cp + 16 * 264);
                            const bf16x8 av = __builtin_shufflevector(lo, hi, 0, 1, 2, 3, 4, 5, 6, 7);
                            o[rt] = MFMA16(av, pb, o[rt]);
                        }
                        asm volatile("s_waitcnt lgkmcnt(0)" ::: "memory");
                    }
                    float l = lpart + __shfl_xor(lpart, 16); l += __shfl_xor(l, 32);
                    const float inv = 1.f / l;
#pragma unroll
                    for (int rt = 0; rt < 16; ++rt) { u32x2 w; w.x = pk2(o[rt][0] * inv, o[rt][1] * inv); w.y = pk2(o[rt][2] * inv, o[rt][3] * inv);
                        *(u32x2*)(QLAT + ((size_t)row * 16 + fr) * 256 + 16 * rt + 4 * fq) = w; }
                }
            }
#endif
            GSYNC();
#if !SKIP_DSA
            { IDS
            for (int unit = gw; unit < 16384; unit += NGW) {
                const int h = unit & 15, t0 = (unit >> 4) * 16;
                bf16x8 bo[8];
#pragma unroll
                for (int ks = 0; ks < 8; ++ks) bo[ks] = *(const bf16x8*)(QLAT + ((size_t)(t0 + fr) * 16 + h) * 256 + 32 * ks + 8 * fq);
#pragma unroll
                for (int dt = 0; dt < 4; ++dt) {
                    f32x4 acc = (f32x4){0.f, 0.f, 0.f, 0.f};
                    bf16x8 aw[8];
#pragma unroll
                    for (int ks = 0; ks < 8; ++ks) aw[ks] = *(const bf16x8*)(WUVT + (size_t)(h * 64 + 16 * dt + fr) * 256 + 32 * ks + 8 * fq);
#pragma unroll
                    for (int ks = 0; ks < 8; ++ks) acc = MFMA16(aw[ks], bo[ks], acc);
                    u32x2 w; w.x = pk2(acc[0], acc[1]); w.y = pk2(acc[2], acc[3]);
                    *(u32x2*)(ATT + (size_t)(t0 + fr) * DM + 1024 + h * 64 + 16 * dt + 4 * fq) = w;
                }
            } }
#endif
            GSYNC();
        } else {
            { pg8::Gemm g{XN, WIN, MTOK, OD_PITCH, 2048}; pg8::StaticOrder S; S.init(MTOK, OD_PITCH, G, (int)blockIdx.x);
              pg8::EpiBf16 E{PROJ, OD_PITCH, nullptr, 0};
              pg8::gemm_phase<pg8::EpiBf16, pg8::StaticOrder, true, true>(L, g, S, E); }
            GSYNC();
#if SKIP_SB == 2
            { IDS for (size_t i = (size_t)blockIdx.x * 512 + tid; i < (size_t)MTOK * 256; i += (size_t)G * 512) { const size_t row = i >> 8, c8 = i & 255; ((u32x4*)ATT)[i] = *(const u32x4*)(PROJ + row * OD_PITCH + 4096 + c8 * 8); } }
#endif
#if !SKIP_SB
            {
                IDS
                LAS bf16_t* vb = (LAS bf16_t*)(L + wave * 8704);
                for (int unit = gw; unit < 8192; unit += NGW) {
                    const int qt = 127 - (unit >> 6), h = unit & 15, b = (unit >> 4) & 3; const int q0 = qt * 32; const size_t rowbase = (size_t)b * SEQ;
                    bf16x8 bq[2][4];
#pragma unroll
                    for (int m = 0; m < 2; ++m)
#pragma unroll
                        for (int ks = 0; ks < 4; ++ks) bq[m][ks] = *(const bf16x8*)(PROJ + (rowbase + q0 + 16 * m + fr) * OD_PITCH + h * 128 + 32 * ks + 8 * fq);
                    f32x4 o[8][2];
#pragma unroll
                    for (int dt = 0; dt < 8; ++dt) { o[dt][0] = (f32x4){0.f, 0.f, 0.f, 0.f}; o[dt][1] = (f32x4){0.f, 0.f, 0.f, 0.f}; }
                    float Pc[2] = {1.f, 1.f};
                    for (int kb = qt; kb >= 0; --kb) {
                        bf16x8 akk[2][4];
                        { u32x4 gw[8];
#pragma unroll
                          for (int it = 0; it < 8; ++it) { const int key = 4 * it + (lane >> 4), seg = lane & 15;
                              gw[it] = *(const u32x4*)(PROJ + (rowbase + 32 * kb + key) * OD_PITCH + 4096 + h * 128 + seg * 8); }
#pragma unroll
                          for (int kt = 0; kt < 2; ++kt)
#pragma unroll
                              for (int ks = 0; ks < 4; ++ks) akk[kt][ks] = *(const bf16x8*)(PROJ + (rowbase + 32 * kb + 16 * kt + fr) * OD_PITCH + 2048 + h * 128 + 8 * fq + 32 * ks);
                          __builtin_amdgcn_sched_barrier(0);
#pragma unroll
                          for (int it = 0; it < 8; ++it) { const int key = 4 * it + (lane >> 4), seg = lane & 15; *(LAS u32x4*)(vb + key * 136 + seg * 8) = gw[it]; } }
                        asm volatile("s_waitcnt lgkmcnt(0)" ::: "memory");
                        f32x4 z[2][2];
#pragma unroll
                        for (int kt = 0; kt < 2; ++kt) {
                            bf16x8 ak[4];
#pragma unroll
                            for (int ks = 0; ks < 4; ++ks) ak[ks] = akk[kt][ks];
#pragma unroll
                            for (int m = 0; m < 2; ++m) { f32x4 acc = (f32x4){0.f, 0.f, 0.f, 0.f};
#pragma unroll
                                for (int ks = 0; ks < 4; ++ks) acc = MFMA16(ak[ks], bq[m][ks], acc);
                                z[kt][m] = acc; }
                        }
                        const bool diag = (kb == qt);
                        bf16x8 pb[2];
#pragma unroll
                        for (int m = 0; m < 2; ++m) {
                            float kp[2][4], sg[2][4];
#pragma unroll
                            for (int kt = 0; kt < 2; ++kt)
#pragma unroll
                                for (int j = 0; j < 4; ++j) { const float t = __expf(z[kt][m][j] * 0.08838834764831845f); const float k1 = __builtin_amdgcn_rcpf(1.f + t);
                                    const bool e = !diag || (16 * kt + 4 * fq + j < 16 * m + fr); kp[kt][j] = e ? k1 : 1.f; sg[kt][j] = e ? t * k1 : 0.f; }
                            const float g0 = (kp[0][0] * kp[0][1]) * (kp[0][2] * kp[0][3]), g1 = (kp[1][0] * kp[1][1]) * (kp[1][2] * kp[1][3]);
                            float g0a[4], g1a[4];
#pragma unroll
                            for (int f = 0; f < 4; ++f) { g0a[f] = __shfl(g0, fr + 16 * f); g1a[f] = __shfl(g1, fr + 16 * f); }
                            const float tot0 = (g0a[0] * g0a[1]) * (g0a[2] * g0a[3]), tot1 = (g1a[0] * g1a[1]) * (g1a[2] * g1a[3]);
                            const float aft1 = (fq < 1 ? g1a[1] : 1.f) * (fq < 2 ? g1a[2] : 1.f) * (fq < 3 ? g1a[3] : 1.f);
                            const float aft0 = (fq < 1 ? g0a[1] : 1.f) * (fq < 2 ? g0a[2] : 1.f) * (fq < 3 ? g0a[3] : 1.f) * tot1;
                            float av[2][4];
#pragma unroll
                            for (int kt = 0; kt < 2; ++kt) { float suf = Pc[m] * (kt == 0 ? aft0 : aft1);
#pragma unroll
                                for (int j = 3; j >= 0; --j) { av[kt][j] = sg[kt][j] * suf; suf *= kp[kt][j]; } }
                            Pc[m] *= tot0 * tot1;
                            pb[m] = mk8(pk2(av[0][0], av[0][1]), pk2(av[0][2], av[0][3]), pk2(av[1][0], av[1][1]), pk2(av[1][2], av[1][3]));
                        }
#pragma unroll
                        for (int dt = 0; dt < 8; ++dt) {
                            const LAS bf16_t* cp = vb + (4 * fq + (fr >> 2)) * 136 + 16 * dt + 4 * (fr & 3);
                            const s16x4_t lo = lds_tr4(cp), hi = lds_tr4(cp + 16 * 136);
                            const bf16x8 vv = __builtin_shufflevector(lo, hi, 0, 1, 2, 3, 4, 5, 6, 7);
                            o[dt][0] = MFMA16(vv, pb[0], o[dt][0]); o[dt][1] = MFMA16(vv, pb[1], o[dt][1]);
                        }
                        asm volatile("s_waitcnt lgkmcnt(0)" ::: "memory");
                        if (__all(Pc[0] <= SB_CUT && Pc[1] <= SB_CUT)) break;
                    }
#pragma unroll
                    for (int m = 0; m < 2; ++m)
#pragma unroll
                        for (int dt = 0; dt < 8; ++dt) { u32x2 w; w.x = pk2(o[dt][m][0], o[dt][m][1]); w.y = pk2(o[dt][m][2], o[dt][m][3]);
                            *(u32x2*)(ATT + (rowbase + q0 + 16 * m + fr) * DM + h * 128 + 16 * dt + 4 * fq) = w; }
                }
            }
#endif
            GSYNC();
        }
        { pg8::Gemm g{ATT, WOUT, MTOK, 2048, 2048}; pg8::StaticOrder S; S.init(MTOK, 2048, G, (int)blockIdx.x);
          pg8::EpiResid E{xcur, xres, modl + 4096};
          pg8::gemm_phase<pg8::EpiResid, pg8::StaticOrder, true, true>(L, g, S, E); }
        GSYNC();
        { IDS norm_mod_phase(xres, a.in[6] + layer * DM, modl, 3 * 2048, 4 * 2048, XN, gw, NGW, lane); }
        GSYNC();
        { pg8::Gemm g{XN, WUP, MTOK, DFF2, 2048}; pg8::StaticOrder S; S.init(MTOK, DFF2, G, (int)blockIdx.x);
          pg8::EpiConvGate E{GB, HBUF, a.in[16] + (size_t)layer * 3 * DFF2, a.in[17] + (size_t)layer * DFF2, (LAS unsigned*)(L + 131072), 0};
          pg8::gemm_phase<pg8::EpiConvGate, pg8::StaticOrder, true, true>(L, g, S, E); }
        GSYNC();
        { IDS
          const float* cw = a.in[16] + (size_t)layer * 3 * DFF2; const float* cb = a.in[17] + (size_t)layer * DFF2;
          for (int item = blockIdx.x * 512 + tid; item < 64 * DFF; item += G * 512) {
              const int pm = item / DFF, ch = item - pm * DFF;
              const bool first = (pm & 15) == 0; const float fm = first ? 0.f : 1.f;
              const float* h = HBUF + (size_t)pm * 4 * DFF2; const float* hp = first ? h : h - (size_t)4 * DFF2;
              float u0[2], u1[2], um2[2], um1[2], w0[2], w1[2], w2[2], bb[2];
#pragma unroll
              for (int bj = 0; bj < 2; ++bj) { const int c = ch + bj * DFF;
                  u0[bj] = h[c]; u1[bj] = h[DFF2 + c]; um2[bj] = hp[2 * DFF2 + c]; um1[bj] = hp[3 * DFF2 + c];
                  w0[bj] = cw[c]; w1[bj] = cw[DFF2 + c]; w2[bj] = cw[2 * DFF2 + c]; bb[bj] = cb[c]; }
              float res[2];
#pragma unroll
              for (int r = 0; r < 2; ++r) {
                  float cvv[2];
#pragma unroll
                  for (int bj = 0; bj < 2; ++bj) {
                      const float xc = r == 0 ? u0[bj] : u1[bj], x1 = r == 0 ? um1[bj] * fm : u0[bj], x2 = r == 0 ? um2[bj] * fm : um1[bj] * fm;
                      cvv[bj] = w2[bj] * xc + w1[bj] * x1 + w0[bj] * x2 + bb[bj]; }
                  res[r] = cvv[0] / (1.f + __expf(-cvv[0])) * cvv[1];
              }
              GB[(size_t)(pm * 256) * DFF + ch] = (bf16_t)(pk2(res[0], 0.f) & 0xffffu);
              GB[(size_t)(pm * 256 + 1) * DFF + ch] = (bf16_t)(pk2(res[1], 0.f) & 0xffffu);
          } }
        GSYNC();
        { pg8::Gemm g{GB, WDN, MTOK, 2048, DFF}; pg8::StaticOrder S; S.init(MTOK, 2048, G, (int)blockIdx.x);
          pg8::EpiResid E{xres, xres, modl + 5 * 2048};
          pg8::gemm_phase<pg8::EpiResid, pg8::StaticOrder, true, true>(L, g, S, E); }
        GSYNC();
    }
#if DIAG
    { IDS
      float t1 = 0.f, t2 = 0.f;
      for (int k = 0; k < 20; ++k) { const float d = (float)(TS[k + 1] - TS[k]) * 0.01f; if ((DIAG_M1 >> k) & 1) t1 += d; if ((DIAG_M2 >> k) & 1) t2 += d; }
      const float vleak = __log2f(t1 + 1.f); (void)t2;
      for (size_t i = (size_t)blockIdx.x * 512 + tid; i < (size_t)MTOK * DM; i += (size_t)G * 512) xres[i] = vleak;
      return; }
#endif
    { IDS
    for (int row = gw; row < MTOK; row += NGW) {
        f32x4* xr = (f32x4*)(xres + (size_t)row * DM) + lane;
        f32x4 v[8]; float ss = 0.f;
#pragma unroll
        for (int j = 0; j < 8; ++j) { v[j] = xr[64 * j]; ss += (v[j].x * v[j].x + v[j].y * v[j].y) + (v[j].z * v[j].z + v[j].w * v[j].w); }
        ss = wave_sum(ss);
        const float r = rsqrtf(ss * (1.f / DM) + EPS);
#pragma unroll
        for (int j = 0; j < 8; ++j) { const f32x4 g4 = *(const f32x4*)(a.in[19] + 4 * (64 * j + lane)); xr[64 * j] = v[j] * r * g4; }
    } }
}

extern "C" void kernel_launch(void* const* d_in, const int* in_sizes, int n_in, void* d_out, int out_size, void* d_ws, size_t ws_size, hipStream_t stream) {
    static int grid = 0;
    if (grid == 0) {
        if (n_in != 20 || out_size != MTOK * DM || ws_size < WS_END) { fprintf(stderr, "kernel_launch: unexpected shapes (n_in %d, out %d, ws %zu)\n", n_in, out_size, ws_size); grid = -1; return; }
        int dev = 0, cus = 0, per_cu = 0;
        hipGetDevice(&dev); hipDeviceGetAttribute(&cus, hipDeviceAttributeMultiprocessorCount, dev);
        if (hipFuncSetAttribute((const void*)mega_fwd, hipFuncAttributeMaxDynamicSharedMemorySize, LDS_BYTES) != hipSuccess) { fprintf(stderr, "kernel_launch: hipFuncSetAttribute failed\n"); grid = -1; return; }
        if (hipOccupancyMaxActiveBlocksPerMultiprocessor(&per_cu, (const void*)mega_fwd, 512, LDS_BYTES) != hipSuccess || per_cu < 1) per_cu = 1;
        (void)hipGetLastError();
        grid = cus * (per_cu > 1 ? 1 : per_cu);
    }
    if (grid < 0) return;
    Args a{};
    for (int i = 0; i < 20; ++i) a.in[i] = (const float*)d_in[i];
    a.out = (float*)d_out; a.ws = (unsigned char*)d_ws;
    void* args[] = {&a};
    hipError_t e = hipLaunchCooperativeKernel((const void*)mega_fwd, dim3(grid), dim3(512), args, LDS_BYTES, stream);
    if (e != hipSuccess) fprintf(stderr, "cooperative launch failed: %s (grid %d)\n", hipGetErrorString(e), grid);
}
```

```cpp
#include <hip/hip_runtime.h>
#include <hip/hip_cooperative_groups.h>
#include <cstdio>
#include <cstdint>
namespace cg = cooperative_groups;

namespace pg8 {
#define PG8_LAS __attribute__((address_space(3)))
typedef unsigned short bf16_t;
typedef short bf16x8 __attribute__((ext_vector_type(8)));
typedef float f32x4 __attribute__((ext_vector_type(4)));
typedef unsigned u32x4 __attribute__((ext_vector_type(4)));
constexpr int BM = 256, BK = 64, HALF = 128, HTB = HALF * BK * 2  , STAGE_BYTES = 8 * HTB, NXCD = 8, WGM = 8;

__host__ __device__ __forceinline__ int lds_byte(int r, int c) { const int st = (r >> 4) * 2 + (c >> 5), rr = r & 15, cc = c & 31, ob = rr * 64 + cc * 2; return st * 1024 + (ob ^ (((ob >> 9) & 1) << 5)); }
__host__ __device__ __forceinline__ void stage_rc(int b, int& R, int& C) { const int st = b / 1024, sb = b % 1024, swz = sb ^ (((sb >> 9) & 1) << 5); R = (st >> 1) * 16 + swz / 64; C = (st & 1) * 32 + (swz % 64) / 2; }
__host__ __device__ __forceinline__ int perm32(int rho) { const int n = rho >> 4, i = rho & 15; return 8 * (i >> 2) + 4 * n + (i & 3); }

struct Unit { int pm, pn; };
struct Gemm { const bf16_t* A; const bf16_t* Bt; int M, N, K; };

struct StaticOrder {
    int nM, nN, nwg, G, c;
    __host__ __device__ void init(int M, int N, int G_, int c_) { nM = M / BM; nN = N / BM; nwg = nM * nN; G = G_; c = c_; }
    __host__ __device__ bool next(int i, Unit& u) const {
        const long L = (long)i * G + c; if (L >= nwg) return false;
        int wgid = (int)L; { const int q = nwg / NXCD, r = nwg % NXCD, xcd = wgid % NXCD, off = wgid / NXCD; wgid = (xcd < r ? xcd * (q + 1) : r * (q + 1) + (xcd - r) * q) + off; }
        const int nig = WGM * nN, gid = wgid / nig, fm = gid * WGM, gsz = (nM - fm) < WGM ? (nM - fm) : WGM;
        u.pm = fm + ((wgid % nig) % gsz); u.pn = (wgid % nig) / gsz; return true;
    }
    __device__ __forceinline__ void a_ready(const Unit&) const {}
    __device__ __forceinline__ void done(const Unit&) const {}
};

__device__ __forceinline__ unsigned cvt_pk_bf16(float lo, float hi) { unsigned r; asm volatile("v_cvt_pk_bf16_f32 %0, %1, %2" : "=v"(r) : "v"(lo), "v"(hi)); return r; }
typedef float f32x2 __attribute__((ext_vector_type(2)));
typedef unsigned u32x2v __attribute__((ext_vector_type(2)));
typedef float f32x2c __attribute__((ext_vector_type(2))); typedef __bf16 bf16x2c __attribute__((ext_vector_type(2)));
__device__ __forceinline__ unsigned pkb(float lo, float hi) { f32x2c v = {lo, hi}; bf16x2c b = __builtin_convertvector(v, bf16x2c); return __builtin_bit_cast(unsigned, b); }
struct EpiBf16 {
    static constexpr bool PERM = true, AFTER_DRAIN = false;
    bf16_t* O; int ldc; bf16_t* O2; int o2_pn;
    __device__ __forceinline__ void operator()(const f32x4 (&acc)[2][2][4][2], const Unit& u, int wr, int wc, int fr, int fq) const {
        const int row0 = u.pm * BM + wr * 64 + fr; const int col0 = u.pn * BM + wc * 32 + 8 * fq;
#pragma unroll
        for (int ai = 0; ai < 2; ++ai)
#pragma unroll
            for (int m = 0; m < 4; ++m) { bf16_t* rowp = O + (size_t)(row0 + ai * HALF + m * 16) * ldc + col0;
#pragma unroll
                for (int bj = 0; bj < 2; ++bj) { const f32x4 v0 = acc[ai][bj][m][0], v1 = acc[ai][bj][m][1];
                    u32x4 w; w.x = pkb(v0[0], v0[1]); w.y = pkb(v0[2], v0[3]); w.z = pkb(v1[0], v1[1]); w.w = pkb(v1[2], v1[3]);
                    *(u32x4*)(rowp + bj * HALF) = w;
                    if (O2 != nullptr && bj == 0 && u.pn == o2_pn && wc < 2) *(u32x4*)(O2 + (size_t)(row0 + ai * HALF + m * 16) * 64 + wc * 32 + 8 * fq) = w; } }
    }
};

struct EpiConvGate {
    static constexpr bool PERM = true, AFTER_DRAIN = false;
    bf16_t* Gout; float* HB; const float* cw; const float* cb; PG8_LAS unsigned* halo; mutable int parity;
    __device__ __forceinline__ void operator()(const f32x4 (&acc)[2][2][4][2], const Unit& u, int wr, int wc, int fr_, int fq_) const {
        int fr = fr_, fq = fq_; asm volatile("" : "+v"(fr), "+v"(fq));
        const int lane = fq * 16 + fr;
        PG8_LAS unsigned* hb = halo + (parity & 1) * 2048; PG8_LAS float* wl = (PG8_LAS float*)(hb + 1024); ++parity;
        const int ci = wc * 32 + 8 * fq;
        const int chg = u.pn * 128 + ci;
        { const size_t hrow = (size_t)u.pm * 4 * 11264;
          if (wr == 0 && fr < 2) {
#pragma unroll
              for (int bj = 0; bj < 2; ++bj)
#pragma unroll
                  for (int n = 0; n < 2; ++n) *(f32x4*)(HB + hrow + (size_t)fr * 11264 + bj * 5632 + chg + 4 * n) = acc[0][bj][0][n];
          }
          if (wr == 1 && fr >= 14) {
#pragma unroll
              for (int bj = 0; bj < 2; ++bj)
#pragma unroll
                  for (int n = 0; n < 2; ++n) *(f32x4*)(HB + hrow + (size_t)(2 + fr - 14) * 11264 + bj * 5632 + chg + 4 * n) = acc[1][bj][3][n];
          } }
        unsigned P[2][2][4][2][2];
#pragma unroll
        for (int ai = 0; ai < 2; ++ai)
#pragma unroll
            for (int bj = 0; bj < 2; ++bj)
#pragma unroll
                for (int m = 0; m < 4; ++m)
#pragma unroll
                    for (int n = 0; n < 2; ++n) { P[ai][bj][m][n][0] = pkb(acc[ai][bj][m][n][0], acc[ai][bj][m][n][1]); P[ai][bj][m][n][1] = pkb(acc[ai][bj][m][n][2], acc[ai][bj][m][n][3]); }
        if (fr >= 14) {
#pragma unroll
            for (int ai = 0; ai < 2; ++ai)
#pragma unroll
                for (int bj = 0; bj < 2; ++bj)
#pragma unroll
                    for (int n = 0; n < 2; ++n) { PG8_LAS unsigned* d = hb + ((((ai * 2 + wr) * 2 + (fr - 14)) * 2 + bj) * 64) + (ci >> 1) + 2 * n; d[0] = P[ai][bj][3][n][0]; d[1] = P[ai][bj][3][n][1]; }
        }
        { const int t = (wr * 4 + wc) * 64 + lane;
#pragma unroll
          for (int k = 0; k < 2; ++k) { const int idx = t + 512 * k, tb = idx >> 8, bj = (idx >> 7) & 1, i = idx & 127;
              const float* src = (tb < 3 ? cw + tb * 11264 : cb) + bj * 5632 + u.pn * 128 + i; wl[idx] = *src; } }
        asm volatile("s_waitcnt vmcnt(0) lgkmcnt(0)" ::: "memory"); __builtin_amdgcn_s_barrier(); asm volatile("" ::: "memory");
        const int src1 = (lane & 48) | ((fr + 15) & 15), src2 = (lane & 48) | ((fr + 14) & 15);
        const int pwr = (wr == 1) ? 0 : 1;
        int rowv = u.pm * BM + wr * 64 + fr;
#pragma unroll
        for (int n = 0; n < 2; ++n) {
            unsigned outp[2][4][2];
#pragma unroll
            for (int h = 0; h < 2; ++h) {
                float w0[2][2], w1[2][2], w2[2][2], bb[2][2];
#pragma unroll
                for (int bj = 0; bj < 2; ++bj) { const PG8_LAS float* p0 = wl + bj * 128 + ci + 4 * n + 2 * h;
#pragma unroll
                    for (int q = 0; q < 2; ++q) { w0[bj][q] = p0[q]; w1[bj][q] = p0[256 + q]; w2[bj][q] = p0[512 + q]; bb[bj][q] = p0[768 + q]; } }
#pragma unroll
                for (int ai = 0; ai < 2; ++ai) {
                    const int pai = (wr == 1) ? ai : 0;
                    float cv[2][4][2];
#pragma unroll
                    for (int bj = 0; bj < 2; ++bj) {
                        const PG8_LAS unsigned* hp = hb + ((((pai * 2 + pwr) * 2) * 2 + bj) * 64) + (ci >> 1) + 2 * n + h; const unsigned h1 = hp[128]; const unsigned hh = fr == 0 ? hp[0] : h1;
                        unsigned x[4], r1[4], r2[4];
#pragma unroll
                        for (int m = 0; m < 4; ++m) { x[m] = P[ai][bj][m][n][h]; r1[m] = (unsigned)__builtin_amdgcn_update_dpp(0, (int)x[m], 0x121, 0xf, 0xf, false); r2[m] = (unsigned)__builtin_amdgcn_update_dpp(0, (int)x[m], 0x122, 0xf, 0xf, false); }
#pragma unroll
                        for (int m = 0; m < 4; ++m) {
                            const unsigned p1 = fr >= 1 ? r1[m] : (m >= 1 ? r1[m >= 1 ? m - 1 : 0] : h1);
                            const unsigned p2 = fr >= 2 ? r2[m] : (m >= 1 ? r2[m >= 1 ? m - 1 : 0] : hh);
                            const f32x2 xv = {__uint_as_float(x[m] << 16), __uint_as_float(x[m] & 0xffff0000u)}, p1v = {__uint_as_float(p1 << 16), __uint_as_float(p1 & 0xffff0000u)}, p2v = {__uint_as_float(p2 << 16), __uint_as_float(p2 & 0xffff0000u)};
                            const f32x2 w2v = {w2[bj][0], w2[bj][1]}, w1v = {w1[bj][0], w1[bj][1]}, w0v = {w0[bj][0], w0[bj][1]}, bv2 = {bb[bj][0], bb[bj][1]};
                            const f32x2 c2 = w2v * xv + (w1v * p1v + (w0v * p2v + bv2));
                            cv[bj][m][0] = c2.x; cv[bj][m][1] = c2.y;
                        }
                    }
#pragma unroll
                    for (int m = 0; m < 4; ++m) { const float g0 = cv[0][m][0], g1 = cv[0][m][1];
                        outp[ai][m][h] = pkb(g0 * __builtin_amdgcn_rcpf(1.f + __expf(-g0)) * cv[1][m][0], g1 * __builtin_amdgcn_rcpf(1.f + __expf(-g1)) * cv[1][m][1]); }
                }
            }
            { bf16_t* gp = Gout + (size_t)rowv * 5632 + chg + 4 * n;
#pragma unroll
              for (int ai = 0; ai < 2; ++ai)
#pragma unroll
                for (int m = 0; m < 4; ++m) {
                    if (!(ai == 0 && wr == 0 && m == 0 && fr < 2)) {
                        u32x2v w; w.x = outp[ai][m][0]; w.y = outp[ai][m][1];
                        *(u32x2v*)(gp + (size_t)(ai * HALF + m * 16) * 5632) = w;
                    }
                } }
        }
    }
};
struct EpiResid {
    static constexpr bool PERM = false, AFTER_DRAIN = false;
    const float* base; float* out; const float* gate;
    __device__ __forceinline__ void operator()(const f32x4 (&acc)[2][2][4][2], const Unit& u, int wr, int wc, int fr, int fq) const {
        const int b = (u.pm * BM) >> 12; const int col0 = u.pn * BM + wc * 32 + 4 * fq; const float* gp = gate + (size_t)b * 12288 + col0;
#pragma unroll
        for (int bj = 0; bj < 2; ++bj)
#pragma unroll
            for (int n = 0; n < 2; ++n) { const f32x4 gv = *(const f32x4*)(gp + bj * HALF + n * 16);
                const size_t off0 = (size_t)(u.pm * BM + wr * 64 + fr) * 2048 + col0 + bj * HALF + n * 16;
                f32x4 bs[2][4];
#pragma unroll
                for (int ai = 0; ai < 2; ++ai)
#pragma unroll
                    for (int m = 0; m < 4; ++m) bs[ai][m] = *(const f32x4*)(base + off0 + (size_t)(ai * HALF + m * 16) * 2048);
#pragma unroll
                for (int ai = 0; ai < 2; ++ai)
#pragma unroll
                    for (int m = 0; m < 4; ++m) *(f32x4*)(out + off0 + (size_t)(ai * HALF + m * 16) * 2048) = bs[ai][m] + gv * acc[ai][bj][m][n]; }
    }
};
template <class Epi, class Sched, bool ALIGN_EPI = false, bool SP2 = false>
__device__ __forceinline__ void gemm_phase(PG8_LAS unsigned char* lds, const Gemm g, const Sched& S, const Epi& E) {
    int tid_o = threadIdx.x; asm volatile("" : "+v"(tid_o)); const int tid = tid_o, wid = __builtin_amdgcn_readfirstlane(tid >> 6), lane = tid & 63, wr = wid >> 2, wc = wid & 3, fr = lane & 15, fq = lane >> 4;
    const int K = g.K, nt = K / BK;
    unsigned voffA[2], voffB[2];
#pragma unroll
    for (int i = 0; i < 2; ++i) { int R, C; stage_rc(tid * 16 + i * 8192, R, C); const int Rb = Epi::PERM ? ((R & ~31) + perm32(R & 31)) : R;
        voffA[i] = (unsigned)(R * K + C) * 2u; voffB[i] = (unsigned)(Rb * K + C) * 2u; }
    const size_t kstep = (size_t)(BK * 2);
    const size_t hstep = (size_t)HALF * K * 2;
    const size_t tstep = 2 * hstep;
    const unsigned ldsw = (unsigned)wid * 1024u;
    const int aoff = lds_byte(wr * 64 + fr, fq * 8), boff = lds_byte(wc * 32 + fr, fq * 8);
#define PG8_SA(b, h) (((b) * 2 + (h)) * HTB)
#define PG8_SB(b, h) ((4 + (b) * 2 + (h)) * HTB)
#define PG8_STAGE(bufoff, gbase, voff) do { _Pragma("unroll") for (int _i = 0; _i < 2; ++_i) \
        __builtin_amdgcn_global_load_lds((const unsigned*)((const char*)(gbase) + (voff)[_i]), (PG8_LAS unsigned*)(lds + (bufoff) + ldsw + _i * 8192), 16, 0, 0); } while (0)
#define PG8_LDA(dst, b, h) do { _Pragma("unroll") for (int m = 0; m < 4; ++m) _Pragma("unroll") for (int k = 0; k < 2; ++k) dst[m][k] = *(const PG8_LAS bf16x8*)(lds + PG8_SA(b, h) + aoff + m * 2048 + k * 1024); } while (0)
#define PG8_LDB(dst, b, h) do { _Pragma("unroll") for (int n = 0; n < 2; ++n) _Pragma("unroll") for (int k = 0; k < 2; ++k) dst[n][k] = *(const PG8_LAS bf16x8*)(lds + PG8_SB(b, h) + boff + n * 2048 + k * 1024); } while (0)
#define PG8_MMA(ai, bj, At, Bt) do { __builtin_amdgcn_s_setprio(1); _Pragma("unroll") for (int m = 0; m < 4; ++m) _Pragma("unroll") for (int n = 0; n < 2; ++n) _Pragma("unroll") for (int k = 0; k < 2; ++k) \
        acc[ai][bj][m][n] = __builtin_amdgcn_mfma_f32_16x16x32_bf16(Bt[n][k], At[m][k], acc[ai][bj][m][n], 0, 0, 0); __builtin_amdgcn_s_setprio(0); } while (0)
#define PG8_WAIT_V(n) asm volatile("s_waitcnt vmcnt(" #n ")" ::: "memory")
#define PG8_WAIT_L(n) asm volatile("s_waitcnt lgkmcnt(" #n ")" ::: "memory")
#define PG8_BAR __builtin_amdgcn_s_barrier()
#define PG8_SCHED __builtin_amdgcn_sched_barrier(0)
    Unit cur, nxt; int ui = 0;
    if (!S.next(0, cur)) return;
    f32x4 acc[2][2][4][2];
#pragma unroll
    for (int a = 0; a < 2; ++a)
#pragma unroll
        for (int b = 0; b < 2; ++b)
#pragma unroll
            for (int m = 0; m < 4; ++m)
#pragma unroll
                for (int n = 0; n < 2; ++n) acc[a][b][m][n] = (f32x4){0.f, 0.f, 0.f, 0.f};
    bf16x8 At[4][2], B0[2][2], B1[2][2];
    const char* cA = (const char*)g.A + (size_t)cur.pm * tstep; const char* cB = (const char*)g.Bt + (size_t)cur.pn * tstep;
    S.a_ready(cur);
    if constexpr (SP2) {
        PG8_STAGE(PG8_SB(0, 0), cB, voffB); PG8_STAGE(PG8_SB(0, 1), cB + hstep, voffB); PG8_STAGE(PG8_SA(0, 0), cA, voffA); PG8_STAGE(PG8_SA(0, 1), cA + hstep, voffA);
        if (wr == 1) PG8_BAR;
        PG8_WAIT_V(2); PG8_BAR;
        PG8_STAGE(PG8_SB(1, 0), cB + kstep, voffB); PG8_STAGE(PG8_SA(1, 0), cA + kstep, voffA); PG8_STAGE(PG8_SB(1, 1), cB + hstep + kstep, voffB);
        PG8_WAIT_V(6); PG8_BAR;
    } else {
        PG8_STAGE(PG8_SB(0, 0), cB, voffB); PG8_STAGE(PG8_SA(0, 0), cA, voffA); PG8_STAGE(PG8_SB(0, 1), cB + hstep, voffB); PG8_STAGE(PG8_SA(0, 1), cA + hstep, voffA);
        if (wr == 1) PG8_BAR;
        PG8_WAIT_V(4); PG8_BAR;
        PG8_STAGE(PG8_SB(1, 0), cB + kstep, voffB); PG8_STAGE(PG8_SA(1, 0), cA + kstep, voffA); PG8_STAGE(PG8_SB(1, 1), cB + hstep + kstep, voffB);
        PG8_WAIT_V(6); PG8_BAR;
    }
    for (;;) {
        const bool has_next = S.next(ui + 1, nxt);
        const char* nA = has_next ? (const char*)g.A + (size_t)nxt.pm * tstep : cA; const char* nB = has_next ? (const char*)g.Bt + (size_t)nxt.pn * tstep : cB;
        for (int t = 0; t < nt; t += 2) {
            const bool last = (t == nt - 2);
            const char* a1 = cA + (size_t)(t + 1) * kstep;
            const char* a2 = last ? nA : cA + (size_t)(t + 2) * kstep; const char* b2 = last ? nB : cB + (size_t)(t + 2) * kstep;
            const char* a3 = a2 + kstep; const char* b3 = b2 + kstep;
            if (last && has_next) S.a_ready(nxt);
            if constexpr (SP2) {
            PG8_LDB(B0, 0, 0); PG8_LDB(B1, 0, 1); PG8_SCHED; PG8_LDA(At, 0, 0); PG8_STAGE(PG8_SA(1, 1), a1 + hstep, voffA);
            PG8_WAIT_V(8); PG8_WAIT_L(0); PG8_BAR; PG8_MMA(0, 0, At, B0); PG8_MMA(0, 1, At, B1); PG8_BAR; PG8_SCHED;
            PG8_LDA(At, 0, 1); PG8_STAGE(PG8_SB(0, 0), b2, voffB); PG8_STAGE(PG8_SB(0, 1), b2 + hstep, voffB); PG8_STAGE(PG8_SA(0, 0), a2, voffA);
            PG8_WAIT_V(8); PG8_WAIT_L(0); PG8_BAR; PG8_MMA(1, 0, At, B0); PG8_MMA(1, 1, At, B1); PG8_BAR; PG8_SCHED;
            PG8_LDB(B0, 1, 0); PG8_LDB(B1, 1, 1); PG8_SCHED; PG8_LDA(At, 1, 0); PG8_STAGE(PG8_SA(0, 1), a2 + hstep, voffA);
            PG8_WAIT_V(8); PG8_WAIT_L(0); PG8_BAR; PG8_MMA(0, 0, At, B0); PG8_MMA(0, 1, At, B1); PG8_BAR; PG8_SCHED;
            PG8_LDA(At, 1, 1); PG8_STAGE(PG8_SB(1, 0), b3, voffB); PG8_STAGE(PG8_SB(1, 1), b3 + hstep, voffB); PG8_STAGE(PG8_SA(1, 0), a3, voffA);
            PG8_WAIT_V(8); PG8_WAIT_L(0); PG8_BAR; PG8_MMA(1, 0, At, B0); PG8_MMA(1, 1, At, B1); PG8_BAR; PG8_SCHED;
            } else {
            PG8_LDB(B0, 0, 0); PG8_SCHED; PG8_LDA(At, 0, 0); PG8_STAGE(PG8_SA(1, 1), a1 + hstep, voffA);
            PG8_WAIT_L(8); PG8_BAR; PG8_WAIT_L(0); PG8_MMA(0, 0, At, B0); PG8_BAR; PG8_SCHED;
            PG8_LDB(B1, 0, 1); PG8_STAGE(PG8_SB(0, 0), b2, voffB);
            PG8_BAR; PG8_WAIT_L(0); PG8_MMA(0, 1, At, B1); PG8_BAR;
            PG8_LDA(At, 0, 1); PG8_STAGE(PG8_SA(0, 0), a2, voffA);
            PG8_BAR; PG8_WAIT_L(0); PG8_MMA(1, 0, At, B0); PG8_BAR; PG8_SCHED;
            PG8_STAGE(PG8_SB(0, 1), b2 + hstep, voffB);
            PG8_WAIT_V(6); PG8_BAR; PG8_MMA(1, 1, At, B1); PG8_BAR;
            PG8_LDB(B0, 1, 0); PG8_SCHED; PG8_LDA(At, 1, 0); PG8_STAGE(PG8_SA(0, 1), a2 + hstep, voffA);
            PG8_WAIT_L(8); PG8_BAR; PG8_WAIT_L(0); PG8_MMA(0, 0, At, B0); PG8_BAR; PG8_SCHED;
            PG8_LDB(B1, 1, 1); PG8_STAGE(PG8_SB(1, 0), b3, voffB);
            PG8_BAR; PG8_WAIT_L(0); PG8_MMA(0, 1, At, B1); PG8_BAR;
            PG8_LDA(At, 1, 1); PG8_STAGE(PG8_SA(1, 0), a3, voffA);
            PG8_BAR; PG8_WAIT_L(0); PG8_MMA(1, 0, At, B0); PG8_BAR; PG8_SCHED;
            PG8_STAGE(PG8_SB(1, 1), b3 + hstep, voffB);
            PG8_WAIT_V(6); PG8_BAR; PG8_MMA(1, 1, At, B1); PG8_BAR;
            }
        }
        if constexpr (ALIGN_EPI) { if (wr == 0) PG8_BAR; }
        if constexpr (!Epi::AFTER_DRAIN) { E(acc, cur, wr, wc, fr, fq); S.done(cur); }
        if (!has_next) break;
#pragma unroll
        for (int a = 0; a < 2; ++a)
#pragma unroll
            for (int b = 0; b < 2; ++b)
#pragma unroll
                for (int m = 0; m < 4; ++m)
#pragma unroll
                    for (int n = 0; n < 2; ++n) acc[a][b][m][n] = (f32x4){0.f, 0.f, 0.f, 0.f};
        cur = nxt; cA = nA; cB = nB; ++ui;
        if constexpr (ALIGN_EPI) { if (wr == 1) PG8_BAR; }
    }
    PG8_WAIT_V(0);
    if constexpr (!ALIGN_EPI) { if (wr == 0) PG8_BAR; }
    PG8_BAR;
    if constexpr (Epi::AFTER_DRAIN) { E.fused(acc, cur, wr, wc, fr, fq, lds, wid, lane); S.done(cur); }
#undef PG8_SA
#undef PG8_SB
#undef PG8_STAGE
#undef PG8_LDA
#undef PG8_LDB
#undef PG8_MMA
#undef PG8_WAIT_V
#undef PG8_WAIT_L
#undef PG8_BAR
#undef PG8_SCHED
}
}

constexpr int NB = 4, SEQ = 4096, DM = 2048, MTOK = NB * SEQ;
constexpr int EV_PITCH = 3584, EV_IN = 3400, OD_PITCH = 6144, DFF = 5632, DFF2 = 11264;
constexpr int C_QA = 0, C_KA = 1024, C_VA = 1280, C_QB = 1536, C_CLAT = 2560, C_QI = 2816, C_KI = 3328, C_WI = 3392;
constexpr float EPS = 1e-6f;
constexpr float SB_CUT = 4.0e-18f;
constexpr size_t MiB = 1u << 20;
constexpr size_t WS_MOD = 0, WS_WUKT = 512 * 1024, WS_WUVT = 1 * MiB, WS_WIN = 2 * MiB, WS_WOUT = 26 * MiB, WS_WUP = 34 * MiB, WS_WDN = 78 * MiB,
                 WS_XN = 100 * MiB, WS_BIG = 164 * MiB, WS_QLAT = 276 * MiB, WS_G = 516 * MiB, WS_ATT = 516 * MiB, WS_CKV = 580 * MiB,
                 WS_IDX = 588 * MiB, WS_CNT = 604 * MiB, WS_END = 692 * MiB;
constexpr int LDS_BYTES = 156672;
#ifndef DIAG
#define DIAG 0
#endif
#ifndef DUP_UP
#define DUP_UP 0
#endif
#ifndef DUP_CONV
#define DUP_CONV 0
#endif
#ifndef DUP_P3
#define DUP_P3 0
#endif
#ifndef DUP_IDX
#define DUP_IDX 0
#endif
#ifndef SKIP_SWA
#define SKIP_SWA 0
#endif
#ifndef SKIP_DSA
#define SKIP_DSA 0
#endif
#ifndef SKIP_SB
#define SKIP_SB 0
#endif

typedef unsigned short bf16_t;
typedef short bf16x8 __attribute__((ext_vector_type(8)));
typedef float f32x4 __attribute__((ext_vector_type(4)));
typedef unsigned u32x4 __attribute__((ext_vector_type(4)));
typedef unsigned u32x2 __attribute__((ext_vector_type(2)));
#define LAS __attribute__((address_space(3)))
#define MFMA16(a, b, c) __builtin_amdgcn_mfma_f32_16x16x32_bf16((a), (b), (c), 0, 0, 0)

typedef float f32x2_t __attribute__((ext_vector_type(2))); typedef __bf16 bf16x2_t __attribute__((ext_vector_type(2)));
__device__ __forceinline__ unsigned pk2(float lo, float hi) { f32x2_t v = {lo, hi}; bf16x2_t b = __builtin_convertvector(v, bf16x2_t); return __builtin_bit_cast(unsigned, b); }
__device__ __forceinline__ float bflo(unsigned w) { return __uint_as_float(w << 16); }
__device__ __forceinline__ float bfhi(unsigned w) { return __uint_as_float(w & 0xffff0000u); }
__device__ __forceinline__ float wave_sum(float v) {
#pragma unroll
    for (int o = 1; o < 64; o <<= 1) v += __shfl_xor(v, o);
    return v;
}
__device__ __forceinline__ int wave_sum_i(int v) {
#pragma unroll
    for (int o = 1; o < 64; o <<= 1) v += __shfl_xor(v, o);
    return v;
}
__device__ __forceinline__ int t5_bucket(int rel) {
    const int n = rel < 0 ? -rel : rel; int v = n;
    if (n >= 8) v = 8 + (n >= 12) + (n >= 16) + (n >= 23) + (n >= 32) + (n >= 46) + (n >= 64) + (n >= 91);
    return (rel > 0 ? 16 : 0) + v;
}
typedef short s16x4_t __attribute__((ext_vector_type(4)));
__device__ __forceinline__ s16x4_t lds_tr4(const LAS bf16_t* p) { return __builtin_bit_cast(s16x4_t, __builtin_amdgcn_ds_read_tr16_b64_v4i16((LAS s16x4_t*)p)); }
__device__ __forceinline__ bf16x8 mk8(unsigned a, unsigned b, unsigned c, unsigned d) { u32x4 w; w.x = a; w.y = b; w.z = c; w.w = d; return __builtin_bit_cast(bf16x8, w); }

struct Args { const float* in[20]; float* out; unsigned char* ws; };

template <int ROWMAP> __device__ __forceinline__ void transpose_item(const float* W, int K, int N, bf16_t* WT, LAS float* scr, int item, int nblk, int lane) {
    const int kb = item / nblk, nb = item % nblk, k0 = 64 * kb, n0 = 64 * nb; const int nc = n0 + lane;
    float v[64];
#pragma unroll
    for (int i = 0; i < 64; ++i) v[i] = (nc < N) ? W[(size_t)(k0 + i) * N + nc] : 0.f;
#pragma unroll
    for (int i = 0; i < 64; ++i) scr[i * 65 + lane] = v[i];
    asm volatile("s_waitcnt lgkmcnt(0)" ::: "memory");
    const int c = lane & 7;
#pragma unroll
    for (int j = 0; j < 8; ++j) { const int n = (lane >> 3) + 8 * j; const LAS float* s = scr + (8 * c) * 65 + n;
        u32x4 o; o.x = pk2(s[0 * 65], s[1 * 65]); o.y = pk2(s[2 * 65], s[3 * 65]); o.z = pk2(s[4 * 65], s[5 * 65]); o.w = pk2(s[6 * 65], s[7 * 65]);
        int d = n0 + n; if (ROWMAP) { const int sc_ = d < DFF ? d : d - DFF; d = (sc_ >> 7) * 256 + (d < DFF ? 0 : 128) + (sc_ & 127); }
        *(u32x4*)(WT + (size_t)d * K + k0 + 8 * c) = o; }
    asm volatile("s_waitcnt lgkmcnt(0)" ::: "memory");
}
template <int ROWMAP = 0> __device__ __forceinline__ void convert_matrix(const float* W, int K, int N, int Npad, bf16_t* WT, LAS float* scr, int gw, int NGW, int lane) {
    const int nblk = Npad / 64, nitems = (K / 64) * nblk;
    for (int it = gw; it < nitems; it += NGW) transpose_item<ROWMAP>(W, K, N, WT, scr, it, nblk, lane);
}

__device__ __forceinline__ void norm_mod_phase(const float* xin, const float* g, const float* modl, int sh_off, int sc_off, bf16_t* XN, int gw, int NGW, int lane) {
    for (int row = gw; row < MTOK; row += 2 * NGW) {
        const int row2 = row + NGW;
        const f32x4* xr = (const f32x4*)(xin + (size_t)row * DM) + lane; const f32x4* xr2 = (const f32x4*)(xin + (size_t)row2 * DM) + lane;
        f32x4 v[8], v2[8]; float ss = 0.f, ss2 = 0.f;
#pragma unroll
        for (int j = 0; j < 8; ++j) { v[j] = xr[64 * j]; v2[j] = xr2[64 * j]; }
#pragma unroll
        for (int j = 0; j < 8; ++j) { ss += (v[j].x * v[j].x + v[j].y * v[j].y) + (v[j].z * v[j].z + v[j].w * v[j].w); ss2 += (v2[j].x * v2[j].x + v2[j].y * v2[j].y) + (v2[j].z * v2[j].z + v2[j].w * v2[j].w); }
        ss = wave_sum(ss); ss2 = wave_sum(ss2);
        const float r = rsqrtf(ss * (1.f / DM) + EPS), r2 = rsqrtf(ss2 * (1.f / DM) + EPS);
        const float* mb = modl + (size_t)(row >> 12) * 12288; const float* mb2 = modl + (size_t)(row2 >> 12) * 12288;
#pragma unroll
        for (int j = 0; j < 8; ++j) { const int col = 4 * (64 * j + lane);
            const f32x4 g4 = *(const f32x4*)(g + col);
            { const f32x4 sc = *(const f32x4*)(mb + sc_off + col), sh = *(const f32x4*)(mb + sh_off + col);
              const f32x4 y = v[j] * r * g4; const f32x4 h = y * (sc + 1.f) + sh;
              u32x2 w; w.x = pk2(h.x, h.y); w.y = pk2(h.z, h.w); *(u32x2*)(XN + (size_t)row * DM + col) = w; }
            { const f32x4 sc = *(const f32x4*)(mb2 + sc_off + col), sh = *(const f32x4*)(mb2 + sh_off + col);
              const f32x4 y = v2[j] * r2 * g4; const f32x4 h = y * (sc + 1.f) + sh;
              u32x2 w; w.x = pk2(h.x, h.y); w.y = pk2(h.z, h.w); *(u32x2*)(XN + (size_t)row2 * DM + col) = w; } }
    }
}

__device__ __forceinline__ void conv_gate_phase(const bf16_t* U, const float* cw, const float* cb, bf16_t* Gout, int G, int tid) {
    for (int item = blockIdx.x * 512 + tid; item < 1024 * 704; item += G * 512) {
        const int cg8 = item % 704, run = item / 704; const int row0 = run * 16, c0 = cg8 * 8; const bool first = (row0 & 4095) == 0;
        float wg[3][8], wv[3][8], bg[8], bv[8];
#pragma unroll
        for (int j = 0; j < 3; ++j) {
            const f32x4 a0 = *(const f32x4*)(cw + j * DFF2 + c0), a1 = *(const f32x4*)(cw + j * DFF2 + c0 + 4);
            const f32x4 b0 = *(const f32x4*)(cw + j * DFF2 + DFF + c0), b1 = *(const f32x4*)(cw + j * DFF2 + DFF + c0 + 4);
#pragma unroll
            for (int e = 0; e < 4; ++e) { wg[j][e] = a0[e]; wg[j][4 + e] = a1[e]; wv[j][e] = b0[e]; wv[j][4 + e] = b1[e]; }
        }
        { const f32x4 a0 = *(const f32x4*)(cb + c0), a1 = *(const f32x4*)(cb + c0 + 4), b0 = *(const f32x4*)(cb + DFF + c0), b1 = *(const f32x4*)(cb + DFF + c0 + 4);
#pragma unroll
          for (int e = 0; e < 4; ++e) { bg[e] = a0[e]; bg[4 + e] = a1[e]; bv[e] = b0[e]; bv[4 + e] = b1[e]; } }
        float g2[8], g1[8], v2[8], v1[8];
#pragma unroll
        for (int e = 0; e < 8; ++e) { g2[e] = 0.f; g1[e] = 0.f; v2[e] = 0.f; v1[e] = 0.f; }
        if (!first) {
            const u32x4 a = *(const u32x4*)(U + (size_t)(row0 - 2) * DFF2 + c0), b = *(const u32x4*)(U + (size_t)(row0 - 2) * DFF2 + DFF + c0);
            const u32x4 c = *(const u32x4*)(U + (size_t)(row0 - 1) * DFF2 + c0), d = *(const u32x4*)(U + (size_t)(row0 - 1) * DFF2 + DFF + c0);
#pragma unroll
            for (int e = 0; e < 4; ++e) { g2[2 * e] = bflo(a[e]); g2[2 * e + 1] = bfhi(a[e]); v2[2 * e] = bflo(b[e]); v2[2 * e + 1] = bfhi(b[e]);
                                          g1[2 * e] = bflo(c[e]); g1[2 * e + 1] = bfhi(c[e]); v1[2 * e] = bflo(d[e]); v1[2 * e + 1] = bfhi(d[e]); }
        }
#pragma unroll 8
        for (int t = 0; t < 16; ++t) {
            const u32x4 a = *(const u32x4*)(U + (size_t)(row0 + t) * DFF2 + c0), b = *(const u32x4*)(U + (size_t)(row0 + t) * DFF2 + DFF + c0);
            float gc[8], vc[8], r[8];
#pragma unroll
            for (int e = 0; e < 4; ++e) { gc[2 * e] = bflo(a[e]); gc[2 * e + 1] = bfhi(a[e]); vc[2 * e] = bflo(b[e]); vc[2 * e + 1] = bfhi(b[e]); }
#pragma unroll
            for (int e = 0; e < 8; ++e) {
                const float gg = wg[0][e] * g2[e] + wg[1][e] * g1[e] + wg[2][e] * gc[e] + bg[e];
                const float vv = wv[0][e] * v2[e] + wv[1][e] * v1[e] + wv[2][e] * vc[e] + bv[e];
                r[e] = gg / (1.f + __expf(-gg)) * vv;
                g2[e] = g1[e]; g1[e] = gc[e]; v2[e] = v1[e]; v1[e] = vc[e];
            }
            u32x4 o; o.x = pk2(r[0], r[1]); o.y = pk2(r[2], r[3]); o.z = pk2(r[4], r[5]); o.w = pk2(r[6], r[7]);
            *(u32x4*)(Gout + (size_t)(row0 + t) * DFF + c0) = o;
        }
    }
}

#define XB_TMO      128
#define XB_XCNT(j)  (256  + 64 * (j))
#define XB_XSUB(j)  (1280 + 64 * (j))
#define XB_XGEN(j)  (2304 + 64 * (j))
#define XB_TOP      3328
#define XB_TOPGEN   3392
#define XCD_BAR_WORDS 3456
#define XB_SPIN_CAP (1u << 18)

__device__ __forceinline__ unsigned xb_ld(unsigned* p)              { return __hip_atomic_load(p, __ATOMIC_RELAXED, __HIP_MEMORY_SCOPE_AGENT); }
__device__ __forceinline__ unsigned xb_add(unsigned* p, unsigned v) { return __hip_atomic_fetch_add(p, v, __ATOMIC_RELAXED, __HIP_MEMORY_SCOPE_AGENT); }
__device__ __forceinline__ unsigned xb_xcc_id() { return (unsigned)__builtin_amdgcn_s_getreg((3 << 11) | 20) & 0xFu; }
#define XB_SPIN(cond, bar) do { unsigned _sp = 0; while (cond) { __builtin_amdgcn_s_sleep(1); \
    if ((++_sp & 255u) == 0u) { if (xb_ld(&(bar)[XB_TMO])) break; if (_sp > XB_SPIN_CAP) { atomicAdd(&(bar)[XB_TMO], 1u); break; } } } } while (0)

struct XcdBarrier {
    unsigned* bar; unsigned x;
    volatile LAS unsigned* st;
};

__device__ __forceinline__ XcdBarrier xcd_barrier_post(unsigned* bar, volatile LAS unsigned* st) {
    XcdBarrier b; b.bar = bar; b.x = (unsigned)__builtin_amdgcn_readfirstlane((int)xb_xcc_id()); b.st = st;
    if (threadIdx.x == 0) (void)xb_add(&bar[XB_XCNT(b.x)], 1u);
    return b;
}
__device__ __forceinline__ void xcd_barrier_complete(unsigned* bar, unsigned x, unsigned& nloc, unsigned& nx) {
    const unsigned G = gridDim.x * gridDim.y * gridDim.z;
    unsigned sum, cnt, mine, sp = 0u;
    for (;;) {
        sum = 0u; cnt = 0u; mine = 0u;
#pragma unroll
        for (unsigned j = 0; j < 16; ++j) { const unsigned c = xb_ld(&bar[XB_XCNT(j)]); sum += c; cnt += (c > 0u) ? 1u : 0u; mine = (j == x) ? c : mine; }
        if (sum == G) break;
        __builtin_amdgcn_s_sleep(1);
        if ((++sp & 255u) == 0u) { if (xb_ld(&bar[XB_TMO])) break; if (sp > XB_SPIN_CAP) { atomicAdd(&bar[XB_TMO], 1u); break; } }
    }
    nloc = mine > 0u ? mine : 1u; nx = cnt > 0u ? cnt : 1u;
}

__device__ __forceinline__ void xcd_barrier(const XcdBarrier& b) {
    asm volatile("s_waitcnt vmcnt(0)" ::: "memory");
    __syncthreads();
    if (threadIdx.x == 0) {
        unsigned* bar = b.bar;
        __builtin_amdgcn_s_waitcnt(0);
        unsigned nloc = b.st[0], nx = b.st[1];
        if (nloc == 0u) { xcd_barrier_complete(bar, b.x, nloc, nx); b.st[0] = nloc; b.st[1] = nx; }
        const unsigned old = xb_add(&bar[XB_XSUB(b.x)], 1u);
        const unsigned gen = old / nloc;
        if (old + 1u == (gen + 1u) * nloc) {
            __builtin_amdgcn_fence(__ATOMIC_RELEASE, "agent");
            asm volatile("s_waitcnt vmcnt(0)" ::: "memory");
            const unsigned og = xb_add(&bar[XB_TOP], 1u);
            const unsigned tg = og / nx;
            if (og + 1u == (tg + 1u) * nx) xb_add(&bar[XB_TOPGEN], 1u);
            else XB_SPIN(xb_ld(&bar[XB_TOPGEN]) == tg, bar);
            __builtin_amdgcn_fence(__ATOMIC_ACQUIRE, "agent");
            xb_add(&bar[XB_XGEN(b.x)], 1u);
            asm volatile("s_waitcnt vmcnt(0)" ::: "memory");
        } else {
            XB_SPIN(xb_ld(&bar[XB_XGEN(b.x)]) == gen, bar);
            __builtin_amdgcn_fence(__ATOMIC_ACQUIRE, "agent");
            asm volatile("s_waitcnt vmcnt(0)" ::: "memory");
        }
    }
    __syncthreads();
}

__global__ void __launch_bounds__(512, 2) mega_fwd(Args a) {
    extern __shared__ __attribute__((aligned(16))) unsigned char lds[];
    cg::grid_group grid = cg::this_grid();
    LAS unsigned char* L = (LAS unsigned char*)lds;
    const int G = gridDim.x, NGW = G * 8;
    { LAS unsigned* mz = (LAS unsigned*)(L + 155648); if (threadIdx.x < 16) mz[threadIdx.x] = 0u; }
    if (blockIdx.x == 0 && threadIdx.x < 64) { unsigned* bw = (unsigned*)(a.ws + 458752);
        for (int i = threadIdx.x; i < 4096; i += 64) __hip_atomic_store(bw + i, 0u, __ATOMIC_RELAXED, __HIP_MEMORY_SCOPE_AGENT);
        __builtin_amdgcn_fence(__ATOMIC_RELEASE, "agent"); asm volatile("s_waitcnt vmcnt(0)" ::: "memory"); }
    __syncthreads();
    grid.sync();
    const XcdBarrier xbar = xcd_barrier_post((unsigned*)(a.ws + 458752), (volatile LAS unsigned*)(L + 155648));
#if DIAG
    unsigned long long* TS = (unsigned long long*)(a.ws + 460800); int ts_n = 0;
#define TSTAMP() do { if (blockIdx.x == 0 && threadIdx.x == 0) TS[ts_n] = __builtin_amdgcn_s_memrealtime(); ++ts_n; } while (0)
#else
#define TSTAMP() do { } while (0)
#endif
#define GSYNC() do { XcdBarrier xb2_; xb2_.bar = (unsigned*)(a.ws + 458752); { unsigned xx_ = xbar.x; asm volatile("" : "+s"(xx_)); xb2_.x = xx_; } xb2_.st = (volatile LAS unsigned*)(L + 155648); xcd_barrier(xb2_); TSTAMP(); } while (0)
#define IDS int tid = threadIdx.x; asm volatile("" : "+v"(tid)); const int lane = tid & 63, wave = __builtin_amdgcn_readfirstlane(tid >> 6), fr = lane & 15, fq = lane >> 4; const int gw = blockIdx.x * 8 + wave; (void)fr; (void)fq; (void)gw; (void)lane; \
            LAS float* scr = (LAS float*)(L + wave * 16640); (void)scr;
    unsigned char* ws = a.ws;
    float* MOD = (float*)(ws + WS_MOD);
    bf16_t* WUKT = (bf16_t*)(ws + WS_WUKT); bf16_t* WUVT = (bf16_t*)(ws + WS_WUVT);
    bf16_t* WIN = (bf16_t*)(ws + WS_WIN); bf16_t* WOUT = (bf16_t*)(ws + WS_WOUT); bf16_t* WUP = (bf16_t*)(ws + WS_WUP); bf16_t* WDN = (bf16_t*)(ws + WS_WDN);
    bf16_t* XN = (bf16_t*)(ws + WS_XN); bf16_t* PROJ = (bf16_t*)(ws + WS_BIG); bf16_t* UB = (bf16_t*)(ws + WS_BIG); bf16_t* QLAT = (bf16_t*)(ws + WS_QLAT);
    bf16_t* GB = (bf16_t*)(ws + WS_G); bf16_t* ATT = (bf16_t*)(ws + WS_ATT); bf16_t* CKV = (bf16_t*)(ws + WS_CKV);
    int* IDX = (int*)(ws + WS_IDX); int* CNT = (int*)(ws + WS_CNT); float* HBUF = (float*)(ws + WS_BIG); bf16_t* KIC = (bf16_t*)(ws + WS_CNT + MiB);
    const float* x_in = a.in[0]; const float* rel_bias = a.in[2];
    float* xres = a.out;

    TSTAMP();
    {
        IDS
        LAS float* cs = (LAS float*)L; LAS float* red = cs + 8192;
        for (int it = blockIdx.x; it < 256; it += G) {
            const int i = it >> 7, jc = it & 127;
            for (int idx = tid; idx < 8192; idx += 512) { const float v = a.in[1][idx]; cs[idx] = v / (1.f + expf(-v)); }
            __syncthreads();
            if (tid < 384) {
                const int cq = tid % 24, kg = tid / 24;
                const float* w = a.in[3] + (size_t)i * 2048 * 12288 + jc * 96 + cq * 4;
                f32x4 ac[4];
#pragma unroll
                for (int b = 0; b < 4; ++b) ac[b] = (f32x4){0.f, 0.f, 0.f, 0.f};
#pragma unroll 8
                for (int kk = 0; kk < 128; ++kk) { const int k = kg * 128 + kk; const f32x4 wv = *(const f32x4*)(w + (size_t)k * 12288);
#pragma unroll
                    for (int b = 0; b < 4; ++b) ac[b] += wv * cs[b * 2048 + k]; }
#pragma unroll
                for (int b = 0; b < 4; ++b) *(LAS f32x4*)(red + (kg * 4 + b) * 96 + cq * 4) = ac[b];
            }
            __syncthreads();
            if (tid < 384) { const int b = tid / 96, col = tid % 96; float s = a.in[4][i * 12288 + jc * 96 + col];
#pragma unroll
              for (int k2 = 0; k2 < 16; ++k2) s += red[(k2 * 4 + b) * 96 + col];
              MOD[(size_t)(i * 4 + b) * 12288 + jc * 96 + col] = s; }
            __syncthreads();
        }
        convert_matrix(a.in[7], 2048, EV_IN, EV_PITCH, WIN, scr, gw, NGW, lane);
        convert_matrix(a.in[12], 2048, 2048, 2048, WOUT, scr, gw, NGW, lane);
        convert_matrix<1>(a.in[15], 2048, DFF2, DFF2, WUP, scr, gw, NGW, lane);
        convert_matrix(a.in[18], DFF, 2048, 2048, WDN, scr, gw, NGW, lane);
        for (int h = 0; h < 16; ++h) {
            convert_matrix(a.in[9] + (size_t)h * 64 * 256, 64, 256, 256, WUKT + (size_t)h * 256 * 64, scr, gw, NGW, lane);
            convert_matrix(a.in[10] + (size_t)h * 256 * 64, 256, 64, 64, WUVT + (size_t)h * 64 * 256, scr, gw, NGW, lane);
        }
    }
    GSYNC();

#pragma unroll
    for (int layer = 0; layer < 2; ++layer) {
        const float* modl = MOD + (size_t)layer * 4 * 12288;
        const float* xcur = (layer == 0) ? x_in : (const float*)xres;
        { IDS
        norm_mod_phase(xcur, a.in[5] + layer * DM, modl, 0, 2048, XN, gw, NGW, lane);
        if (layer == 1) {
            convert_matrix(a.in[13], 2048, OD_PITCH, OD_PITCH, WIN, scr, gw, NGW, lane);
            convert_matrix(a.in[14], 2048, 2048, 2048, WOUT, scr, gw, NGW, lane);
            convert_matrix<1>(a.in[15] + (size_t)2048 * DFF2, 2048, DFF2, DFF2, WUP, scr, gw, NGW, lane);
            convert_matrix(a.in[18] + (size_t)DFF * 2048, DFF, 2048, 2048, WDN, scr, gw, NGW, lane);
        } }
        GSYNC();
#if SKIP_SWA || SKIP_DSA || SKIP_SB
        { IDS for (size_t i = (size_t)blockIdx.x * 512 + tid; i < (size_t)MTOK * DM / 8; i += (size_t)G * 512) ((u32x4*)ATT)[i] = (u32x4){0u, 0u, 0u, 0u}; }
#endif
        if (layer == 0) {
            { pg8::Gemm g{XN, WIN, MTOK, EV_PITCH, 2048}; pg8::StaticOrder S; S.init(MTOK, EV_PITCH, G, (int)blockIdx.x);
              pg8::EpiBf16 E{PROJ, EV_PITCH, KIC, C_KI / 256};
              pg8::gemm_phase<pg8::EpiBf16, pg8::StaticOrder, true, true>(L, g, S, E); }
            GSYNC();
            { IDS
            for (int row = gw; row < MTOK; row += 4 * NGW) {
                u32x2 w[4]; float ss[4];
#pragma unroll
                for (int q = 0; q < 4; ++q) w[q] = *(const u32x2*)(PROJ + (size_t)(row + q * NGW) * EV_PITCH + C_CLAT + 4 * lane);
                const f32x4 g4 = *(const f32x4*)(a.in[8] + 4 * lane);
#pragma unroll
                for (int q = 0; q < 4; ++q) { const float x0 = bflo(w[q].x), x1 = bfhi(w[q].x), x2 = bflo(w[q].y), x3 = bfhi(w[q].y); ss[q] = (x0 * x0 + x1 * x1) + (x2 * x2 + x3 * x3); }
#pragma unroll
                for (int o_ = 1; o_ < 64; o_ <<= 1) {
#pragma unroll
                    for (int q = 0; q < 4; ++q) ss[q] += __shfl_xor(ss[q], o_); }
#pragma unroll
                for (int q = 0; q < 4; ++q) { const float x0 = bflo(w[q].x), x1 = bfhi(w[q].x), x2 = bflo(w[q].y), x3 = bfhi(w[q].y);
                    const float r = rsqrtf(ss[q] * (1.f / 256.f) + EPS);
                    u32x2 o; o.x = pk2(x0 * r * g4.x, x1 * r * g4.y); o.y = pk2(x2 * r * g4.z, x3 * r * g4.w);
                    *(u32x2*)(CKV + (size_t)(row + q * NGW) * 256 + 4 * lane) = o; }
            } }
            { IDS
            for (int unit = gw; unit < 16384; unit += NGW) {
                const int h = unit & 15, t0 = (unit >> 4) * 16;
                bf16x8 bq[2];
#pragma unroll
                for (int ks = 0; ks < 2; ++ks) bq[ks] = *(const bf16x8*)(PROJ + (size_t)(t0 + fr) * EV_PITCH + C_QB + h * 64 + 32 * ks + 8 * fq);
#pragma unroll
                for (int rg = 0; rg < 2; ++rg) {
                    bf16x8 aw[8][2];
#pragma unroll
                    for (int r8 = 0; r8 < 8; ++r8)
#pragma unroll
                        for (int ks = 0; ks < 2; ++ks) aw[r8][ks] = *(const bf16x8*)(WUKT + (size_t)(h * 256 + 16 * (8 * rg + r8) + fr) * 64 + 32 * ks + 8 * fq);
#pragma unroll
                    for (int r8 = 0; r8 < 8; ++r8) { const int rt = 8 * rg + r8;
                        f32x4 acc = (f32x4){0.f, 0.f, 0.f, 0.f};
                        acc = MFMA16(aw[r8][0], bq[0], acc); acc = MFMA16(aw[r8][1], bq[1], acc);
                        u32x2 o; o.x = pk2(acc[0] * 0.125f, acc[1] * 0.125f); o.y = pk2(acc[2] * 0.125f, acc[3] * 0.125f);
                        *(u32x2*)(QLAT + ((size_t)(t0 + fr) * 16 + h) * 256 + 16 * rt + 4 * fq) = o; }
                }
            } }
#if !SKIP_DSA
            {
                IDS
                LAS float* sc = (LAS float*)L;
                __syncthreads();
                for (int uu = blockIdx.x; uu < 2048; uu += G) {
                    const int kk = uu / G, bi = uu - kk * G;
                    const int unit = (G == 256) ? ((kk >> 1) * 512 + ((kk & 1) ? 511 - bi : bi)) : uu;
                    const int row0 = unit * 8, b = row0 >> 12, c = (row0 & 4095) >> 6, nall = (c + 1) * 64;
                    const int row = row0 + wave;
                    int* idxp = IDX + (size_t)row * 256;
                    if (nall <= 256) { for (int i = lane; i < nall; i += 64) idxp[i] = i; if (lane == 0) CNT[row] = nall; continue; }
                    const int nquads = c + 1, ntiles = nall >> 4;
                    bf16x8 qa[4][2];
#pragma unroll
                    for (int hp = 0; hp < 4; ++hp)
#pragma unroll
                        for (int ks = 0; ks < 2; ++ks) qa[hp][ks] = *(const bf16x8*)(PROJ + (size_t)(row0 + (fr & 7)) * EV_PITCH + C_QI + (2 * hp + (fr >> 3)) * 64 + 32 * ks + 8 * fq);
                    float wq[4][4];
#pragma unroll
                    for (int j = 0; j < 4; ++j) { const u32x4 ww = *(const u32x4*)(PROJ + (size_t)(row0 + 4 * (fq & 1) + j) * EV_PITCH + C_WI);
#pragma unroll
                        for (int hp = 0; hp < 4; ++hp) wq[hp][j] = (fq >> 1) ? bfhi(ww[hp]) : bflo(ww[hp]); }
                    const bf16_t* kbase = KIC + ((size_t)b * SEQ + fr) * 64 + 8 * fq;
#pragma unroll 8
                    for (int t = wave; t < ntiles; t += 8) {
                        const bf16_t* kp = kbase + (size_t)(16 * t) * 64;
                        const bf16x8 b0 = *(const bf16x8*)kp, b1 = *(const bf16x8*)(kp + 32);
                        float part[4] = {0.f, 0.f, 0.f, 0.f};
#pragma unroll
                        for (int hp = 0; hp < 4; ++hp) {
                            f32x4 acc = (f32x4){0.f, 0.f, 0.f, 0.f};
                            acc = MFMA16(qa[hp][0], b0, acc); acc = MFMA16(qa[hp][1], b1, acc);
#pragma unroll
                            for (int j = 0; j < 4; ++j) part[j] += wq[hp][j] * fmaxf(acc[j], 0.f);
                        }
#pragma unroll
                        for (int j = 0; j < 4; ++j) part[j] += __shfl_xor(part[j], 32);
                        if (fq < 2) {
#pragma unroll
                            for (int j = 0; j < 4; ++j) sc[(4 * fq + j) * 4096 + 16 * t + fr] = part[j];
                        }
                    }
                    __syncthreads();
                    unsigned v[64];
#pragma unroll
                    for (int q = 0; q < 64; ++q) {
                        unsigned val = 0u;
                        if (q < nquads) { unsigned u = __float_as_uint(sc[wave * 4096 + 64 * q + lane]); if (u == 0x80000000u) u = 0u; val = (u & 0x80000000u) ? ~u : (u | 0x80000000u); }
                        v[q] = val;
                    }
                    unsigned T = 0u;
                    for (int bit = 31; bit >= 0; --bit) {
                        const unsigned cand = T | (1u << bit); int cnt = 0;
#pragma unroll
                        for (int qg = 0; qg < 4; ++qg) {
                            if (16 * qg < nquads) {
#pragma unroll
                                for (int q = 16 * qg; q < 16 * qg + 16; ++q) cnt += __popcll(__ballot(v[q] >= cand));
                            }
                        }
                        if (cnt >= 256) T = cand;
                        if (cnt == 256) break;
                    }
                    int cgt = 0;
#pragma unroll
                    for (int q = 0; q < 64; ++q) cgt += __popcll(__ballot(v[q] > T));
                    int need = 256 - cgt, pos = 0;
                    const unsigned long long ltmask = (1ull << lane) - 1ull;
#pragma unroll
                    for (int q = 0; q < 64; ++q) {
                        if (q < nquads) {
                            const bool gt = v[q] > T, eq = v[q] == T;
                            const unsigned long long meq = __ballot(eq);
                            const int eqrank = __popcll(meq & ltmask);
                            const bool sel = gt || (eq && eqrank < need);
                            const unsigned long long msel = __ballot(sel);
                            if (sel) idxp[pos + __popcll(msel & ltmask)] = q * 64 + lane;
                            pos += __popcll(msel);
                            const int neq = __popcll(meq); need -= (neq < need ? neq : need);
                        }
                    }
                    if (lane == 0) CNT[row] = 256;
                    __syncthreads();
                }
            }
#endif
#if !SKIP_SWA
            {
                IDS
                LAS bf16_t* Vt = (LAS bf16_t*)L;
                LAS float* bT = (LAS float*)(L + 64 * 200 * 2);
                LAS bf16_t* Kl = (LAS bf16_t*)(L + 64 * 200 * 2 + 4096);
                __syncthreads();
                { const int kvh0 = blockIdx.x & 3;
                  for (int idx = tid; idx < 1024; idx += 512) { const int g = idx >> 8, ri = idx & 255; bT[idx] = rel_bias[t5_bucket(ri - 191) * 32 + kvh0 * 4 + g]; } }
                for (int unit = blockIdx.x; unit < 1024; unit += G) {
                    const int b = unit >> 8, c = (unit >> 2) & 63, kvh = unit & 3;
                    const int kstart = (c >= 2 ? c - 2 : 0) * 64, nk = (c + 1) * 64 - kstart;
                    const size_t rowbase = (size_t)b * SEQ;
                    bf16x8 bq0[2], bq1[2];
                    { const int g_ = wave >> 1, qh_ = wave & 1, head_ = kvh * 4 + g_, q0_ = c * 64 + qh_ * 32;
#pragma unroll
                      for (int ks = 0; ks < 2; ++ks) { bq0[ks] = *(const bf16x8*)(PROJ + (rowbase + q0_ + fr) * EV_PITCH + C_QA + head_ * 64 + 32 * ks + 8 * fq);
                                                       bq1[ks] = *(const bf16x8*)(PROJ + (rowbase + q0_ + 16 + fr) * EV_PITCH + C_QA + head_ * 64 + 32 * ks + 8 * fq); } }
                    { u32x4 kx[3], vx[3];
#pragma unroll
                      for (int it = 0; it < 3; ++it) { const int i = tid + 512 * it; int key = i >> 3; const int ch = i & 7; key = key < nk ? key : nk - 1;
                          const bf16_t* src = PROJ + (rowbase + kstart + key) * EV_PITCH + kvh * 64 + ch * 8;
                          kx[it] = *(const u32x4*)(src + C_KA); vx[it] = *(const u32x4*)(src + C_VA); }
#pragma unroll
                      for (int it = 0; it < 3; ++it) { const int i = tid + 512 * it; const int key = i >> 3, ch = i & 7;
                          *(LAS u32x4*)(Kl + key * 72 + ch * 8) = kx[it];
                          const u32x4 w = vx[it]; LAS bf16_t* vp = Vt + (ch * 8) * 200 + key;
                          vp[0 * 200] = (bf16_t)(w.x & 0xffffu); vp[1 * 200] = (bf16_t)(w.x >> 16); vp[2 * 200] = (bf16_t)(w.y & 0xffffu); vp[3 * 200] = (bf16_t)(w.y >> 16);
                          vp[4 * 200] = (bf16_t)(w.z & 0xffffu); vp[5 * 200] = (bf16_t)(w.z >> 16); vp[6 * 200] = (bf16_t)(w.w & 0xffffu); vp[7 * 200] = (bf16_t)(w.w >> 16); } }
                    __syncthreads();
                    const int g = wave >> 1, qh = wave & 1, head = kvh * 4 + g, q0 = c * 64 + qh * 32;
                    const int ntile = nk >> 4;
                    const float sink = a.in[11][head];
#pragma unroll 1
                    for (int m = 0; m < 2; ++m) {
                        const int qpos = q0 + 16 * m + fr;
                        bf16x8 bq[2];
#pragma unroll
                        for (int ks = 0; ks < 2; ++ks) bq[ks] = m ? bq1[ks] : bq0[ks];
                        f32x4 s1[12];
                        float mx = -1e30f;
#pragma unroll
                        for (int t = 0; t < 12; ++t) {
                            if (t < ntile) {
                                const LAS bf16_t* kp = Kl + (16 * t + fr) * 72 + 8 * fq;
                                const bf16x8 k0 = *(const LAS bf16x8*)kp, k1 = *(const LAS bf16x8*)(kp + 32);
                                f32x4 acc = (f32x4){0.f, 0.f, 0.f, 0.f}; acc = MFMA16(k0, bq[0], acc); acc = MFMA16(k1, bq[1], acc);
#pragma unroll
                                for (int j = 0; j < 4; ++j) { const int ri = (kstart + 16 * t + 4 * fq + j) - qpos + 191; const float vv = acc[j] * 0.125f + bT[g * 256 + ri]; acc[j] = vv; mx = fmaxf(mx, vv); }
                                s1[t] = acc;
                            } else s1[t] = (f32x4){0.f, 0.f, 0.f, 0.f};
                        }
                        mx = fmaxf(mx, __shfl_xor(mx, 16)); mx = fmaxf(mx, __shfl_xor(mx, 32)); mx = fmaxf(mx, sink);
                        float sum = 0.f;
#pragma unroll
                        for (int t = 0; t < 12; ++t)
                            if (t < ntile) {
#pragma unroll
                                for (int j = 0; j < 4; ++j) { const float p = __expf(s1[t][j] - mx); s1[t][j] = p; sum += p; }
                            }
                        sum += __shfl_xor(sum, 16); sum += __shfl_xor(sum, 32);
                        const float inv = 1.f / (sum + __expf(sink - mx));
                        f32x4 o[4];
#pragma unroll
                        for (int dt = 0; dt < 4; ++dt) o[dt] = (f32x4){0.f, 0.f, 0.f, 0.f};
#pragma unroll
                        for (int st = 0; st < 6; ++st) {
                            if (2 * st < ntile) {
                                const bf16x8 pb = mk8(pk2(s1[2 * st][0], s1[2 * st][1]), pk2(s1[2 * st][2], s1[2 * st][3]), pk2(s1[2 * st + 1][0], s1[2 * st + 1][1]), pk2(s1[2 * st + 1][2], s1[2 * st + 1][3]));
#pragma unroll
                                for (int dt = 0; dt < 4; ++dt) {
                                    const LAS bf16_t* vp = Vt + (16 * dt + fr) * 200 + 32 * st + 4 * fq;
                                    const u32x2 lo = *(const LAS u32x2*)vp, hi = *(const LAS u32x2*)(vp + 16);
                                    o[dt] = MFMA16(mk8(lo.x, lo.y, hi.x, hi.y), pb, o[dt]);
                                }
                            }
                        }
#pragma unroll
                        for (int dt = 0; dt < 4; ++dt) { u32x2 w; w.x = pk2(o[dt][0] * inv, o[dt][1] * inv); w.y = pk2(o[dt][2] * inv, o[dt][3] * inv);
                            *(u32x2*)(ATT + (rowbase + qpos) * DM + head * 64 + 16 * dt + 4 * fq) = w; }
                    }
                    __syncthreads();
                }
            }
#endif
                        GSYNC();
#if !SKIP_DSA
            {
                IDS
                LAS float* bB = (LAS float*)(L + 8 * 16896);
                if (tid < 512) bB[tid] = rel_bias[(tid >> 4) * 32 + 16 + (tid & 15)];
                __syncthreads();
                LAS bf16_t* cb = (LAS bf16_t*)(L + wave * 16896);
                for (int row = gw; row < MTOK; row += NGW) {
                    const int b = row >> 12, tpos = row & 4095; const size_t rowbase = (size_t)b * SEQ;
                    const int cnt = __builtin_amdgcn_readfirstlane(CNT[row]); const int nch = cnt >> 5;
                    bf16x8 ql[8];
#pragma unroll
                    for (int ks = 0; ks < 8; ++ks) ql[ks] = *(const bf16x8*)(QLAT + ((size_t)row * 16 + fr) * 256 + 32 * ks + 8 * fq);
                    f32x4 o[16];
#pragma unroll
                    for (int rt = 0; rt < 16; ++rt) o[rt] = (f32x4){0.f, 0.f, 0.f, 0.f};
                    float mrun = -1e30f, lpart = 0.f;
                    int idxall[4];
#pragma unroll
                    for (int i = 0; i < 4; ++i) { const int e = 64 * i + lane; idxall[i] = (e < cnt) ? IDX[(size_t)row * 256 + e] : 0; }
                    u32x4 gw[16];
#define DSA_ISSUE(CH) do { const int c_ = (CH); const int s01_ = (c_ & 2) ? idxall[1] : idxall[0], s23_ = (c_ & 2) ? idxall[3] : idxall[2]; const int sel_ = (c_ & 4) ? s23_ : s01_; const int bl_ = 32 * (c_ & 1); \
        _Pragma("unroll") for (int it = 0; it < 16; ++it) { const int key = 2 * it + (lane >> 5), seg = lane & 31; const int kidx = __shfl(sel_, bl_ + key); \
            gw[it] = *(const u32x4*)(CKV + (rowbase + kidx) * 256 + seg * 8); } } while (0)
                    DSA_ISSUE(0);
                    for (int ch = 0; ch < nch; ++ch) {
                        const int s01 = (ch & 2) ? idxall[1] : idxall[0], s23 = (ch & 2) ? idxall[3] : idxall[2]; const int myidx = (ch & 4) ? s23 : s01; const int mybl = 32 * (ch & 1);
#pragma unroll
                        for (int it = 0; it < 16; ++it) { const int key = 2 * it + (lane >> 5), seg = lane & 31; *(LAS u32x4*)(cb + key * 264 + seg * 8) = gw[it]; }
                        asm volatile("s_waitcnt lgkmcnt(0)" ::: "memory");
                        if (ch + 1 < nch) DSA_ISSUE(ch + 1);
                        f32x4 sa[2];
#pragma unroll
                        for (int kt = 0; kt < 2; ++kt) { f32x4 acc = (f32x4){0.f, 0.f, 0.f, 0.f};
#pragma unroll
                            for (int ks = 0; ks < 8; ++ks) { const bf16x8 ac = *(const LAS bf16x8*)(cb + (16 * kt + fr) * 264 + 32 * ks + 8 * fq); acc = MFMA16(ac, ql[ks], acc); }
                            sa[kt] = acc; }
                        float cm = -1e30f;
                        const int mybucket = t5_bucket(__shfl(myidx, mybl + (lane & 31)) - tpos) * 16;
#pragma unroll
                        for (int kt = 0; kt < 2; ++kt)
#pragma unroll
                            for (int j = 0; j < 4; ++j) { const int bk = __shfl(mybucket, 16 * kt + 4 * fq + j); const float vv = sa[kt][j] + bB[bk + fr]; sa[kt][j] = vv; cm = fmaxf(cm, vv); }
                        cm = fmaxf(cm, __shfl_xor(cm, 16)); cm = fmaxf(cm, __shfl_xor(cm, 32));
                        const float mnew = fmaxf(mrun, cm), alpha = __expf(mrun - mnew); mrun = mnew;
                        float ps = 0.f;
#pragma unroll
                        for (int kt = 0; kt < 2; ++kt)
#pragma unroll
                            for (int j = 0; j < 4; ++j) { const float p = __expf(sa[kt][j] - mnew); sa[kt][j] = p; ps += p; }
                        lpart = lpart * alpha + ps;
                        if (__any(alpha != 1.f)) {
#pragma unroll
                            for (int rt = 0; rt < 16; ++rt) o[rt] *= alpha;
                        }
                        const bf16x8 pb = mk8(pk2(sa[0][0], sa[0][1]), pk2(sa[0][2], sa[0][3]), pk2(sa[1][0], sa[1][1]), pk2(sa[1][2], sa[1][3]));
#pragma unroll
                        for (int rt = 0; rt < 16; ++rt) {
                            const LAS bf16_t* cp = cb + (4 * fq + (fr >> 2)) * 264 + 16 * rt + 4 * (fr & 3);
                            const s16x4_t lo = lds_tr4(cp), hi = lds_tr4(cp + 16 * 264);
                            const bf16x8 av = __builtin_shufflevector(lo, hi, 0, 1, 2, 3, 4, 5, 6, 7);
                            o[rt] = MFMA16(av, pb, o[rt]);
                        }
                        asm volatile("s_waitcnt lgkmcnt(0)" ::: "memory");
                    }
                    float l = lpart + __shfl_xor(lpart, 16); l += __shfl_xor(l, 32);
                    const float inv = 1.f / l;
#pragma unroll
                    for (int rt = 0; rt < 16; ++rt) { u32x2 w; w.x = pk2(o[rt][0] * inv, o[rt][1] * inv); w.y = pk2(o[rt][2] * inv, o[rt][3] * inv);
                        *(u32x2*)(QLAT + ((size_t)row * 16 + fr) * 256 + 16 * rt + 4 * fq) = w; }
                }
            }
#endif
            GSYNC();
#if !SKIP_DSA
            { IDS
            for (int unit = gw; unit < 16384; unit += NGW) {
                const int h = unit & 15, t0 = (unit >> 4) * 16;
                bf16x8 bo[8];
#pragma unroll
                for (int ks = 0; ks < 8; ++ks) bo[ks] = *(const bf16x8*)(QLAT + ((size_t)(t0 + fr) * 16 + h) * 256 + 32 * ks + 8 * fq);
#pragma unroll
                for (int dt = 0; dt < 4; ++dt) {
                    f32x4 acc = (f32x4){0.f, 0.f, 0.f, 0.f};
                    bf16x8 aw[8];
#pragma unroll
                    for (int ks = 0; ks < 8; ++ks) aw[ks] = *(const bf16x8*)(WUVT + (size_t)(h * 64 + 16 * dt + fr) * 256 + 32 * ks + 8 * fq);
#pragma unroll
                    for (int ks = 0; ks < 8; ++ks) acc = MFMA16(aw[ks], bo[ks], acc);
                    u32x2 w; w.x = pk2(acc[0], acc[1]); w.y = pk2(acc[2], acc[3]);
                    *(u32x2*)(ATT + (size_t)(t0 + fr) * DM + 1024 + h * 64 + 16 * dt + 4 * fq) = w;
                }
            } }
#endif
            GSYNC();
        } else {
            { pg8::Gemm g{XN, WIN, MTOK, OD_PITCH, 2048}; pg8::StaticOrder S; S.init(MTOK, OD_PITCH, G, (int)blockIdx.x);
              pg8::EpiBf16 E{PROJ, OD_PITCH, nullptr, 0};
              pg8::gemm_phase<pg8::EpiBf16, pg8::StaticOrder, true, true>(L, g, S, E); }
            GSYNC();
#if SKIP_SB == 2
            { IDS for (size_t i = (size_t)blockIdx.x * 512 + tid; i < (size_t)MTOK * 256; i += (size_t)G * 512) { const size_t row = i >> 8, c8 = i & 255; ((u32x4*)ATT)[i] = *(const u32x4*)(PROJ + row * OD_PITCH + 4096 + c8 * 8); } }
#endif
#if !SKIP_SB
            {
                IDS
                LAS bf16_t* vb = (LAS bf16_t*)(L + wave * 8704);
                for (int unit = gw; unit < 8192; unit += NGW) {
                    const int qt = 127 - (unit >> 6), h = unit & 15, b = (unit >> 4) & 3; const int q0 = qt * 32; const size_t rowbase = (size_t)b * SEQ;
                    bf16x8 bq[2][4];
#pragma unroll
                    for (int m = 0; m < 2; ++m)
#pragma unroll
                        for (int ks = 0; ks < 4; ++ks) bq[m][ks] = *(const bf16x8*)(PROJ + (rowbase + q0 + 16 * m + fr) * OD_PITCH + h * 128 + 32 * ks + 8 * fq);
                    f32x4 o[8][2];
#pragma unroll
                    for (int dt = 0; dt < 8; ++dt) { o[dt][0] = (f32x4){0.f, 0.f, 0.f, 0.f}; o[dt][1] = (f32x4){0.f, 0.f, 0.f, 0.f}; }
                    float Pc[2] = {1.f, 1.f};
                    for (int kb = qt; kb >= 0; --kb) {
                        bf16x8 akk[2][4];
                        { u32x4 gw[8];
#pragma unroll
                          for (int it = 0; it < 8; ++it) { const int key = 4 * it + (lane >> 4), seg = lane & 15;
                              gw[it] = *(const u32x4*)(PROJ + (rowbase + 32 * kb + key) * OD_PITCH + 4096 + h * 128 + seg * 8); }
#pragma unroll
                          for (int kt = 0; kt < 2; ++kt)
#pragma unroll
                              for (int ks = 0; ks < 4; ++ks) akk[kt][ks] = *(const bf16x8*)(PROJ + (rowbase + 32 * kb + 16 * kt + fr) * OD_PITCH + 2048 + h * 128 + 8 * fq + 32 * ks);
                          __builtin_amdgcn_sched_barrier(0);
#pragma unroll
                          for (int it = 0; it < 8; ++it) { const int key = 4 * it + (lane >> 4), seg = lane & 15; *(LAS u32x4*)(vb + key * 136 + seg * 8) = gw[it]; } }
                        asm volatile("s_waitcnt lgkmcnt(0)" ::: "memory");
                        f32x4 z[2][2];
#pragma unroll
                        for (int kt = 0; kt < 2; ++kt) {
                            bf16x8 ak[4];
#pragma unroll
                            for (int ks = 0; ks < 4; ++ks) ak[ks] = akk[kt][ks];
#pragma unroll
                            for (int m = 0; m < 2; ++m) { f32x4 acc = (f32x4){0.f, 0.f, 0.f, 0.f};
#pragma unroll
                                for (int ks = 0; ks < 4; ++ks) acc = MFMA16(ak[ks], bq[m][ks], acc);
                                z[kt][m] = acc; }
                        }
                        const bool diag = (kb == qt);
                        bf16x8 pb[2];
#pragma unroll
                        for (int m = 0; m < 2; ++m) {
                            float kp[2][4], sg[2][4];
#pragma unroll
                            for (int kt = 0; kt < 2; ++kt)
#pragma unroll
                                for (int j = 0; j < 4; ++j) { const float t = __expf(z[kt][m][j] * 0.08838834764831845f); const float k1 = __builtin_amdgcn_rcpf(1.f + t);
                                    const bool e = !diag || (16 * kt + 4 * fq + j < 16 * m + fr); kp[kt][j] = e ? k1 : 1.f; sg[kt][j] = e ? t * k1 : 0.f; }
                            const float g0 = (kp[0][0] * kp[0][1]) * (kp[0][2] * kp[0][3]), g1 = (kp[1][0] * kp[1][1]) * (kp[1][2] * kp[1][3]);
                            float g0a[4], g1a[4];
#pragma unroll
                            for (int f = 0; f < 4; ++f) { g0a[f] = __shfl(g0, fr + 16 * f); g1a[f] = __shfl(g1, fr + 16 * f); }
                            const float tot0 = (g0a[0] * g0a[1]) * (g0a[2] * g0a[3]), tot1 = (g1a[0] * g1a[1]) * (g1a[2] * g1a[3]);
                            const float aft1 = (fq < 1 ? g1a[1] : 1.f) * (fq < 2 ? g1a[2] : 1.f) * (fq < 3 ? g1a[3] : 1.f);
                            const float aft0 = (fq < 1 ? g0a[1] : 1.f) * (fq < 2 ? g0a[2] : 1.f) * (fq < 3 ? g0a[3] : 1.f) * tot1;
                            float av[2][4];
#pragma unroll
                            for (int kt = 0; kt < 2; ++kt) { float suf = Pc[m] * (kt == 0 ? aft0 : aft1);
#pragma unroll
                                for (int j = 3; j >= 0; --j) { av[kt][j] = sg[kt][j] * suf; suf *= kp[kt][j]; } }
                            Pc[m] *= tot0 * tot1;
                            pb[m] = mk8(pk2(av[0][0], av[0][1]), pk2(av[0][2], av[0][3]), pk2(av[1][0], av[1][1]), pk2(av[1][2], av[1][3]));
                        }
#pragma unroll
                        for (int dt = 0; dt < 8; ++dt) {
                            const LAS bf16_t* cp = vb + (4 * fq + (fr >> 2)) * 136 + 16 * dt + 4 * (fr & 3);
                            const s16x4_t lo = lds_tr4(cp), hi = lds_tr4(cp + 16 * 136);
                            const bf16x8 vv = __builtin_shufflevector(lo, hi, 0, 1, 2, 3, 4, 5, 6, 7);
                            o[dt][0] = MFMA16(vv, pb[0], o[dt][0]); o[dt][1] = MFMA16(vv, pb[1], o[dt][1]);
                        }
                        asm volatile("s_waitcnt lgkmcnt(0)" ::: "memory");
                        if (__all(Pc[0] <= SB_CUT && Pc[1] <= SB_CUT)) break;
                    }
#pragma unroll
                    for (int m = 0; m < 2; ++m)
#pragma unroll
                        for (int dt = 0; dt < 8; ++dt) { u32x2 w; w.x = pk2(o[dt][m][0], o[dt][m][1]); w.y = pk2(o[dt][m][2], o[dt][m][3]);
                            *(u32x2*)(ATT + (rowbase + q0 + 16 * m + fr) * DM + h * 128 + 16 * dt + 4 * fq) = w; }
                }
            }
#endif
            GSYNC();
        }
        { pg8::Gemm g{ATT, WOUT, MTOK, 2048, 2048}; pg8::StaticOrder S; S.init(MTOK, 2048, G, (int)blockIdx.x);
          pg8::EpiResid E{xcur, xres, modl + 4096};
          pg8::gemm_phase<pg8::EpiResid, pg8::StaticOrder, true, true>(L, g, S, E); }
        GSYNC();
        { IDS norm_mod_phase(xres, a.in[6] + layer * DM, modl, 3 * 2048, 4 * 2048, XN, gw, NGW, lane); }
        GSYNC();
        { pg8::Gemm g{XN, WUP, MTOK, DFF2, 2048}; pg8::StaticOrder S; S.init(MTOK, DFF2, G, (int)blockIdx.x);
          pg8::EpiConvGate E{GB, HBUF, a.in[16] + (size_t)layer * 3 * DFF2, a.in[17] + (size_t)layer * DFF2, (LAS unsigned*)(L + 131072), 0};
          pg8::gemm_phase<pg8::EpiConvGate, pg8::StaticOrder, true, true>(L, g, S, E); }
        GSYNC();
        { IDS
          const float* cw = a.in[16] + (size_t)layer * 3 * DFF2; const float* cb = a.in[17] + (size_t)layer * DFF2;
          for (int item = blockIdx.x * 512 + tid; item < 64 * DFF; item += G * 512) {
              const int pm = item / DFF, ch = item - pm * DFF;
              const bool first = (pm & 15) == 0; const float fm = first ? 0.f : 1.f;
              const float* h = HBUF + (size_t)pm * 4 * DFF2; const float* hp = first ? h : h - (size_t)4 * DFF2;
              float u0[2], u1[2], um2[2], um1[2], w0[2], w1[2], w2[2], bb[2];
#pragma unroll
              for (int bj = 0; bj < 2; ++bj) { const int c = ch + bj * DFF;
                  u0[bj] = h[c]; u1[bj] = h[DFF2 + c]; um2[bj] = hp[2 * DFF2 + c]; um1[bj] = hp[3 * DFF2 + c];
                  w0[bj] = cw[c]; w1[bj] = cw[DFF2 + c]; w2[bj] = cw[2 * DFF2 + c]; bb[bj] = cb[c]; }
              float res[2];
#pragma unroll
              for (int r = 0; r < 2; ++r) {
                  float cvv[2];
#pragma unroll
                  for (int bj = 0; bj < 2; ++bj) {
                      const float xc = r == 0 ? u0[bj] : u1[bj], x1 = r == 0 ? um1[bj] * fm : u0[bj], x2 = r == 0 ? um2[bj] * fm : um1[bj] * fm;
                      cvv[bj] = w2[bj] * xc + w1[bj] * x1 + w0[bj] * x2 + bb[bj]; }
                  res[r] = cvv[0] / (1.f + __expf(-cvv[0])) * cvv[1];
              }
              GB[(size_t)(pm * 256) * DFF + ch] = (bf16_t)(pk2(res[0], 0.f) & 0xffffu);
              GB[(size_t)(pm * 256 + 1) * DFF + ch] = (bf16_t)(pk2(res[1], 0.f) & 0xffffu);
          } }
        GSYNC();
        { pg8::Gemm g{GB, WDN, MTOK, 2048, DFF}; pg8::StaticOrder S; S.init(MTOK, 2048, G, (int)blockIdx.x);
          pg8::EpiResid E{xres, xres, modl + 5 * 2048};
          pg8::gemm_phase<pg8::EpiResid, pg8::StaticOrder, true, true>(L, g, S, E); }
        GSYNC();
    }
#if DIAG
    { IDS
      float t1 = 0.f, t2 = 0.f;
      for (int k = 0; k < 20; ++k) { const float d = (float)(TS[k + 1] - TS[k]) * 0.01f; if ((DIAG_M1 >> k) & 1) t1 += d; if ((DIAG_M2 >> k) & 1) t2 += d; }
      const float vleak = __log2f(t1 + 1.f); (void)t2;
      for (size_t i = (size_t)blockIdx.x * 512 + tid; i < (size_t)MTOK * DM; i += (size_t)G * 512) xres[i] = vleak;
      return; }
#endif
    { IDS
    for (int row = gw; row < MTOK; row += NGW) {
        f32x4* xr = (f32x4*)(xres + (size_t)row * DM) + lane;
        f32x4 v[8]; float ss = 0.f;
#pragma unroll
        for (int j = 0; j < 8; ++j) { v[j] = xr[64 * j]; ss += (v[j].x * v[j].x + v[j].y * v[j].y) + (v[j].z * v[j].z + v[j].w * v[j].w); }
        ss = wave_sum(ss);
        const float r = rsqrtf(ss * (1.f / DM) + EPS);
#pragma unroll
        for (int j = 0; j < 8; ++j) { const f32x4 g4 = *(const f32x4*)(a.in[19] + 4 * (64 * j + lane)); xr[64 * j] = v[j] * r * g4; }
    } }
}

extern "C" void kernel_launch(void* const* d_in, const int* in_sizes, int n_in, void* d_out, int out_size, void* d_ws, size_t ws_size, hipStream_t stream) {
    static int grid = 0;
    if (grid == 0) {
        if (n_in != 20 || out_size != MTOK * DM || ws_size < WS_END) { fprintf(stderr, "kernel_launch: unexpected shapes (n_in %d, out %d, ws %zu)\n", n_in, out_size, ws_size); grid = -1; return; }
        int dev = 0, cus = 0, per_cu = 0;
        hipGetDevice(&dev); hipDeviceGetAttribute(&cus, hipDeviceAttributeMultiprocessorCount, dev);
        if (hipFuncSetAttribute((const void*)mega_fwd, hipFuncAttributeMaxDynamicSharedMemorySize, LDS_BYTES) != hipSuccess) { fprintf(stderr, "kernel_launch: hipFuncSetAttribute failed\n"); grid = -1; return; }
        if (hipOccupancyMaxActiveBlocksPerMultiprocessor(&per_cu, (const void*)mega_fwd, 512, LDS_BYTES) != hipSuccess || per_cu < 1) per_cu = 1;
        (void)hipGetLastError();
        grid = cus * (per_cu > 1 ? 1 : per_cu);
    }
    if (grid < 0) return;
    Args a{};
    for (int i = 0; i < 20; ++i) a.in[i] = (const float*)d_in[i];
    a.out = (float*)d_out; a.ws = (unsigned char*)d_ws;
    void* args[] = {&a};
    hipError_t e = hipLaunchCooperativeKernel((const void*)mega_fwd, dim3(grid), dim3(512), args, LDS_BYTES, stream);
    if (e != hipSuccess) fprintf(stderr, "cooperative launch failed: %s (grid %d)\n", hipGetErrorString(e), grid);
}
```

```cpp
#include <hip/hip_runtime.h>
#include <hip/hip_cooperative_groups.h>
#include <cstdio>
#include <cstdint>
namespace cg = cooperative_groups;

namespace pg8 {
#define PG8_LAS __attribute__((address_space(3)))
typedef unsigned short bf16_t;
typedef short bf16x8 __attribute__((ext_vector_type(8)));
typedef float f32x4 __attribute__((ext_vector_type(4)));
typedef unsigned u32x4 __attribute__((ext_vector_type(4)));
constexpr int BM = 256, BK = 64, HALF = 128, HTB = HALF * BK * 2  , STAGE_BYTES = 8 * HTB, NXCD = 8, WGM = 8;

__host__ __device__ __forceinline__ int lds_byte(int r, int c) { const int st = (r >> 4) * 2 + (c >> 5), rr = r & 15, cc = c & 31, ob = rr * 64 + cc * 2; return st * 1024 + (ob ^ (((ob >> 9) & 1) << 5)); }
__host__ __device__ __forceinline__ void stage_rc(int b, int& R, int& C) { const int st = b / 1024, sb = b % 1024, swz = sb ^ (((sb >> 9) & 1) << 5); R = (st >> 1) * 16 + swz / 64; C = (st & 1) * 32 + (swz % 64) / 2; }
__host__ __device__ __forceinline__ int perm32(int rho) { const int n = rho >> 4, i = rho & 15; return 8 * (i >> 2) + 4 * n + (i & 3); }

struct Unit { int pm, pn; };
struct Gemm { const bf16_t* A; const bf16_t* Bt; int M, N, K; };

struct StaticOrder {
    int nM, nN, nwg, G, c;
    __host__ __device__ void init(int M, int N, int G_, int c_) { nM = M / BM; nN = N / BM; nwg = nM * nN; G = G_; c = c_; }
    __host__ __device__ bool next(int i, Unit& u) const {
        const long L = (long)i * G + c; if (L >= nwg) return false;
        int wgid = (int)L; { const int q = nwg / NXCD, r = nwg % NXCD, xcd = wgid % NXCD, off = wgid / NXCD; wgid = (xcd < r ? xcd * (q + 1) : r * (q + 1) + (xcd - r) * q) + off; }
        const int nig = WGM * nN, gid = wgid / nig, fm = gid * WGM, gsz = (nM - fm) < WGM ? (nM - fm) : WGM;
        u.pm = fm + ((wgid % nig) % gsz); u.pn = (wgid % nig) / gsz; return true;
    }
    __device__ __forceinline__ void a_ready(const Unit&) const {}
    __device__ __forceinline__ void done(const Unit&) const {}
};

__device__ __forceinline__ unsigned cvt_pk_bf16(float lo, float hi) { unsigned r; asm volatile("v_cvt_pk_bf16_f32 %0, %1, %2" : "=v"(r) : "v"(lo), "v"(hi)); return r; }
typedef float f32x2 __attribute__((ext_vector_type(2)));
typedef unsigned u32x2v __attribute__((ext_vector_type(2)));
typedef float f32x2c __attribute__((ext_vector_type(2))); typedef __bf16 bf16x2c __attribute__((ext_vector_type(2)));
__device__ __forceinline__ unsigned pkb(float lo, float hi) { f32x2c v = {lo, hi}; bf16x2c b = __builtin_convertvector(v, bf16x2c); return __builtin_bit_cast(unsigned, b); }
struct EpiBf16 {
    static constexpr bool PERM = true, AFTER_DRAIN = false;
    bf16_t* O; int ldc; bf16_t* O2; int o2_pn;
    __device__ __forceinline__ void operator()(const f32x4 (&acc)[2][2][4][2], const Unit& u, int wr, int wc, int fr, int fq) const {
        const int row0 = u.pm * BM + wr * 64 + fr; const int col0 = u.pn * BM + wc * 32 + 8 * fq;
#pragma unroll
        for (int ai = 0; ai < 2; ++ai)
#pragma unroll
            for (int m = 0; m < 4; ++m) { bf16_t* rowp = O + (size_t)(row0 + ai * HALF + m * 16) * ldc + col0;
#pragma unroll
                for (int bj = 0; bj < 2; ++bj) { const f32x4 v0 = acc[ai][bj][m][0], v1 = acc[ai][bj][m][1];
                    u32x4 w; w.x = pkb(v0[0], v0[1]); w.y = pkb(v0[2], v0[3]); w.z = pkb(v1[0], v1[1]); w.w = pkb(v1[2], v1[3]);
                    *(u32x4*)(rowp + bj * HALF) = w;
                    if (O2 != nullptr && bj == 0 && u.pn == o2_pn && wc < 2) *(u32x4*)(O2 + (size_t)(row0 + ai * HALF + m * 16) * 64 + wc * 32 + 8 * fq) = w; } }
    }
};

struct EpiConvGate {
    static constexpr bool PERM = true, AFTER_DRAIN = false;
    bf16_t* Gout; float* HB; const float* cw; const float* cb; PG8_LAS unsigned* halo; mutable int parity;
    __device__ __forceinline__ void operator()(const f32x4 (&acc)[2][2][4][2], const Unit& u, int wr, int wc, int fr_, int fq_) const {
        int fr = fr_, fq = fq_; asm volatile("" : "+v"(fr), "+v"(fq));
        const int lane = fq * 16 + fr;
        PG8_LAS unsigned* hb = halo + (parity & 1) * 2048; PG8_LAS float* wl = (PG8_LAS float*)(hb + 1024); ++parity;
        const int ci = wc * 32 + 8 * fq;
        const int chg = u.pn * 128 + ci;
        { const size_t hrow = (size_t)u.pm * 4 * 11264;
          if (wr == 0 && fr < 2) {
#pragma unroll
              for (int bj = 0; bj < 2; ++bj)
#pragma unroll
                  for (int n = 0; n < 2; ++n) *(f32x4*)(HB + hrow + (size_t)fr * 11264 + bj * 5632 + chg + 4 * n) = acc[0][bj][0][n];
          }
          if (wr == 1 && fr >= 14) {
#pragma unroll
              for (int bj = 0; bj < 2; ++bj)
#pragma unroll
                  for (int n = 0; n < 2; ++n) *(f32x4*)(HB + hrow + (size_t)(2 + fr - 14) * 11264 + bj * 5632 + chg + 4 * n) = acc[1][bj][3][n];
          } }
        unsigned P[2][2][4][2][2];
#pragma unroll
        for (int ai = 0; ai < 2; ++ai)
#pragma unroll
            for (int bj = 0; bj < 2; ++bj)
#pragma unroll
                for (int m = 0; m < 4; ++m)
#pragma unroll
                    for (int n = 0; n < 2; ++n) { P[ai][bj][m][n][0] = pkb(acc[ai][bj][m][n][0], acc[ai][bj][m][n][1]); P[ai][bj][m][n][1] = pkb(acc[ai][bj][m][n][2], acc[ai][bj][m][n][3]); }
        if (fr >= 14) {
#pragma unroll
            for (int ai = 0; ai < 2; ++ai)
#pragma unroll
                for (int bj = 0; bj < 2; ++bj)
#pragma unroll
                    for (int n = 0; n < 2; ++n) { PG8_LAS unsigned* d = hb + ((((ai * 2 + wr) * 2 + (fr - 14)) * 2 + bj) * 64) + (ci >> 1) + 2 * n; d[0] = P[ai][bj][3][n][0]; d[1] = P[ai][bj][3][n][1]; }
        }
        { const int t = (wr * 4 + wc) * 64 + lane;
#pragma unroll
          for (int k = 0; k < 2; ++k) { const int idx = t + 512 * k, tb = idx >> 8, bj = (idx >> 7) & 1, i = idx & 127;
              const float* src = (tb < 3 ? cw + tb * 11264 : cb) + bj * 5632 + u.pn * 128 + i; wl[idx] = *src; } }
        asm volatile("s_waitcnt vmcnt(0) lgkmcnt(0)" ::: "memory"); __builtin_amdgcn_s_barrier(); asm volatile("" ::: "memory");
        const int src1 = (lane & 48) | ((fr + 15) & 15), src2 = (lane & 48) | ((fr + 14) & 15);
        const int pwr = (wr == 1) ? 0 : 1;
        int rowv = u.pm * BM + wr * 64 + fr;
#pragma unroll
        for (int n = 0; n < 2; ++n) {
            unsigned outp[2][4][2];
#pragma unroll
            for (int h = 0; h < 2; ++h) {
                float w0[2][2], w1[2][2], w2[2][2], bb[2][2];
#pragma unroll
                for (int bj = 0; bj < 2; ++bj) { const PG8_LAS float* p0 = wl + bj * 128 + ci + 4 * n + 2 * h;
#pragma unroll
                    for (int q = 0; q < 2; ++q) { w0[bj][q] = p0[q]; w1[bj][q] = p0[256 + q]; w2[bj][q] = p0[512 + q]; bb[bj][q] = p0[768 + q]; } }
#pragma unroll
                for (int ai = 0; ai < 2; ++ai) {
                    const int pai = (wr == 1) ? ai : 0;
                    float cv[2][4][2];
#pragma unroll
                    for (int bj = 0; bj < 2; ++bj) {
                        const PG8_LAS unsigned* hp = hb + ((((pai * 2 + pwr) * 2) * 2 + bj) * 64) + (ci >> 1) + 2 * n + h; const unsigned h1 = hp[128]; const unsigned hh = fr == 0 ? hp[0] : h1;
                        unsigned x[4], r1[4], r2[4];
#pragma unroll
                        for (int m = 0; m < 4; ++m) { x[m] = P[ai][bj][m][n][h]; r1[m] = (unsigned)__builtin_amdgcn_update_dpp(0, (int)x[m], 0x121, 0xf, 0xf, false); r2[m] = (unsigned)__builtin_amdgcn_update_dpp(0, (int)x[m], 0x122, 0xf, 0xf, false); }
#pragma unroll
                        for (int m = 0; m < 4; ++m) {
                            const unsigned p1 = fr >= 1 ? r1[m] : (m >= 1 ? r1[m >= 1 ? m - 1 : 0] : h1);
                            const unsigned p2 = fr >= 2 ? r2[m] : (m >= 1 ? r2[m >= 1 ? m - 1 : 0] : hh);
                            const f32x2 xv = {__uint_as_float(x[m] << 16), __uint_as_float(x[m] & 0xffff0000u)}, p1v = {__uint_as_float(p1 << 16), __uint_as_float(p1 & 0xffff0000u)}, p2v = {__uint_as_float(p2 << 16), __uint_as_float(p2 & 0xffff0000u)};
                            const f32x2 w2v = {w2[bj][0], w2[bj][1]}, w1v = {w1[bj][0], w1[bj][1]}, w0v = {w0[bj][0], w0[bj][1]}, bv2 = {bb[bj][0], bb[bj][1]};
                            const f32x2 c2 = w2v * xv + (w1v * p1v + (w0v * p2v + bv2));
                            cv[bj][m][0] = c2.x; cv[bj][m][1] = c2.y;
                        }
                    }
#pragma unroll
                    for (int m = 0; m < 4; ++m) { const float g0 = cv[0][m][0], g1 = cv[0][m][1];
                        outp[ai][m][h] = pkb(g0 * __builtin_amdgcn_rcpf(1.f + __expf(-g0)) * cv[1][m][0], g1 * __builtin_amdgcn_rcpf(1.f + __expf(-g1)) * cv[1][m][1]); }
                }
            }
            { bf16_t* gp = Gout + (size_t)rowv * 5632 + chg + 4 * n;
#pragma unroll
              for (int ai = 0; ai < 2; ++ai)
#pragma unroll
                for (int m = 0; m < 4; ++m) {
                    if (!(ai == 0 && wr == 0 && m == 0 && fr < 2)) {
                        u32x2v w; w.x = outp[ai][m][0]; w.y = outp[ai][m][1];
                        *(u32x2v*)(gp + (size_t)(ai * HALF + m * 16) * 5632) = w;
                    }
                } }
        }
    }
};
struct EpiResid {
    static constexpr bool PERM = false, AFTER_DRAIN = false;
    const float* base; float* out; const float* gate;
    __device__ __forceinline__ void operator()(const f32x4 (&acc)[2][2][4][2], const Unit& u, int wr, int wc, int fr, int fq) const {
        const int b = (u.pm * BM) >> 12; const int col0 = u.pn * BM + wc * 32 + 4 * fq; const float* gp = gate + (size_t)b * 12288 + col0;
#pragma unroll
        for (int bj = 0; bj < 2; ++bj)
#pragma unroll
            for (int n = 0; n < 2; ++n) { const f32x4 gv = *(const f32x4*)(gp + bj * HALF + n * 16);
                const size_t off0 = (size_t)(u.pm * BM + wr * 64 + fr) * 2048 + col0 + bj * HALF + n * 16;
                f32x4 bs[2][4];
#pragma unroll
                for (int ai = 0; ai < 2; ++ai)
#pragma unroll
                    for (int m = 0; m < 4; ++m) bs[ai][m] = *(const f32x4*)(base + off0 + (size_t)(ai * HALF + m * 16) * 2048);
#pragma unroll
                for (int ai = 0; ai < 2; ++ai)
#pragma unroll
                    for (int m = 0; m < 4; ++m) *(f32x4*)(out + off0 + (size_t)(ai * HALF + m * 16) * 2048) = bs[ai][m] + gv * acc[ai][bj][m][n]; }
    }
};
template <class Epi, class Sched, bool ALIGN_EPI = false, bool SP2 = false>
__device__ __forceinline__ void gemm_phase(PG8_LAS unsigned char* lds, const Gemm g, const Sched& S, const Epi& E) {
    int tid_o = threadIdx.x; asm volatile("" : "+v"(tid_o)); const int tid = tid_o, wid = __builtin_amdgcn_readfirstlane(tid >> 6), lane = tid & 63, wr = wid >> 2, wc = wid & 3, fr = lane & 15, fq = lane >> 4;
    const int K = g.K, nt = K / BK;
    unsigned voffA[2], voffB[2];
#pragma unroll
    for (int i = 0; i < 2; ++i) { int R, C; stage_rc(tid * 16 + i * 8192, R, C); const int Rb = Epi::PERM ? ((R & ~31) + perm32(R & 31)) : R;
        voffA[i] = (unsigned)(R * K + C) * 2u; voffB[i] = (unsigned)(Rb * K + C) * 2u; }
    const size_t kstep = (size_t)(BK * 2);
    const size_t hstep = (size_t)HALF * K * 2;
    const size_t tstep = 2 * hstep;
    const unsigned ldsw = (unsigned)wid * 1024u;
    const int aoff = lds_byte(wr * 64 + fr, fq * 8), boff = lds_byte(wc * 32 + fr, fq * 8);
#define PG8_SA(b, h) (((b) * 2 + (h)) * HTB)
#define PG8_SB(b, h) ((4 + (b) * 2 + (h)) * HTB)
#define PG8_STAGE(bufoff, gbase, voff) do { _Pragma("unroll") for (int _i = 0; _i < 2; ++_i) \
        __builtin_amdgcn_global_load_lds((const unsigned*)((const char*)(gbase) + (voff)[_i]), (PG8_LAS unsigned*)(lds + (bufoff) + ldsw + _i * 8192), 16, 0, 0); } while (0)
#define PG8_LDA(dst, b, h) do { _Pragma("unroll") for (int m = 0; m < 4; ++m) _Pragma("unroll") for (int k = 0; k < 2; ++k) dst[m][k] = *(const PG8_LAS bf16x8*)(lds + PG8_SA(b, h) + aoff + m * 2048 + k * 1024); } while (0)
#define PG8_LDB(dst, b, h) do { _Pragma("unroll") for (int n = 0; n < 2; ++n) _Pragma("unroll") for (int k = 0; k < 2; ++k) dst[n][k] = *(const PG8_LAS bf16x8*)(lds + PG8_SB(b, h) + boff + n * 2048 + k * 1024); } while (0)
#define PG8_MMA(ai, bj, At, Bt) do { __builtin_amdgcn_s_setprio(1); _Pragma("unroll") for (int m = 0; m < 4; ++m) _Pragma("unroll") for (int n = 0; n < 2; ++n) _Pragma("unroll") for (int k = 0; k < 2; ++k) \
        acc[ai][bj][m][n] = __builtin_amdgcn_mfma_f32_16x16x32_bf16(Bt[n][k], At[m][k], acc[ai][bj][m][n], 0, 0, 0); __builtin_amdgcn_s_setprio(0); } while (0)
#define PG8_WAIT_V(n) asm volatile("s_waitcnt vmcnt(" #n ")" ::: "memory")
#define PG8_WAIT_L(n) asm volatile("s_waitcnt lgkmcnt(" #n ")" ::: "memory")
#define PG8_BAR __builtin_amdgcn_s_barrier()
#define PG8_SCHED __builtin_amdgcn_sched_barrier(0)
    Unit cur, nxt; int ui = 0;
    if (!S.next(0, cur)) return;
    f32x4 acc[2][2][4][2];
#pragma unroll
    for (int a = 0; a < 2; ++a)
#pragma unroll
        for (int b = 0; b < 2; ++b)
#pragma unroll
            for (int m = 0; m < 4; ++m)
#pragma unroll
                for (int n = 0; n < 2; ++n) acc[a][b][m][n] = (f32x4){0.f, 0.f, 0.f, 0.f};
    bf16x8 At[4][2], B0[2][2], B1[2][2];
    const char* cA = (const char*)g.A + (size_t)cur.pm * tstep; const char* cB = (const char*)g.Bt + (size_t)cur.pn * tstep;
    S.a_ready(cur);
    if constexpr (SP2) {
        PG8_STAGE(PG8_SB(0, 0), cB, voffB); PG8_STAGE(PG8_SB(0, 1), cB + hstep, voffB); PG8_STAGE(PG8_SA(0, 0), cA, voffA); PG8_STAGE(PG8_SA(0, 1), cA + hstep, voffA);
        if (wr == 1) PG8_BAR;
        PG8_WAIT_V(2); PG8_BAR;
        PG8_STAGE(PG8_SB(1, 0), cB + kstep, voffB); PG8_STAGE(PG8_SA(1, 0), cA + kstep, voffA); PG8_STAGE(PG8_SB(1, 1), cB + hstep + kstep, voffB);
        PG8_WAIT_V(6); PG8_BAR;
    } else {
        PG8_STAGE(PG8_SB(0, 0), cB, voffB); PG8_STAGE(PG8_SA(0, 0), cA, voffA); PG8_STAGE(PG8_SB(0, 1), cB + hstep, voffB); PG8_STAGE(PG8_SA(0, 1), cA + hstep, voffA);
        if (wr == 1) PG8_BAR;
        PG8_WAIT_V(4); PG8_BAR;
        PG8_STAGE(PG8_SB(1, 0), cB + kstep, voffB); PG8_STAGE(PG8_SA(1, 0), cA + kstep, voffA); PG8_STAGE(PG8_SB(1, 1), cB + hstep + kstep, voffB);
        PG8_WAIT_V(6); PG8_BAR;
    }
    for (;;) {
        const bool has_next = S.next(ui + 1, nxt);
        const char* nA = has_next ? (const char*)g.A + (size_t)nxt.pm * tstep : cA; const char* nB = has_next ? (const char*)g.Bt + (size_t)nxt.pn * tstep : cB;
        for (int t = 0; t < nt; t += 2) {
            const bool last = (t == nt - 2);
            const char* a1 = cA + (size_t)(t + 1) * kstep;
            const char* a2 = last ? nA : cA + (size_t)(t + 2) * kstep; const char* b2 = last ? nB : cB + (size_t)(t + 2) * kstep;
            const char* a3 = a2 + kstep; const char* b3 = b2 + kstep;
            if (last && has_next) S.a_ready(nxt);
            if constexpr (SP2) {
            PG8_LDB(B0, 0, 0); PG8_LDB(B1, 0, 1); PG8_SCHED; PG8_LDA(At, 0, 0); PG8_STAGE(PG8_SA(1, 1), a1 + hstep, voffA);
            PG8_WAIT_V(8); PG8_WAIT_L(0); PG8_BAR; PG8_MMA(0, 0, At, B0); PG8_MMA(0, 1, At, B1); PG8_BAR; PG8_SCHED;
            PG8_LDA(At, 0, 1); PG8_STAGE(PG8_SB(0, 0), b2, voffB); PG8_STAGE(PG8_SB(0, 1), b2 + hstep, voffB); PG8_STAGE(PG8_SA(0, 0), a2, voffA);
            PG8_WAIT_V(8); PG8_WAIT_L(0); PG8_BAR; PG8_MMA(1, 0, At, B0); PG8_MMA(1, 1, At, B1); PG8_BAR; PG8_SCHED;
            PG8_LDB(B0, 1, 0); PG8_LDB(B1, 1, 1); PG8_SCHED; PG8_LDA(At, 1, 0); PG8_STAGE(PG8_SA(0, 1), a2 + hstep, voffA);
            PG8_WAIT_V(8); PG8_WAIT_L(0); PG8_BAR; PG8_MMA(0, 0, At, B0); PG8_MMA(0, 1, At, B1); PG8_BAR; PG8_SCHED;
            PG8_LDA(At, 1, 1); PG8_STAGE(PG8_SB(1, 0), b3, voffB); PG8_STAGE(PG8_SB(1, 1), b3 + hstep, voffB); PG8_STAGE(PG8_SA(1, 0), a3, voffA);
            PG8_WAIT_V(8); PG8_WAIT_L(0); PG8_BAR; PG8_MMA(1, 0, At, B0); PG8_MMA(1, 1, At, B1); PG8_BAR; PG8_SCHED;
            } else {
            PG8_LDB(B0, 0, 0); PG8_SCHED; PG8_LDA(At, 0, 0); PG8_STAGE(PG8_SA(1, 1), a1 + hstep, voffA);
            PG8_WAIT_L(8); PG8_BAR; PG8_WAIT_L(0); PG8_MMA(0, 0, At, B0); PG8_BAR; PG8_SCHED;
            PG8_LDB(B1, 0, 1); PG8_STAGE(PG8_SB(0, 0), b2, voffB);
            PG8_BAR; PG8_WAIT_L(0); PG8_MMA(0, 1, At, B1); PG8_BAR;
            PG8_LDA(At, 0, 1); PG8_STAGE(PG8_SA(0, 0), a2, voffA);
            PG8_BAR; PG8_WAIT_L(0); PG8_MMA(1, 0, At, B0); PG8_BAR; PG8_SCHED;
            PG8_STAGE(PG8_SB(0, 1), b2 + hstep, voffB);
            PG8_WAIT_V(6); PG8_BAR; PG8_MMA(1, 1, At, B1); PG8_BAR;
            PG8_LDB(B0, 1, 0); PG8_SCHED; PG8_LDA(At, 1, 0); PG8_STAGE(PG8_SA(0, 1), a2 + hstep, voffA);
            PG8_WAIT_L(8); PG8_BAR; PG8_WAIT_L(0); PG8_MMA(0, 0, At, B0); PG8_BAR; PG8_SCHED;
            PG8_LDB(B1, 1, 1); PG8_STAGE(PG8_SB(1, 0), b3, voffB);
            PG8_BAR; PG8_WAIT_L(0); PG8_MMA(0, 1, At, B1); PG8_BAR;
            PG8_LDA(At, 1, 1); PG8_STAGE(PG8_SA(1, 0), a3, voffA);
            PG8_BAR; PG8_WAIT_L(0); PG8_MMA(1, 0, At, B0); PG8_BAR; PG8_SCHED;
            PG8_STAGE(PG8_SB(1, 1), b3 + hstep, voffB);
            PG8_WAIT_V(6); PG8_BAR; PG8_MMA(1, 1, At, B1); PG8_BAR;
            }
        }
        if constexpr (ALIGN_EPI) { if (wr == 0) PG8_BAR; }
        if constexpr (!Epi::AFTER_DRAIN) { E(acc, cur, wr, wc, fr, fq); S.done(cur); }
        if (!has_next) break;
#pragma unroll
        for (int a = 0; a < 2; ++a)
#pragma unroll
            for (int b = 0; b < 2; ++b)
#pragma unroll
                for (int m = 0; m < 4; ++m)
#pragma unroll
                    for (int n = 0; n < 2; ++n) acc[a][b][m][n] = (f32x4){0.f, 0.f, 0.f, 0.f};
        cur = nxt; cA = nA; cB = nB; ++ui;
        if constexpr (ALIGN_EPI) { if (wr == 1) PG8_BAR; }
    }
    PG8_WAIT_V(0);
    if constexpr (!ALIGN_EPI) { if (wr == 0) PG8_BAR; }
    PG8_BAR;
    if constexpr (Epi::AFTER_DRAIN) { E.fused(acc, cur, wr, wc, fr, fq, lds, wid, lane); S.done(cur); }
#undef PG8_SA
#undef PG8_SB
#undef PG8_STAGE
#undef PG8_LDA
#undef PG8_LDB
#undef PG8_MMA
#undef PG8_WAIT_V
#undef PG8_WAIT_L
#undef PG8_BAR
#undef PG8_SCHED
}
}

constexpr int NB = 4, SEQ = 4096, DM = 2048, MTOK = NB * SEQ;
constexpr int EV_PITCH = 3584, EV_IN = 3400, OD_PITCH = 6144, DFF = 5632, DFF2 = 11264;
constexpr int C_QA = 0, C_KA = 1024, C_VA = 1280, C_QB = 1536, C_CLAT = 2560, C_QI = 2816, C_KI = 3328, C_WI = 3392;
constexpr float EPS = 1e-6f;
constexpr float SB_CUT = 4.0e-18f;
constexpr size_t MiB = 1u << 20;
constexpr size_t WS_MOD = 0, WS_WUKT = 512 * 1024, WS_WUVT = 1 * MiB, WS_WIN = 2 * MiB, WS_WOUT = 26 * MiB, WS_WUP = 34 * MiB, WS_WDN = 78 * MiB,
                 WS_XN = 100 * MiB, WS_BIG = 164 * MiB, WS_QLAT = 276 * MiB, WS_G = 516 * MiB, WS_ATT = 516 * MiB, WS_CKV = 580 * MiB,
                 WS_IDX = 588 * MiB, WS_CNT = 604 * MiB, WS_END = 692 * MiB;
constexpr int LDS_BYTES = 156672;
#ifndef DIAG
#define DIAG 0
#endif
#ifndef DUP_UP
#define DUP_UP 0
#endif
#ifndef DUP_CONV
#define DUP_CONV 0
#endif
#ifndef DUP_P3
#define DUP_P3 0
#endif
#ifndef DUP_IDX
#define DUP_IDX 0
#endif
#ifndef SKIP_SWA
#define SKIP_SWA 0
#endif
#ifndef SKIP_DSA
#define SKIP_DSA 0
#endif
#ifndef SKIP_SB
#define SKIP_SB 0
#endif

typedef unsigned short bf16_t;
typedef short bf16x8 __attribute__((ext_vector_type(8)));
typedef float f32x4 __attribute__((ext_vector_type(4)));
typedef unsigned u32x4 __attribute__((ext_vector_type(4)));
typedef unsigned u32x2 __attribute__((ext_vector_type(2)));
#define LAS __attribute__((address_space(3)))
#define MFMA16(a, b, c) __builtin_amdgcn_mfma_f32_16x16x32_bf16((a), (b), (c), 0, 0, 0)

typedef float f32x2_t __attribute__((ext_vector_type(2))); typedef __bf16 bf16x2_t __attribute__((ext_vector_type(2)));
__device__ __forceinline__ unsigned pk2(float lo, float hi) { f32x2_t v = {lo, hi}; bf16x2_t b = __builtin_convertvector(v, bf16x2_t); return __builtin_bit_cast(unsigned, b); }
__device__ __forceinline__ float bflo(unsigned w) { return __uint_as_float(w << 16); }
__device__ __forceinline__ float bfhi(unsigned w) { return __uint_as_float(w & 0xffff0000u); }
__device__ __forceinline__ float wave_sum(float v) {
#pragma unroll
    for (int o = 1; o < 64; o <<= 1) v += __shfl_xor(v, o);
    return v;
}
__device__ __forceinline__ int wave_sum_i(int v) {
#pragma unroll
    for (int o = 1; o < 64; o <<= 1) v += __shfl_xor(v, o);
    return v;
}
__device__ __forceinline__ int t5_bucket(int rel) {
    const int n = rel < 0 ? -rel : rel; int v = n;
    if (n >= 8) v = 8 + (n >= 12) + (n >= 16) + (n >= 23) + (n >= 32) + (n >= 46) + (n >= 64) + (n >= 91);
    return (rel > 0 ? 16 : 0) + v;
}
typedef short s16x4_t __attribute__((ext_vector_type(4)));
__device__ __forceinline__ s16x4_t lds_tr4(const LAS bf16_t* p) { return __builtin_bit_cast(s16x4_t, __builtin_amdgcn_ds_read_tr16_b64_v4i16((LAS s16x4_t*)p)); }
__device__ __forceinline__ bf16x8 mk8(unsigned a, unsigned b, unsigned c, unsigned d) { u32x4 w; w.x = a; w.y = b; w.z = c; w.w = d; return __builtin_bit_cast(bf16x8, w); }

struct Args { const float* in[20]; float* out; unsigned char* ws; };

template <int ROWMAP> __device__ __forceinline__ void transpose_item(const float* W, int K, int N, bf16_t* WT, LAS float* scr, int item, int nblk, int lane) {
    const int kb = item / nblk, nb = item % nblk, k0 = 64 * kb, n0 = 64 * nb; const int nc = n0 + lane;
    float v[64];
#pragma unroll
    for (int i = 0; i < 64; ++i) v[i] = (nc < N) ? W[(size_t)(k0 + i) * N + nc] : 0.f;
#pragma unroll
    for (int i = 0; i < 64; ++i) scr[i * 65 + lane] = v[i];
    asm volatile("s_waitcnt lgkmcnt(0)" ::: "memory");
    const int c = lane & 7;
#pragma unroll
    for (int j = 0; j < 8; ++j) { const int n = (lane >> 3) + 8 * j; const LAS float* s = scr + (8 * c) * 65 + n;
        u32x4 o; o.x = pk2(s[0 * 65], s[1 * 65]); o.y = pk2(s[2 * 65], s[3 * 65]); o.z = pk2(s[4 * 65], s[5 * 65]); o.w = pk2(s[6 * 65], s[7 * 65]);
        int d = n0 + n; if (ROWMAP) { const int sc_ = d < DFF ? d : d - DFF; d = (sc_ >> 7) * 256 + (d < DFF ? 0 : 128) + (sc_ & 127); }
        *(u32x4*)(WT + (size_t)d * K + k0 + 8 * c) = o; }
    asm volatile("s_waitcnt lgkmcnt(0)" ::: "memory");
}
template <int ROWMAP = 0> __device__ __forceinline__ void convert_matrix(const float* W, int K, int N, int Npad, bf16_t* WT, LAS float* scr, int gw, int NGW, int lane) {
    const int nblk = Npad / 64, nitems = (K / 64) * nblk;
    for (int it = gw; it < nitems; it += NGW) transpose_item<ROWMAP>(W, K, N, WT, scr, it, nblk, lane);
}

__device__ __forceinline__ void norm_mod_phase(const float* xin, const float* g, const float* modl, int sh_off, int sc_off, bf16_t* XN, int gw, int NGW, int lane) {
    for (int row = gw; row < MTOK; row += 2 * NGW) {
        const int row2 = row + NGW;
        const f32x4* xr = (const f32x4*)(xin + (size_t)row * DM) + lane; const f32x4* xr2 = (const f32x4*)(xin + (size_t)row2 * DM) + lane;
        f32x4 v[8], v2[8]; float ss = 0.f, ss2 = 0.f;
#pragma unroll
        for (int j = 0; j < 8; ++j) { v[j] = xr[64 * j]; v2[j] = xr2[64 * j]; }
#pragma unroll
        for (int j = 0; j < 8; ++j) { ss += (v[j].x * v[j].x + v[j].y * v[j].y) + (v[j].z * v[j].z + v[j].w * v[j].w); ss2 += (v2[j].x * v2[j].x + v2[j].y * v2[j].y) + (v2[j].z * v2[j].z + v2[j].w * v2[j].w); }
        ss = wave_sum(ss); ss2 = wave_sum(ss2);
        const float r = rsqrtf(ss * (1.f / DM) + EPS), r2 = rsqrtf(ss2 * (1.f / DM) + EPS);
        const float* mb = modl + (size_t)(row >> 12) * 12288; const float* mb2 = modl + (size_t)(row2 >> 12) * 12288;
#pragma unroll
        for (int j = 0; j < 8; ++j) { const int col = 4 * (64 * j + lane);
            const f32x4 g4 = *(const f32x4*)(g + col);
            { const f32x4 sc = *(const f32x4*)(mb + sc_off + col), sh = *(const f32x4*)(mb + sh_off + col);
              const f32x4 y = v[j] * r * g4; const f32x4 h = y * (sc + 1.f) + sh;
              u32x2 w; w.x = pk2(h.x, h.y); w.y = pk2(h.z, h.w); *(u32x2*)(XN + (size_t)row * DM + col) = w; }
            { const f32x4 sc = *(const f32x4*)(mb2 + sc_off + col), sh = *(const f32x4*)(mb2 + sh_off + col);
              const f32x4 y = v2[j] * r2 * g4; const f32x4 h = y * (sc + 1.f) + sh;
              u32x2 w; w.x = pk2(h.x, h.y); w.y = pk2(h.z, h.w); *(u32x2*)(XN + (size_t)row2 * DM + col) = w; } }
    }
}

__device__ __forceinline__ void conv_gate_phase(const bf16_t* U, const float* cw, const float* cb, bf16_t* Gout, int G, int tid) {
    for (int item = blockIdx.x * 512 + tid; item < 1024 * 704; item += G * 512) {
        const int cg8 = item % 704, run = item / 704; const int row0 = run * 16, c0 = cg8 * 8; const bool first = (row0 & 4095) == 0;
        float wg[3][8], wv[3][8], bg[8], bv[8];
#pragma unroll
        for (int j = 0; j < 3; ++j) {
            const f32x4 a0 = *(const f32x4*)(cw + j * DFF2 + c0), a1 = *(const f32x4*)(cw + j * DFF2 + c0 + 4);
            const f32x4 b0 = *(const f32x4*)(cw + j * DFF2 + DFF + c0), b1 = *(const f32x4*)(cw + j * DFF2 + DFF + c0 + 4);
#pragma unroll
            for (int e = 0; e < 4; ++e) { wg[j][e] = a0[e]; wg[j][4 + e] = a1[e]; wv[j][e] = b0[e]; wv[j][4 + e] = b1[e]; }
        }
        { const f32x4 a0 = *(const f32x4*)(cb + c0), a1 = *(const f32x4*)(cb + c0 + 4), b0 = *(const f32x4*)(cb + DFF + c0), b1 = *(const f32x4*)(cb + DFF + c0 + 4);
#pragma unroll
          for (int e = 0; e < 4; ++e) { bg[e] = a0[e]; bg[4 + e] = a1[e]; bv[e] = b0[e]; bv[4 + e] = b1[e]; } }
        float g2[8], g1[8], v2[8], v1[8];
#pragma unroll
        for (int e = 0; e < 8; ++e) { g2[e] = 0.f; g1[e] = 0.f; v2[e] = 0.f; v1[e] = 0.f; }
        if (!first) {
            const u32x4 a = *(const u32x4*)(U + (size_t)(row0 - 2) * DFF2 + c0), b = *(const u32x4*)(U + (size_t)(row0 - 2) * DFF2 + DFF + c0);
            const u32x4 c = *(const u32x4*)(U + (size_t)(row0 - 1) * DFF2 + c0), d = *(const u32x4*)(U + (size_t)(row0 - 1) * DFF2 + DFF + c0);
#pragma unroll
            for (int e = 0; e < 4; ++e) { g2[2 * e] = bflo(a[e]); g2[2 * e + 1] = bfhi(a[e]); v2[2 * e] = bflo(b[e]); v2[2 * e + 1] = bfhi(b[e]);
                                          g1[2 * e] = bflo(c[e]); g1[2 * e + 1] = bfhi(c[e]); v1[2 * e] = bflo(d[e]); v1[2 * e + 1] = bfhi(d[e]); }
        }
#pragma unroll 8
        for (int t = 0; t < 16; ++t) {
            const u32x4 a = *(const u32x4*)(U + (size_t)(row0 + t) * DFF2 + c0), b = *(const u32x4*)(U + (size_t)(row0 + t) * DFF2 + DFF + c0);
            float gc[8], vc[8], r[8];
#pragma unroll
            for (int e = 0; e < 4; ++e) { gc[2 * e] = bflo(a[e]); gc[2 * e + 1] = bfhi(a[e]); vc[2 * e] = bflo(b[e]); vc[2 * e + 1] = bfhi(b[e]); }
#pragma unroll
            for (int e = 0; e < 8; ++e) {
                const float gg = wg[0][e] * g2[e] + wg[1][e] * g1[e] + wg[2][e] * gc[e] + bg[e];
                const float vv = wv[0][e] * v2[e] + wv[1][e] * v1[e] + wv[2][e] * vc[e] + bv[e];
                r[e] = gg / (1.f + __expf(-gg)) * vv;
                g2[e] = g1[e]; g1[e] = gc[e]; v2[e] = v1[e]; v1[e] = vc[e];
            }
            u32x4 o; o.x = pk2(r[0], r[1]); o.y = pk2(r[2], r[3]); o.z = pk2(r[4], r[5]); o.w = pk2(r[6], r[7]);
            *(u32x4*)(Gout + (size_t)(row0 + t) * DFF + c0) = o;
        }
    }
}

#define XB_TMO      128
#define XB_XCNT(j)  (256  + 64 * (j))
#define XB_XSUB(j)  (1280 + 64 * (j))
#define XB_XGEN(j)  (2304 + 64 * (j))
#define XB_TOP      3328
#define XB_TOPGEN   3392
#define XCD_BAR_WORDS 3456
#define XB_SPIN_CAP (1u << 18)

__device__ __forceinline__ unsigned xb_ld(unsigned* p)              { return __hip_atomic_load(p, __ATOMIC_RELAXED, __HIP_MEMORY_SCOPE_AGENT); }
__device__ __forceinline__ unsigned xb_add(unsigned* p, unsigned v) { return __hip_atomic_fetch_add(p, v, __ATOMIC_RELAXED, __HIP_MEMORY_SCOPE_AGENT); }
__device__ __forceinline__ unsigned xb_xcc_id() { return (unsigned)__builtin_amdgcn_s_getreg((3 << 11) | 20) & 0xFu; }
#define XB_SPIN(cond, bar) do { unsigned _sp = 0; while (cond) { __builtin_amdgcn_s_sleep(1); \
    if ((++_sp & 255u) == 0u) { if (xb_ld(&(bar)[XB_TMO])) break; if (_sp > XB_SPIN_CAP) { atomicAdd(&(bar)[XB_TMO], 1u); break; } } } } while (0)

struct XcdBarrier {
    unsigned* bar; unsigned x;
    volatile LAS unsigned* st;
};

__device__ __forceinline__ XcdBarrier xcd_barrier_post(unsigned* bar, volatile LAS unsigned* st) {
    XcdBarrier b; b.bar = bar; b.x = (unsigned)__builtin_amdgcn_readfirstlane((int)xb_xcc_id()); b.st = st;
    if (threadIdx.x == 0) (void)xb_add(&bar[XB_XCNT(b.x)], 1u);
    return b;
}
__device__ __forceinline__ void xcd_barrier_complete(unsigned* bar, unsigned x, unsigned& nloc, unsigned& nx) {
    const unsigned G = gridDim.x * gridDim.y * gridDim.z;
    unsigned sum, cnt, mine, sp = 0u;
    for (;;) {
        sum = 0u; cnt = 0u; mine = 0u;
#pragma unroll
        for (unsigned j = 0; j < 16; ++j) { const unsigned c = xb_ld(&bar[XB_XCNT(j)]); sum += c; cnt += (c > 0u) ? 1u : 0u; mine = (j == x) ? c : mine; }
        if (sum == G) break;
        __builtin_amdgcn_s_sleep(1);
        if ((++sp & 255u) == 0u) { if (xb_ld(&bar[XB_TMO])) break; if (sp > XB_SPIN_CAP) { atomicAdd(&bar[XB_TMO], 1u); break; } }
    }
    nloc = mine > 0u ? mine : 1u; nx = cnt > 0u ? cnt : 1u;
}

__device__ __forceinline__ void xcd_barrier(const XcdBarrier& b) {
    asm volatile("s_waitcnt vmcnt(0)" ::: "memory");
    __syncthreads();
    if (threadIdx.x == 0) {
        unsigned* bar = b.bar;
        __builtin_amdgcn_s_waitcnt(0);
        unsigned nloc = b.st[0], nx = b.st[1];
        if (nloc == 0u) { xcd_barrier_complete(bar, b.x, nloc, nx); b.st[0] = nloc; b.st[1] = nx; }
        const unsigned old = xb_add(&bar[XB_XSUB(b.x)], 1u);
        const unsigned gen = old / nloc;
        if (old + 1u == (gen + 1u) * nloc) {
            __builtin_amdgcn_fence(__ATOMIC_RELEASE, "agent");
            asm volatile("s_waitcnt vmcnt(0)" ::: "memory");
            const unsigned og = xb_add(&bar[XB_TOP], 1u);
            const unsigned tg = og / nx;
            if (og + 1u == (tg + 1u) * nx) xb_add(&bar[XB_TOPGEN], 1u);
            else XB_SPIN(xb_ld(&bar[XB_TOPGEN]) == tg, bar);
            __builtin_amdgcn_fence(__ATOMIC_ACQUIRE, "agent");
            xb_add(&bar[XB_XGEN(b.x)], 1u);
            asm volatile("s_waitcnt vmcnt(0)" ::: "memory");
        } else {
            XB_SPIN(xb_ld(&bar[XB_XGEN(b.x)]) == gen, bar);
            __builtin_amdgcn_fence(__ATOMIC_ACQUIRE, "agent");
            asm volatile("s_waitcnt vmcnt(0)" ::: "memory");
        }
    }
    __syncthreads();
}

__global__ void __launch_bounds__(512, 2) mega_fwd(Args a) {
    extern __shared__ __attribute__((aligned(16))) unsigned char lds[];
    cg::grid_group grid = cg::this_grid();
    LAS unsigned char* L = (LAS unsigned char*)lds;
    const int G = gridDim.x, NGW = G * 8;
    { LAS unsigned* mz = (LAS unsigned*)(L + 155648); if (threadIdx.x < 16) mz[threadIdx.x] = 0u; }
    if (blockIdx.x == 0 && threadIdx.x < 64) { unsigned* bw = (unsigned*)(a.ws + 458752);
        for (int i = threadIdx.x; i < 4096; i += 64) __hip_atomic_store(bw + i, 0u, __ATOMIC_RELAXED, __HIP_MEMORY_SCOPE_AGENT);
        __builtin_amdgcn_fence(__ATOMIC_RELEASE, "agent"); asm volatile("s_waitcnt vmcnt(0)" ::: "memory"); }
    __syncthreads();
    grid.sync();
    const XcdBarrier xbar = xcd_barrier_post((unsigned*)(a.ws + 458752), (volatile LAS unsigned*)(L + 155648));
#if DIAG
    unsigned long long* TS = (unsigned long long*)(a.ws + 460800); int ts_n = 0;
#define TSTAMP() do { if (blockIdx.x == 0 && threadIdx.x == 0) TS[ts_n] = __builtin_amdgcn_s_memrealtime(); ++ts_n; } while (0)
#else
#define TSTAMP() do { } while (0)
#endif
#define GSYNC() do { XcdBarrier xb2_; xb2_.bar = (unsigned*)(a.ws + 458752); { unsigned xx_ = xbar.x; asm volatile("" : "+s"(xx_)); xb2_.x = xx_; } xb2_.st = (volatile LAS unsigned*)(L + 155648); xcd_barrier(xb2_); TSTAMP(); } while (0)
#define IDS int tid = threadIdx.x; asm volatile("" : "+v"(tid)); const int lane = tid & 63, wave = __builtin_amdgcn_readfirstlane(tid >> 6), fr = lane & 15, fq = lane >> 4; const int gw = blockIdx.x * 8 + wave; (void)fr; (void)fq; (void)gw; (void)lane; \
            LAS float* scr = (LAS float*)(L + wave * 16640); (void)scr;
    unsigned char* ws = a.ws;
    float* MOD = (float*)(ws + WS_MOD);
    bf16_t* WUKT = (bf16_t*)(ws + WS_WUKT); bf16_t* WUVT = (bf16_t*)(ws + WS_WUVT);
    bf16_t* WIN = (bf16_t*)(ws + WS_WIN); bf16_t* WOUT = (bf16_t*)(ws + WS_WOUT); bf16_t* WUP = (bf16_t*)(ws + WS_WUP); bf16_t* WDN = (bf16_t*)(ws + WS_WDN);
    bf16_t* XN = (bf16_t*)(ws + WS_XN); bf16_t* PROJ = (bf16_t*)(ws + WS_BIG); bf16_t* UB = (bf16_t*)(ws + WS_BIG); bf16_t* QLAT = (bf16_t*)(ws + WS_QLAT);
    bf16_t* GB = (bf16_t*)(ws + WS_G); bf16_t* ATT = (bf16_t*)(ws + WS_ATT); bf16_t* CKV = (bf16_t*)(ws + WS_CKV);
    int* IDX = (int*)(ws + WS_IDX); int* CNT = (int*)(ws + WS_CNT); float* HBUF = (float*)(ws + WS_BIG); bf16_t* KIC = (bf16_t*)(ws + WS_CNT + MiB);
    const float* x_in = a.in[0]; const float* rel_bias = a.in[2];
    float* xres = a.out;

    TSTAMP();
    {
        IDS
        LAS float* cs = (LAS float*)L; LAS float* red = cs + 8192;
        for (int it = blockIdx.x; it < 256; it += G) {
            const int i = it >> 7, jc = it & 127;
            for (int idx = tid; idx < 8192; idx += 512) { const float v = a.in[1][idx]; cs[idx] = v / (1.f + expf(-v)); }
            __syncthreads();
            if (tid < 384) {
                const int cq = tid % 24, kg = tid / 24;
                const float* w = a.in[3] + (size_t)i * 2048 * 12288 + jc * 96 + cq * 4;
                f32x4 ac[4];
#pragma unroll
                for (int b = 0; b < 4; ++b) ac[b] = (f32x4){0.f, 0.f, 0.f, 0.f};
#pragma unroll 8
                for (int kk = 0; kk < 128; ++kk) { const int k = kg * 128 + kk; const f32x4 wv = *(const f32x4*)(w + (size_t)k * 12288);
#pragma unroll
                    for (int b = 0; b < 4; ++b) ac[b] += wv * cs[b * 2048 + k]; }
#pragma unroll
                for (int b = 0; b < 4; ++b) *(LAS f32x4*)(red + (kg * 4 + b) * 96 + cq * 4) = ac[b];
            }
            __syncthreads();
            if (tid < 384) { const int b = tid / 96, col = tid % 96; float s = a.in[4][i * 12288 + jc * 96 + col];
#pragma unroll
              for (int k2 = 0; k2 < 16; ++k2) s += red[(k2 * 4 + b) * 96 + col];
              MOD[(size_t)(i * 4 + b) * 12288 + jc * 96 + col] = s; }
            __syncthreads();
        }
        convert_matrix(a.in[7], 2048, EV_IN, EV_PITCH, WIN, scr, gw, NGW, lane);
        convert_matrix(a.in[12], 2048, 2048, 2048, WOUT, scr, gw, NGW, lane);
        convert_matrix<1>(a.in[15], 2048, DFF2, DFF2, WUP, scr, gw, NGW, lane);
        convert_matrix(a.in[18], DFF, 2048, 2048, WDN, scr, gw, NGW, lane);
        for (int h = 0; h < 16; ++h) {
            convert_matrix(a.in[9] + (size_t)h * 64 * 256, 64, 256, 256, WUKT + (size_t)h * 256 * 64, scr, gw, NGW, lane);
            convert_matrix(a.in[10] + (size_t)h * 256 * 64, 256, 64, 64, WUVT + (size_t)h * 64 * 256, scr, gw, NGW, lane);
        }
    }
    GSYNC();

#pragma unroll
    for (int layer = 0; layer < 2; ++layer) {
        const float* modl = MOD + (size_t)layer * 4 * 12288;
        const float* xcur = (layer == 0) ? x_in : (const float*)xres;
        { IDS
        norm_mod_phase(xcur, a.in[5] + layer * DM, modl, 0, 2048, XN, gw, NGW, lane);
        if (layer == 1) {
            convert_matrix(a.in[13], 2048, OD_PITCH, OD_PITCH, WIN, scr, gw, NGW, lane);
            convert_matrix(a.in[14], 2048, 2048, 2048, WOUT, scr, gw, NGW, lane);
            convert_matrix<1>(a.in[15] + (size_t)2048 * DFF2, 2048, DFF2, DFF2, WUP, scr, gw, NGW, lane);
            convert_matrix(a.in[18] + (size_t)DFF * 2048, DFF, 2048, 2048, WDN, scr, gw, NGW, lane);
        } }
        GSYNC();
#if SKIP_SWA || SKIP_DSA || SKIP_SB
        { IDS for (size_t i = (size_t)blockIdx.x * 512 + tid; i < (size_t)MTOK * DM / 8; i += (size_t)G * 512) ((u32x4*)ATT)[i] = (u32x4){0u, 0u, 0u, 0u}; }
#endif
        if (layer == 0) {
            { pg8::Gemm g{XN, WIN, MTOK, EV_PITCH, 2048}; pg8::StaticOrder S; S.init(MTOK, EV_PITCH, G, (int)blockIdx.x);
              pg8::EpiBf16 E{PROJ, EV_PITCH, KIC, C_KI / 256};
              pg8::gemm_phase<pg8::EpiBf16, pg8::StaticOrder, true, true>(L, g, S, E); }
            GSYNC();
            { IDS
            for (int row = gw; row < MTOK; row += 4 * NGW) {
                u32x2 w[4]; float ss[4];
#pragma unroll
                for (int q = 0; q < 4; ++q) w[q] = *(const u32x2*)(PROJ + (size_t)(row + q * NGW) * EV_PITCH + C_CLAT + 4 * lane);
                const f32x4 g4 = *(const f32x4*)(a.in[8] + 4 * lane);
#pragma unroll
                for (int q = 0; q < 4; ++q) { const float x0 = bflo(w[q].x), x1 = bfhi(w[q].x), x2 = bflo(w[q].y), x3 = bfhi(w[q].y); ss[q] = (x0 * x0 + x1 * x1) + (x2 * x2 + x3 * x3); }
#pragma unroll
                for (int o_ = 1; o_ < 64; o_ <<= 1) {
#pragma unroll
                    for (int q = 0; q < 4; ++q) ss[q] += __shfl_xor(ss[q], o_); }
#pragma unroll
                for (int q = 0; q < 4; ++q) { const float x0 = bflo(w[q].x), x1 = bfhi(w[q].x), x2 = bflo(w[q].y), x3 = bfhi(w[q].y);
                    const float r = rsqrtf(ss[q] * (1.f / 256.f) + EPS);
                    u32x2 o; o.x = pk2(x0 * r * g4.x, x1 * r * g4.y); o.y = pk2(x2 * r * g4.z, x3 * r * g4.w);
                    *(u32x2*)(CKV + (size_t)(row + q * NGW) * 256 + 4 * lane) = o; }
            } }
            { IDS
            for (int unit = gw; unit < 16384; unit += 2 * NGW) {
                const int h = unit & 15, t0 = (unit >> 4) * 16, t1 = ((unit + NGW) >> 4) * 16;
                bf16x8 bq[2], bq2[2];
#pragma unroll
                for (int ks = 0; ks < 2; ++ks) { bq[ks] = *(const bf16x8*)(PROJ + (size_t)(t0 + fr) * EV_PITCH + C_QB + h * 64 + 32 * ks + 8 * fq);
                                                 bq2[ks] = *(const bf16x8*)(PROJ + (size_t)(t1 + fr) * EV_PITCH + C_QB + h * 64 + 32 * ks + 8 * fq); }
#pragma unroll
                for (int rg = 0; rg < 2; ++rg) {
                    bf16x8 aw[8][2];
#pragma unroll
                    for (int r8 = 0; r8 < 8; ++r8)
#pragma unroll
                        for (int ks = 0; ks < 2; ++ks) aw[r8][ks] = *(const bf16x8*)(WUKT + (size_t)(h * 256 + 16 * (8 * rg + r8) + fr) * 64 + 32 * ks + 8 * fq);
#pragma unroll
                    for (int r8 = 0; r8 < 8; ++r8) { const int rt = 8 * rg + r8;
                        f32x4 acc = (f32x4){0.f, 0.f, 0.f, 0.f}, acc2 = acc;
                        acc = MFMA16(aw[r8][0], bq[0], acc); acc2 = MFMA16(aw[r8][0], bq2[0], acc2); acc = MFMA16(aw[r8][1], bq[1], acc); acc2 = MFMA16(aw[r8][1], bq2[1], acc2);
                        u32x2 o; o.x = pk2(acc[0] * 0.125f, acc[1] * 0.125f); o.y = pk2(acc[2] * 0.125f, acc[3] * 0.125f);
                        *(u32x2*)(QLAT + ((size_t)(t0 + fr) * 16 + h) * 256 + 16 * rt + 4 * fq) = o;
                        u32x2 o2; o2.x = pk2(acc2[0] * 0.125f, acc2[1] * 0.125f); o2.y = pk2(acc2[2] * 0.125f, acc2[3] * 0.125f);
                        *(u32x2*)(QLAT + ((size_t)(t1 + fr) * 16 + h) * 256 + 16 * rt + 4 * fq) = o2; }
                }
            } }
#if !SKIP_DSA
            {
                IDS
                LAS float* sc = (LAS float*)L;
                __syncthreads();
                for (int uu = blockIdx.x; uu < 2048; uu += G) {
                    const int kk = uu / G, bi = uu - kk * G;
                    const int unit = (G == 256) ? ((kk >> 1) * 512 + ((kk & 1) ? 511 - bi : bi)) : uu;
                    const int row0 = unit * 8, b = row0 >> 12, c = (row0 & 4095) >> 6, nall = (c + 1) * 64;
                    const int row = row0 + wave;
                    int* idxp = IDX + (size_t)row * 256;
                    if (nall <= 256) { for (int i = lane; i < nall; i += 64) idxp[i] = i; if (lane == 0) CNT[row] = nall; continue; }
                    const int nquads = c + 1, ntiles = nall >> 4;
                    bf16x8 qa[4][2];
#pragma unroll
                    for (int hp = 0; hp < 4; ++hp)
#pragma unroll
                        for (int ks = 0; ks < 2; ++ks) qa[hp][ks] = *(const bf16x8*)(PROJ + (size_t)(row0 + (fr & 7)) * EV_PITCH + C_QI + (2 * hp + (fr >> 3)) * 64 + 32 * ks + 8 * fq);
                    float wq[4][4];
#pragma unroll
                    for (int j = 0; j < 4; ++j) { const u32x4 ww = *(const u32x4*)(PROJ + (size_t)(row0 + 4 * (fq & 1) + j) * EV_PITCH + C_WI);
#pragma unroll
                        for (int hp = 0; hp < 4; ++hp) wq[hp][j] = (fq >> 1) ? bfhi(ww[hp]) : bflo(ww[hp]); }
                    const bf16_t* kbase = KIC + ((size_t)b * SEQ + fr) * 64 + 8 * fq;
#pragma unroll 8
                    for (int t = wave; t < ntiles; t += 8) {
                        const bf16_t* kp = kbase + (size_t)(16 * t) * 64;
                        const bf16x8 b0 = *(const bf16x8*)kp, b1 = *(const bf16x8*)(kp + 32);
                        float part[4] = {0.f, 0.f, 0.f, 0.f};
#pragma unroll
                        for (int hp = 0; hp < 4; ++hp) {
                            f32x4 acc = (f32x4){0.f, 0.f, 0.f, 0.f};
                            acc = MFMA16(qa[hp][0], b0, acc); acc = MFMA16(qa[hp][1], b1, acc);
#pragma unroll
                            for (int j = 0; j < 4; ++j) part[j] += wq[hp][j] * fmaxf(acc[j], 0.f);
                        }
#pragma unroll
                        for (int j = 0; j < 4; ++j) part[j] += __shfl_xor(part[j], 32);
                        if (fq < 2) {
#pragma unroll
                            for (int j = 0; j < 4; ++j) sc[(4 * fq + j) * 4096 + 16 * t + fr] = part[j];
                        }
                    }
                    __syncthreads();
                    unsigned v[64];
#pragma unroll
                    for (int q = 0; q < 64; ++q) {
                        unsigned val = 0u;
                        if (q < nquads) { unsigned u = __float_as_uint(sc[wave * 4096 + 64 * q + lane]); if (u == 0x80000000u) u = 0u; val = (u & 0x80000000u) ? ~u : (u | 0x80000000u); }
                        v[q] = val;
                    }
                    unsigned T = 0u;
                    for (int bit = 31; bit >= 0; --bit) {
                        const unsigned cand = T | (1u << bit); int cnt = 0;
#pragma unroll
                        for (int qg = 0; qg < 4; ++qg) {
                            if (16 * qg < nquads) {
#pragma unroll
                                for (int q = 16 * qg; q < 16 * qg + 16; ++q) cnt += __popcll(__ballot(v[q] >= cand));
                            }
                        }
                        if (cnt >= 256) T = cand;
                        if (cnt == 256) break;
                    }
                    int cgt = 0;
#pragma unroll
                    for (int q = 0; q < 64; ++q) cgt += __popcll(__ballot(v[q] > T));
                    int need = 256 - cgt, pos = 0;
                    const unsigned long long ltmask = (1ull << lane) - 1ull;
#pragma unroll
                    for (int q = 0; q < 64; ++q) {
                        if (q < nquads) {
                            const bool gt = v[q] > T, eq = v[q] == T;
                            const unsigned long long meq = __ballot(eq);
                            const int eqrank = __popcll(meq & ltmask);
                            const bool sel = gt || (eq && eqrank < need);
                            const unsigned long long msel = __ballot(sel);
                            if (sel) idxp[pos + __popcll(msel & ltmask)] = q * 64 + lane;
                            pos += __popcll(msel);
                            const int neq = __popcll(meq); need -= (neq < need ? neq : need);
                        }
                    }
                    if (lane == 0) CNT[row] = 256;
                    __syncthreads();
                }
            }
#endif
#if !SKIP_SWA
            {
                IDS
                LAS bf16_t* Vt = (LAS bf16_t*)L;
                LAS float* bT = (LAS float*)(L + 64 * 200 * 2);
                LAS bf16_t* Kl = (LAS bf16_t*)(L + 64 * 200 * 2 + 4096);
                __syncthreads();
                { const int kvh0 = blockIdx.x & 3;
                  for (int idx = tid; idx < 1024; idx += 512) { const int g = idx >> 8, ri = idx & 255; bT[idx] = rel_bias[t5_bucket(ri - 191) * 32 + kvh0 * 4 + g]; } }
                for (int unit = blockIdx.x; unit < 1024; unit += G) {
                    const int b = unit >> 8, c = (unit >> 2) & 63, kvh = unit & 3;
                    const int kstart = (c >= 2 ? c - 2 : 0) * 64, nk = (c + 1) * 64 - kstart;
                    const size_t rowbase = (size_t)b * SEQ;
                    bf16x8 bq0[2], bq1[2];
                    { const int g_ = wave >> 1, qh_ = wave & 1, head_ = kvh * 4 + g_, q0_ = c * 64 + qh_ * 32;
#pragma unroll
                      for (int ks = 0; ks < 2; ++ks) { bq0[ks] = *(const bf16x8*)(PROJ + (rowbase + q0_ + fr) * EV_PITCH + C_QA + head_ * 64 + 32 * ks + 8 * fq);
                                                       bq1[ks] = *(const bf16x8*)(PROJ + (rowbase + q0_ + 16 + fr) * EV_PITCH + C_QA + head_ * 64 + 32 * ks + 8 * fq); } }
                    { u32x4 kx[3], vx[3];
#pragma unroll
                      for (int it = 0; it < 3; ++it) { const int i = tid + 512 * it; int key = i >> 3; const int ch = i & 7; key = key < nk ? key : nk - 1;
                          const bf16_t* src = PROJ + (rowbase + kstart + key) * EV_PITCH + kvh * 64 + ch * 8;
                          kx[it] = *(const u32x4*)(src + C_KA); vx[it] = *(const u32x4*)(src + C_VA); }
#pragma unroll
                      for (int it = 0; it < 3; ++it) { const int i = tid + 512 * it; const int key = i >> 3, ch = i & 7;
                          *(LAS u32x4*)(Kl + key * 72 + ch * 8) = kx[it];
                          const u32x4 w = vx[it]; LAS bf16_t* vp = Vt + (ch * 8) * 200 + key;
                          vp[0 * 200] = (bf16_t)(w.x & 0xffffu); vp[1 * 200] = (bf16_t)(w.x >> 16); vp[2 * 200] = (bf16_t)(w.y & 0xffffu); vp[3 * 200] = (bf16_t)(w.y >> 16);
                          vp[4 * 200] = (bf16_t)(w.z & 0xffffu); vp[5 * 200] = (bf16_t)(w.z >> 16); vp[6 * 200] = (bf16_t)(w.w & 0xffffu); vp[7 * 200] = (bf16_t)(w.w >> 16); } }
                    __syncthreads();
                    const int g = wave >> 1, qh = wave & 1, head = kvh * 4 + g, q0 = c * 64 + qh * 32;
                    const int ntile = nk >> 4;
                    const float sink = a.in[11][head];
#pragma unroll 1
                    for (int m = 0; m < 2; ++m) {
                        const int qpos = q0 + 16 * m + fr;
                        bf16x8 bq[2];
#pragma unroll
                        for (int ks = 0; ks < 2; ++ks) bq[ks] = m ? bq1[ks] : bq0[ks];
                        f32x4 s1[12];
                        float mx = -1e30f;
#pragma unroll
                        for (int t = 0; t < 12; ++t) {
                            if (t < ntile) {
                                const LAS bf16_t* kp = Kl + (16 * t + fr) * 72 + 8 * fq;
                                const bf16x8 k0 = *(const LAS bf16x8*)kp, k1 = *(const LAS bf16x8*)(kp + 32);
                                f32x4 acc = (f32x4){0.f, 0.f, 0.f, 0.f}; acc = MFMA16(k0, bq[0], acc); acc = MFMA16(k1, bq[1], acc);
#pragma unroll
                                for (int j = 0; j < 4; ++j) { const int ri = (kstart + 16 * t + 4 * fq + j) - qpos + 191; const float vv = acc[j] * 0.125f + bT[g * 256 + ri]; acc[j] = vv; mx = fmaxf(mx, vv); }
                                s1[t] = acc;
                            } else s1[t] = (f32x4){0.f, 0.f, 0.f, 0.f};
                        }
                        mx = fmaxf(mx, __shfl_xor(mx, 16)); mx = fmaxf(mx, __shfl_xor(mx, 32)); mx = fmaxf(mx, sink);
                        float sum = 0.f;
#pragma unroll
                        for (int t = 0; t < 12; ++t)
                            if (t < ntile) {
#pragma unroll
                                for (int j = 0; j < 4; ++j) { const float p = __expf(s1[t][j] - mx); s1[t][j] = p; sum += p; }
                            }
                        sum += __shfl_xor(sum, 16); sum += __shfl_xor(sum, 32);
                        const float inv = 1.f / (sum + __expf(sink - mx));
                        f32x4 o[4];
#pragma unroll
                        for (int dt = 0; dt < 4; ++dt) o[dt] = (f32x4){0.f, 0.f, 0.f, 0.f};
#pragma unroll
                        for (int st = 0; st < 6; ++st) {
                            if (2 * st < ntile) {
                                const bf16x8 pb = mk8(pk2(s1[2 * st][0], s1[2 * st][1]), pk2(s1[2 * st][2], s1[2 * st][3]), pk2(s1[2 * st + 1][0], s1[2 * st + 1][1]), pk2(s1[2 * st + 1][2], s1[2 * st + 1][3]));
#pragma unroll
                                for (int dt = 0; dt < 4; ++dt) {
                                    const LAS bf16_t* vp = Vt + (16 * dt + fr) * 200 + 32 * st + 4 * fq;
                                    const u32x2 lo = *(const LAS u32x2*)vp, hi = *(const LAS u32x2*)(vp + 16);
                                    o[dt] = MFMA16(mk8(lo.x, lo.y, hi.x, hi.y), pb, o[dt]);
                                }
                            }
                        }
#pragma unroll
                        for (int dt = 0; dt < 4; ++dt) { u32x2 w; w.x = pk2(o[dt][0] * inv, o[dt][1] * inv); w.y = pk2(o[dt][2] * inv, o[dt][3] * inv);
                            *(u32x2*)(ATT + (rowbase + qpos) * DM + head * 64 + 16 * dt + 4 * fq) = w; }
                    }
                    __syncthreads();
                }
            }
#endif
                        GSYNC();
#if !SKIP_DSA
            {
                IDS
                LAS float* bB = (LAS float*)(L + 8 * 16896);
                if (tid < 512) bB[tid] = rel_bias[(tid >> 4) * 32 + 16 + (tid & 15)];
                __syncthreads();
                LAS bf16_t* cb = (LAS bf16_t*)(L + wave * 16896);
                for (int row = gw; row < MTOK; row += NGW) {
                    const int b = row >> 12, tpos = row & 4095; const size_t rowbase = (size_t)b * SEQ;
                    const int cnt = __builtin_amdgcn_readfirstlane(CNT[row]); const int nch = cnt >> 5;
                    bf16x8 ql[8];
#pragma unroll
                    for (int ks = 0; ks < 8; ++ks) ql[ks] = *(const bf16x8*)(QLAT + ((size_t)row * 16 + fr) * 256 + 32 * ks + 8 * fq);
                    f32x4 o[16];
#pragma unroll
                    for (int rt = 0; rt < 16; ++rt) o[rt] = (f32x4){0.f, 0.f, 0.f, 0.f};
                    float mrun = -1e30f, lpart = 0.f;
                    int idxall[4];
#pragma unroll
                    for (int i = 0; i < 4; ++i) { const int e = 64 * i + lane; idxall[i] = (e < cnt) ? IDX[(size_t)row * 256 + e] : 0; }
                    u32x4 gw[16];
#define DSA_ISSUE(CH) do { const int c_ = (CH); const int s01_ = (c_ & 2) ? idxall[1] : idxall[0], s23_ = (c_ & 2) ? idxall[3] : idxall[2]; const int sel_ = (c_ & 4) ? s23_ : s01_; const int bl_ = 32 * (c_ & 1); \
        _Pragma("unroll") for (int it = 0; it < 16; ++it) { const int key = 2 * it + (lane >> 5), seg = lane & 31; const int kidx = __shfl(sel_, bl_ + key); \
            gw[it] = *(const u32x4*)(CKV + (rowbase + kidx) * 256 + seg * 8); } } while (0)
                    DSA_ISSUE(0);
                    for (int ch = 0; ch < nch; ++ch) {
                        const int s01 = (ch & 2) ? idxall[1] : idxall[0], s23 = (ch & 2) ? idxall[3] : idxall[2]; const int myidx = (ch & 4) ? s23 : s01; const int mybl = 32 * (ch & 1);
#pragma unroll
                        for (int it = 0; it < 16; ++it) { const int key = 2 * it + (lane >> 5), seg = lane & 31; *(LAS u32x4*)(cb + key * 264 + seg * 8) = gw[it]; }
                        asm volatile("s_waitcnt lgkmcnt(0)" ::: "memory");
                        if (ch + 1 < nch) DSA_ISSUE(ch + 1);
                        f32x4 sa[2];
#pragma unroll
                        for (int kt = 0; kt < 2; ++kt) { f32x4 acc = (f32x4){0.f, 0.f, 0.f, 0.f};
#pragma unroll
                            for (int ks = 0; ks < 8; ++ks) { const bf16x8 ac = *(const LAS bf16x8*)(cb + (16 * kt + fr) * 264 + 32 * ks + 8 * fq); acc = MFMA16(ac, ql[ks], acc); }
                            sa[kt] = acc; }
                        float cm = -1e30f;
                        const int mybucket = t5_bucket(__shfl(myidx, mybl + (lane & 31)) - tpos) * 16;
#pragma unroll
                        for (int kt = 0; kt < 2; ++kt)
#pragma unroll
                            for (int j = 0; j < 4; ++j) { const int bk = __shfl(mybucket, 16 * kt + 4 * fq + j); const float vv = sa[kt][j] + bB[bk + fr]; sa[kt][j] = vv; cm = fmaxf(cm, vv); }
                        cm = fmaxf(cm, __shfl_xor(cm, 16)); cm = fmaxf(cm, __shfl_xor(cm, 32));
                        const float mnew = fmaxf(mrun, cm), alpha = __expf(mrun - mnew); mrun = mnew;
                        float ps = 0.f;
#pragma unroll
                        for (int kt = 0; kt < 2; ++kt)
#pragma unroll
                            for (int j = 0; j < 4; ++j) { const float p = __expf(sa[kt][j] - mnew); sa[kt][j] = p; ps += p; }
                        lpart = lpart * alpha + ps;
                        if (__any(alpha != 1.f)) {
#pragma unroll
                            for (int rt = 0; rt < 16; ++rt) o[rt] *= alpha;
                        }
                        const bf16x8 pb = mk8(pk2(sa[0][0], sa[0][1]), pk2(sa[0][2], sa[0][3]), pk2(sa[1][0], sa[1][1]), pk2(sa[1][2], sa[1][3]));
#pragma unroll
                        for (int rt = 0; rt < 16; ++rt) {
                            const LAS bf16_t* cp = cb + (4 * fq + (fr >> 2)) * 264 + 16 * rt + 4 * (fr & 3);
                            const s16x4_t lo = lds_tr4(cp), hi = lds_tr4(cp + 16 * 264);
                            const bf16x8 av = __builtin_shufflevector(lo, hi, 0, 1, 2, 3, 4, 5, 6, 7);
                            o[rt] = MFMA16(av, pb, o[rt]);
                        }
                        asm volatile("s_waitcnt lgkmcnt(0)" ::: "memory");
                    }
                    float l = lpart + __shfl_xor(lpart, 16); l += __shfl_xor(l, 32);
                    const float inv = 1.f / l;
#pragma unroll
                    for (int rt = 0; rt < 16; ++rt) { u32x2 w; w.x = pk2(o[rt][0] * inv, o[rt][1] * inv); w.y = pk2(o[rt][2] * inv, o[rt][3] * inv);
                        *(u32x2*)(QLAT + ((size_t)row * 16 + fr) * 256 + 16 * rt + 4 * fq) = w; }
                }
            }
#endif
            GSYNC();
#if !SKIP_DSA
            { IDS
            for (int unit = gw; unit < 16384; unit += NGW) {
                const int h = unit & 15, t0 = (unit >> 4) * 16;
                bf16x8 bo[8];
#pragma unroll
                for (int ks = 0; ks < 8; ++ks) bo[ks] = *(const bf16x8*)(QLAT + ((size_t)(t0 + fr) * 16 + h) * 256 + 32 * ks + 8 * fq);
#pragma unroll
                for (int dt = 0; dt < 4; ++dt) {
                    f32x4 acc = (f32x4){0.f, 0.f, 0.f, 0.f};
                    bf16x8 aw[8];
#pragma unroll
                    for (int ks = 0; ks < 8; ++ks) aw[ks] = *(const bf16x8*)(WUVT + (size_t)(h * 64 + 16 * dt + fr) * 256 + 32 * ks + 8 * fq);
#pragma unroll
                    for (int ks = 0; ks < 8; ++ks) acc = MFMA16(aw[ks], bo[ks], acc);
                    u32x2 w; w.x = pk2(acc[0], acc[1]); w.y = pk2(acc[2], acc[3]);
                    *(u32x2*)(ATT + (size_t)(t0 + fr) * DM + 1024 + h * 64 + 16 * dt + 4 * fq) = w;
                }
            } }
#endif
            GSYNC();
        } else {
            { pg8::Gemm g{XN, WIN, MTOK, OD_PITCH, 2048}; pg8::StaticOrder S; S.init(MTOK, OD_PITCH, G, (int)blockIdx.x);
              pg8::EpiBf16 E{PROJ, OD_PITCH, nullptr, 0};
              pg8::gemm_phase<pg8::EpiBf16, pg8::StaticOrder, true, true>(L, g, S, E); }
            GSYNC();
#if SKIP_SB == 2
            { IDS for (size_t i = (size_t)blockIdx.x * 512 + tid; i < (size_t)MTOK * 256; i += (size_t)G * 512) { const size_t row = i >> 8, c8 = i & 255; ((u32x4*)ATT)[i] = *(const u32x4*)(PROJ + row * OD_PITCH + 4096 + c8 * 8); } }
#endif
#if !SKIP_SB
            {
                IDS
                LAS bf16_t* vb = (LAS bf16_t*)(L + wave * 8704);
                for (int unit = gw; unit < 8192; unit += NGW) {
                    const int qt = 127 - (unit >> 6), h = unit & 15, b = (unit >> 4) & 3; const int q0 = qt * 32; const size_t rowbase = (size_t)b * SEQ;
                    bf16x8 bq[2][4];
#pragma unroll
                    for (int m = 0; m < 2; ++m)
#pragma unroll
                        for (int ks = 0; ks < 4; ++ks) bq[m][ks] = *(const bf16x8*)(PROJ + (rowbase + q0 + 16 * m + fr) * OD_PITCH + h * 128 + 32 * ks + 8 * fq);
                    f32x4 o[8][2];
#pragma unroll
                    for (int dt = 0; dt < 8; ++dt) { o[dt][0] = (f32x4){0.f, 0.f, 0.f, 0.f}; o[dt][1] = (f32x4){0.f, 0.f, 0.f, 0.f}; }
                    float Pc[2] = {1.f, 1.f};
                    for (int kb = qt; kb >= 0; --kb) {
                        bf16x8 akk[2][4];
                        { u32x4 gw[8];
#pragma unroll
                          for (int it = 0; it < 8; ++it) { const int key = 4 * it + (lane >> 4), seg = lane & 15;
                              gw[it] = *(const u32x4*)(PROJ + (rowbase + 32 * kb + key) * OD_PITCH + 4096 + h * 128 + seg * 8); }
#pragma unroll
                          for (int kt = 0; kt < 2; ++kt)
#pragma unroll
                              for (int ks = 0; ks < 4; ++ks) akk[kt][ks] = *(const bf16x8*)(PROJ + (rowbase + 32 * kb + 16 * kt + fr) * OD_PITCH + 2048 + h * 128 + 8 * fq + 32 * ks);
                          __builtin_amdgcn_sched_barrier(0);
#pragma unroll
                          for (int it = 0; it < 8; ++it) { const int key = 4 * it + (lane >> 4), seg = lane & 15; *(LAS u32x4*)(vb + key * 136 + seg * 8) = gw[it]; } }
                        asm volatile("s_waitcnt lgkmcnt(0)" ::: "memory");
                        f32x4 z[2][2];
#pragma unroll
                        for (int kt = 0; kt < 2; ++kt) {
                            bf16x8 ak[4];
#pragma unroll
                            for (int ks = 0; ks < 4; ++ks) ak[ks] = akk[kt][ks];
#pragma unroll
                            for (int m = 0; m < 2; ++m) { f32x4 acc = (f32x4){0.f, 0.f, 0.f, 0.f};
#pragma unroll
                                for (int ks = 0; ks < 4; ++ks) acc = MFMA16(ak[ks], bq[m][ks], acc);
                                z[kt][m] = acc; }
                        }
                        const bool diag = (kb == qt);
                        bf16x8 pb[2];
#pragma unroll
                        for (int m = 0; m < 2; ++m) {
                            float kp[2][4], sg[2][4];
#pragma unroll
                            for (int kt = 0; kt < 2; ++kt)
#pragma unroll
                                for (int j = 0; j < 4; ++j) { const float t = __expf(z[kt][m][j] * 0.08838834764831845f); const float k1 = __builtin_amdgcn_rcpf(1.f + t);
                                    const bool e = !diag || (16 * kt + 4 * fq + j < 16 * m + fr); kp[kt][j] = e ? k1 : 1.f; sg[kt][j] = e ? t * k1 : 0.f; }
                            const float g0 = (kp[0][0] * kp[0][1]) * (kp[0][2] * kp[0][3]), g1 = (kp[1][0] * kp[1][1]) * (kp[1][2] * kp[1][3]);
                            float g0a[4], g1a[4];
#pragma unroll
                            for (int f = 0; f < 4; ++f) { g0a[f] = __shfl(g0, fr + 16 * f); g1a[f] = __shfl(g1, fr + 16 * f); }
                            const float tot0 = (g0a[0] * g0a[1]) * (g0a[2] * g0a[3]), tot1 = (g1a[0] * g1a[1]) * (g1a[2] * g1a[3]);
                            const float aft1 = (fq < 1 ? g1a[1] : 1.f) * (fq < 2 ? g1a[2] : 1.f) * (fq < 3 ? g1a[3] : 1.f);
                            const float aft0 = (fq < 1 ? g0a[1] : 1.f) * (fq < 2 ? g0a[2] : 1.f) * (fq < 3 ? g0a[3] : 1.f) * tot1;
                            float av[2][4];
#pragma unroll
                            for (int kt = 0; kt < 2; ++kt) { float suf = Pc[m] * (kt == 0 ? aft0 : aft1);
#pragma unroll
                                for (int j = 3; j >= 0; --j) { av[kt][j] = sg[kt][j] * suf; suf *= kp[kt][j]; } }
                            Pc[m] *= tot0 * tot1;
                            pb[m] = mk8(pk2(av[0][0], av[0][1]), pk2(av[0][2], av[0][3]), pk2(av[1][0], av[1][1]), pk2(av[1][2], av[1][3]));
                        }
#pragma unroll
                        for (int dt = 0; dt < 8; ++dt) {
                            const LAS bf16_t* cp = vb + (4 * fq + (fr >> 2)) * 136 + 16 * dt + 4 * (fr & 3);
                            const s16x4_t lo = lds_tr4(cp), hi = lds_tr4(cp + 16 * 136);
                            const bf16x8 vv = __builtin_shufflevector(lo, hi, 0, 1, 2, 3, 4, 5, 6, 7);
                            o[dt][0] = MFMA16(vv, pb[0], o[dt][0]); o[dt][1] = MFMA16(vv, pb[1], o[dt][1]);
                        }
                        asm volatile("s_waitcnt lgkmcnt(0)" ::: "memory");
                        if (__all(Pc[0] <= SB_CUT && Pc[1] <= SB_CUT)) break;
                    }
#pragma unroll
                    for (int m = 0; m < 2; ++m)
#pragma unroll
                        for (int dt = 0; dt < 8; ++dt) { u32x2 w; w.x = pk2(o[dt][m][0], o[dt][m][1]); w.y = pk2(o[dt][m][2], o[dt][m][3]);
                            *(u32x2*)(ATT + (rowbase + q0 + 16 * m + fr) * DM + h * 128 + 16 * dt + 4 * fq) = w; }
                }
            }
#endif
            GSYNC();
        }
        { pg8::Gemm g{ATT, WOUT, MTOK, 2048, 2048}; pg8::StaticOrder S; S.init(MTOK, 2048, G, (int)blockIdx.x);
          pg8::EpiResid E{xcur, xres, modl + 4096};
          pg8::gemm_phase<pg8::EpiResid, pg8::StaticOrder, true, true>(L, g, S, E); }
        GSYNC();
        { IDS norm_mod_phase(xres, a.in[6] + layer * DM, modl, 3 * 2048, 4 * 2048, XN, gw, NGW, lane); }
        GSYNC();
        { pg8::Gemm g{XN, WUP, MTOK, DFF2, 2048}; pg8::StaticOrder S; S.init(MTOK, DFF2, G, (int)blockIdx.x);
          pg8::EpiConvGate E{GB, HBUF, a.in[16] + (size_t)layer * 3 * DFF2, a.in[17] + (size_t)layer * DFF2, (LAS unsigned*)(L + 131072), 0};
          pg8::gemm_phase<pg8::EpiConvGate, pg8::StaticOrder, true, true>(L, g, S, E); }
        GSYNC();
        { IDS
          const float* cw = a.in[16] + (size_t)layer * 3 * DFF2; const float* cb = a.in[17] + (size_t)layer * DFF2;
          for (int item = blockIdx.x * 512 + tid; item < 64 * DFF; item += G * 512) {
              const int pm = item / DFF, ch = item - pm * DFF;
              const bool first = (pm & 15) == 0; const float fm = first ? 0.f : 1.f;
              const float* h = HBUF + (size_t)pm * 4 * DFF2; const float* hp = first ? h : h - (size_t)4 * DFF2;
              float u0[2], u1[2], um2[2], um1[2], w0[2], w1[2], w2[2], bb[2];
#pragma unroll
              for (int bj = 0; bj < 2; ++bj) { const int c = ch + bj * DFF;
                  u0[bj] = h[c]; u1[bj] = h[DFF2 + c]; um2[bj] = hp[2 * DFF2 + c]; um1[bj] = hp[3 * DFF2 + c];
                  w0[bj] = cw[c]; w1[bj] = cw[DFF2 + c]; w2[bj] = cw[2 * DFF2 + c]; bb[bj] = cb[c]; }
              float res[2];
#pragma unroll
              for (int r = 0; r < 2; ++r) {
                  float cvv[2];
#pragma unroll
                  for (int bj = 0; bj < 2; ++bj) {
                      const float xc = r == 0 ? u0[bj] : u1[bj], x1 = r == 0 ? um1[bj] * fm : u0[bj], x2 = r == 0 ? um2[bj] * fm : um1[bj] * fm;
                      cvv[bj] = w2[bj] * xc + w1[bj] * x1 + w0[bj] * x2 + bb[bj]; }
                  res[r] = cvv[0] / (1.f + __expf(-cvv[0])) * cvv[1];
              }
              GB[(size_t)(pm * 256) * DFF + ch] = (bf16_t)(pk2(res[0], 0.f) & 0xffffu);
              GB[(size_t)(pm * 256 + 1) * DFF + ch] = (bf16_t)(pk2(res[1], 0.f) & 0xffffu);
          } }
        GSYNC();
        { pg8::Gemm g{GB, WDN, MTOK, 2048, DFF}; pg8::StaticOrder S; S.init(MTOK, 2048, G, (int)blockIdx.x);
          pg8::EpiResid E{xres, xres, modl + 5 * 2048};
          pg8::gemm_phase<pg8::EpiResid, pg8::StaticOrder, true, true>(L, g, S, E); }
        GSYNC();
    }
#if DIAG
    { IDS
      float t1 = 0.f, t2 = 0.f;
      for (int k = 0; k < 20; ++k) { const float d = (float)(TS[k + 1] - TS[k]) * 0.01f; if ((DIAG_M1 >> k) & 1) t1 += d; if ((DIAG_M2 >> k) & 1) t2 += d; }
      const float vleak = __log2f(t1 + 1.f); (void)t2;
      for (size_t i = (size_t)blockIdx.x * 512 + tid; i < (size_t)MTOK * DM; i += (size_t)G * 512) xres[i] = vleak;
      return; }
#endif
    { IDS
    for (int row = gw; row < MTOK; row += NGW) {
        f32x4* xr = (f32x4*)(xres + (size_t)row * DM) + lane;
        f32x4 v[8]; float ss = 0.f;
#pragma unroll
        for (int j = 0; j < 8; ++j) { v[j] = xr[64 * j]; ss += (v[j].x * v[j].x + v[j].y * v[j].y) + (v[j].z * v[j].z + v[j].w * v[j].w); }
        ss = wave_sum(ss);
        const float r = rsqrtf(ss * (1.f / DM) + EPS);
#pragma unroll
        for (int j = 0; j < 8; ++j) { const f32x4 g4 = *(const f32x4*)(a.in[19] + 4 * (64 * j + lane)); xr[64 * j] = v[j] * r * g4; }
    } }
}

extern "C" void kernel_launch(void* const* d_in, const int* in_sizes, int n_in, void* d_out, int out_size, void* d_ws, size_t ws_size, hipStream_t stream) {
    static int grid = 0;
    if (grid == 0) {
        if (n_in != 20 || out_size != MTOK * DM || ws_size < WS_END) { fprintf(stderr, "kernel_launch: unexpected shapes (n_in %d, out %d, ws %zu)\n", n_in, out_size, ws_size); grid = -1; return; }
        int dev = 0, cus = 0, per_cu = 0;
        hipGetDevice(&dev); hipDeviceGetAttribute(&cus, hipDeviceAttributeMultiprocessorCount, dev);
        if (hipFuncSetAttribute((const void*)mega_fwd, hipFuncAttributeMaxDynamicSharedMemorySize, LDS_BYTES) != hipSuccess) { fprintf(stderr, "kernel_launch: hipFuncSetAttribute failed\n"); grid = -1; return; }
        if (hipOccupancyMaxActiveBlocksPerMultiprocessor(&per_cu, (const void*)mega_fwd, 512, LDS_BYTES) != hipSuccess || per_cu < 1) per_cu = 1;
        (void)hipGetLastError();
        grid = cus * (per_cu > 1 ? 1 : per_cu);
    }
    if (grid < 0) return;
    Args a{};
    for (int i = 0; i < 20; ++i) a.in[i] = (const float*)d_in[i];
    a.out = (float*)d_out; a.ws = (unsigned char*)d_ws;
    void* args[] = {&a};
    hipError_t e = hipLaunchCooperativeKernel((const void*)mega_fwd, dim3(grid), dim3(512), args, LDS_BYTES, stream);
    if (e != hipSuccess) fprintf(stderr, "cooperative launch failed: %s (grid %d)\n", hipGetErrorString(e), grid);
}
```
